# Optimizing an MI355X kernel written in HIP

```python
import math
import jax, jax.numpy as jnp
from jax import lax
import numpy as np

D_MODEL = 1024
BATCH = 16
SEQ = 256
DEPTH = 2
DEC_BATCH = 8
DEC_SEQ = 1024
PAST_LEN = 512

GRID_W = 64
N_DIR = 2
EPS = 1e-6
ATT_HD = 64
ATT_WIDTH = D_MODEL // 2
ATT_HEADS = ATT_WIDTH // ATT_HD
ATT_KV_HEADS = ATT_HEADS // 4
ATT_KV_WIDTH = ATT_KV_HEADS * ATT_HD
Q_BLOCK = 128
ROPE_THETA = 10000.0
S5_CH = 16
S5_STATE = 64
S5_WIDTH = D_MODEL // 4
S5_GROUPS = S5_WIDTH // S5_CH
M_HD = 64
M_WIDTH = D_MODEL // 4
M_HEADS = M_WIDTH // M_HD
M_CHUNK = 64
M_GATE_COLS = 2 * N_DIR * M_HEADS
MIX_WIDTH = ATT_WIDTH + S5_WIDTH + M_WIDTH
SPLIT_SIZES = (ATT_WIDTH, ATT_KV_WIDTH, ATT_KV_WIDTH, S5_WIDTH, M_WIDTH, M_WIDTH, M_WIDTH, M_WIDTH, M_GATE_COLS)
N_IN = sum(SPLIT_SIZES)
D_FF = ((8 * D_MODEL // 3 + 127) // 128) * 128
CONV_W = 3

kernel_name = "hybrid_dit_s5_gqa_mlstm_prefix_step"


def rms_norm(x, g):
    xf = x.astype(jnp.float32)
    xf = xf * lax.rsqrt(jnp.mean(xf * xf, axis=-1, keepdims=True) + EPS)
    return (xf * g.astype(jnp.float32)).astype(x.dtype)


def adaln(cvec, w_mod, b_mod):
    mod = jax.nn.silu(cvec) @ w_mod + b_mod
    return jnp.split(mod[:, None, :], 6, axis=-1)


def axial_rope(x):
    L = x.shape[1]
    n_rows = L // GRID_W
    row = jnp.repeat(jnp.arange(n_rows), GRID_W)
    col = jnp.tile(jnp.arange(GRID_W), n_rows)
    half = ATT_HD // 2
    inv_freq = 1.0 / (ROPE_THETA ** (jnp.arange(0, half, 2, dtype=jnp.float32) / half))

    def rot(xs, pos):
        ang = pos.astype(jnp.float32)[:, None] * inv_freq[None, :]
        cos = jnp.cos(ang)[None, :, None, :]
        sin = jnp.sin(ang)[None, :, None, :]
        x1, x2 = jnp.split(xs.astype(jnp.float32), 2, axis=-1)
        return jnp.concatenate([x1 * cos - x2 * sin, x2 * cos + x1 * sin], axis=-1)

    out = jnp.concatenate([rot(x[..., :half], row), rot(x[..., half:], col)], axis=-1)
    return out.astype(x.dtype)


def block_attention(q, k, v):
    B, Lq = q.shape[0], q.shape[1]
    G = ATT_HEADS // ATT_KV_HEADS
    qb = q.reshape(B, Lq // Q_BLOCK, Q_BLOCK, ATT_KV_HEADS, G, ATT_HD).transpose(1, 0, 2, 3, 4, 5)
    scale = ATT_HD ** -0.5

    def one_block(qblk):
        s = jnp.einsum('bqhgd,bshd->bhgqs', qblk, k).astype(jnp.float32) * scale
        p = jax.nn.softmax(s, axis=-1).astype(v.dtype)
        return jnp.einsum('bhgqs,bshd->bqhgd', p, v)

    out = lax.map(one_block, qb)
    return out.transpose(1, 0, 2, 3, 4, 5).reshape(B, Lq, ATT_WIDTH)


def s5_scan(u, a_re, a_im, log_dt, b_re, b_im, init_re, init_im):
    dt = jnp.exp(log_dt)[:, None]
    mag = jnp.exp(dt * a_re)
    abar_re = mag * jnp.cos(dt * a_im)
    abar_im = mag * jnp.sin(dt * a_im)
    den = a_re * a_re + a_im * a_im
    nr = abar_re - 1.0
    ni = abar_im
    f_re = (nr * a_re + ni * a_im) / den
    f_im = (ni * a_re - nr * a_im) / den
    bb_re = f_re[..., None] * b_re - f_im[..., None] * b_im
    bb_im = f_re[..., None] * b_im + f_im[..., None] * b_re
    x_re = jnp.einsum('blgc,gpc->blgp', u, bb_re)
    x_im = jnp.einsum('blgc,gpc->blgp', u, bb_im)
    x_re = x_re.at[:, 0].add(abar_re * init_re - abar_im * init_im)
    x_im = x_im.at[:, 0].add(abar_re * init_im + abar_im * init_re)
    A_re = jnp.broadcast_to(abar_re, x_re.shape)
    A_im = jnp.broadcast_to(abar_im, x_im.shape)

    def combine(e1, e2):
        a1r, a1i, b1r, b1i = e1
        a2r, a2i, b2r, b2i = e2
        return (a1r * a2r - a1i * a2i, a1r * a2i + a1i * a2r,
                a2r * b1r - a2i * b1i + b2r, a2r * b1i + a2i * b1r + b2i)

    _, _, s_re, s_im = lax.associative_scan(combine, (A_re, A_im, x_re, x_im), axis=1)
    return s_re, s_im


def s5_mixer(u, a_re, a_im, log_dt, b_re, b_im, c_re, c_im, d_skip, glu_w, glu_b, init_re, init_im):
    B, L = u.shape[0], u.shape[1]
    f32 = jnp.float32
    uf = u.astype(f32).reshape(B, L, S5_GROUPS, S5_CH)
    y = uf * d_skip.astype(f32).reshape(S5_GROUPS, S5_CH)
    fin_re, fin_im = [], []
    for d in range(N_DIR):
        ud = uf if d == 0 else uf[:, ::-1]
        s_re, s_im = s5_scan(ud, a_re[d].astype(f32), a_im[d].astype(f32), log_dt[d].astype(f32),
                             b_re[d].astype(f32), b_im[d].astype(f32),
                             init_re[:, d].astype(f32), init_im[:, d].astype(f32))
        yd = (jnp.einsum('blgp,gcp->blgc', s_re, c_re[d].astype(f32))
              - jnp.einsum('blgp,gcp->blgc', s_im, c_im[d].astype(f32)))
        y = y + (yd if d == 0 else yd[:, ::-1])
        fin_re.append(s_re[:, -1])
        fin_im.append(s_im[:, -1])
    y = y.reshape(B, L, S5_WIDTH)
    z = jax.nn.gelu(y)
    out = z * jax.nn.sigmoid(z @ glu_w.astype(f32) + glu_b.astype(f32))
    return out.astype(u.dtype), jnp.stack(fin_re, axis=1), jnp.stack(fin_im, axis=1)


def mlstm_scan(q, k, v, li, lf, C0, n0, m0):
    B, H, L, HD = q.shape
    nc = L // M_CHUNK

    def chunks(t):
        return jnp.moveaxis(t.reshape((B, H, nc, M_CHUNK) + t.shape[3:]), 2, 0)

    mask = jnp.tril(jnp.ones((M_CHUNK, M_CHUNK), dtype=bool))

    def step(carry, xs):
        C, n, m = carry
        qc, kc, vc, lic, lfc = xs
        b = jnp.cumsum(lfc, axis=-1)
        dmat = b[..., :, None] - b[..., None, :] + lic[..., None, :]
        dmat = jnp.where(mask, dmat, -jnp.inf)
        inter = b + m[..., None]
        m_t = jnp.maximum(inter, jnp.max(dmat, axis=-1))
        w = jnp.exp(dmat - m_t[..., None])
        s_inter = jnp.exp(inter - m_t)
        sc = jnp.einsum('bhtd,bhsd->bhts', qc, kc) * w
        num = (jnp.einsum('bhts,bhsd->bhtd', sc, vc)
               + s_inter[..., None] * jnp.einsum('bhde,bhte->bhtd', C, qc))
        den = jnp.sum(sc, axis=-1) + s_inter * jnp.einsum('bhe,bhte->bht', n, qc)
        h = num / jnp.maximum(jnp.abs(den), jnp.exp(-m_t))[..., None]
        b_last = b[..., -1]
        g = b_last[..., None] - b + lic
        m_new = jnp.maximum(b_last + m, jnp.max(g, axis=-1))
        wk = jnp.exp(g - m_new[..., None])
        decay = jnp.exp(b_last + m - m_new)
        C_new = decay[..., None, None] * C + jnp.einsum('bhs,bhsd,bhse->bhde', wk, vc, kc)
        n_new = decay[..., None] * n + jnp.einsum('bhs,bhse->bhe', wk, kc)
        return (C_new, n_new, m_new), h

    (Cf, nf, mf), h = lax.scan(step, (C0, n0, m0), (chunks(q), chunks(k), chunks(v), chunks(li), chunks(lf)))
    h = jnp.moveaxis(h, 0, 2).reshape(B, H, L, HD)
    return h, Cf, nf, mf


def mlstm_mixer(mq, mk, mv, mo, mg, gate_b, norm_g, C0, n0, m0):
    B, L = mq.shape[0], mq.shape[1]
    f32 = jnp.float32

    def heads(t):
        return t.astype(f32).reshape(B, L, M_HEADS, M_HD).transpose(0, 2, 1, 3)

    q = heads(mq)
    k = heads(mk) * (M_HD ** -0.5)
    v = heads(mv)
    g = mg.astype(f32).reshape(B, L, 2, N_DIR, M_HEADS) + gate_b.astype(f32)
    g = g.transpose(2, 3, 0, 4, 1)
    li_all = g[0]
    lf_all = jax.nn.log_sigmoid(g[1])
    h = jnp.zeros_like(q)
    fin_C, fin_n, fin_m = [], [], []
    for d in range(N_DIR):
        def flip(t):
            return t if d == 0 else jnp.flip(t, axis=2)
        hd, Cf, nf, mf = mlstm_scan(flip(q), flip(k), flip(v), flip(li_all[d]), flip(lf_all[d]),
                                    C0[:, d].astype(f32), n0[:, d].astype(f32), m0[:, d].astype(f32))
        h = h + flip(hd)
        fin_C.append(Cf)
        fin_n.append(nf)
        fin_m.append(mf)
    h = h * lax.rsqrt(jnp.mean(h * h, axis=-1, keepdims=True) + EPS) * norm_g.astype(f32)
    h = h.transpose(0, 2, 1, 3).reshape(B, L, M_WIDTH) * jax.nn.sigmoid(mo.astype(f32))
    return (h.astype(mq.dtype), jnp.stack(fin_C, axis=1), jnp.stack(fin_n, axis=1), jnp.stack(fin_m, axis=1))


def conv_ffn(h, w_gate, w_up, conv_w, conv_b, w_down):
    a = h @ w_gate
    ap = jnp.pad(a, ((0, 0), (1, 1), (0, 0)))
    a = ap[:, :-2] * conv_w[0] + ap[:, 1:-1] * conv_w[1] + ap[:, 2:] * conv_w[2] + conv_b
    return (jax.nn.silu(a) * (h @ w_up)) @ w_down


def trunk_layer(x, cvec, lp, ctx):
    B, L = x.shape[0], x.shape[1]
    sh1, sc1, g1, sh2, sc2, g2 = adaln(cvec, lp['ada_w'], lp['ada_b'])
    h = rms_norm(x, lp['norm1_g']) * (1.0 + sc1) + sh1
    proj = h @ lp['w_in']
    points = [int(p) for p in np.cumsum(SPLIT_SIZES)[:-1]]
    aq, ak, av, su, mq, mk, mv, mo, mg = jnp.split(proj, points, axis=-1)
    aq = rms_norm(aq.reshape(B, L, ATT_HEADS, ATT_HD), lp['q_norm_g'])
    ak = rms_norm(ak.reshape(B, L, ATT_KV_HEADS, ATT_HD), lp['k_norm_g'])
    av = av.reshape(B, L, ATT_KV_HEADS, ATT_HD)
    if ctx is None:
        keys, vals = ak, av
        s5_init_re = jnp.zeros((B, N_DIR, S5_GROUPS, S5_STATE), jnp.float32)
        s5_init_im = jnp.zeros((B, N_DIR, S5_GROUPS, S5_STATE), jnp.float32)
        m_C0 = jnp.zeros((B, N_DIR, M_HEADS, M_HD, M_HD), jnp.float32)
        m_n0 = jnp.zeros((B, N_DIR, M_HEADS, M_HD), jnp.float32)
        m_m0 = jnp.zeros((B, N_DIR, M_HEADS), jnp.float32)
    else:
        ctx_k, ctx_v, s5_init_re, s5_init_im, m_C0, m_n0, m_m0 = ctx
        aq = axial_rope(aq)
        keys = jnp.concatenate([ctx_k.astype(ak.dtype), axial_rope(ak)], axis=1)
        vals = jnp.concatenate([ctx_v.astype(av.dtype), av], axis=1)
    att = block_attention(aq, keys, vals)
    s5o, s5_re, s5_im = s5_mixer(su, lp['s5_a_re'], lp['s5_a_im'], lp['s5_log_dt'], lp['s5_b_re'], lp['s5_b_im'],
                                 lp['s5_c_re'], lp['s5_c_im'], lp['s5_d'], lp['s5_glu_w'], lp['s5_glu_b'],
                                 s5_init_re, s5_init_im)
    mlo, mC, mn, mm = mlstm_mixer(mq, mk, mv, mo, mg, lp['m_gate_b'], lp['m_norm_g'], m_C0, m_n0, m_m0)
    mix = jnp.concatenate([att, s5o.astype(att.dtype), mlo.astype(att.dtype)], axis=-1) @ lp['w_out']
    x = x + g1 * mix
    h2 = rms_norm(x, lp['norm2_g']) * (1.0 + sc2) + sh2
    x = x + g2 * conv_ffn(h2, lp['ffn_w_gate'], lp['ffn_w_up'], lp['ffn_conv_w'], lp['ffn_conv_b'], lp['ffn_w_down'])
    return x, (ak, av, s5_re, s5_im, mC, mn, mm)


def setup_inputs(seed: int = 0) -> dict:
    key = jax.random.key(seed)
    keys = iter(jax.random.split(key, 48))
    f32 = jnp.float32

    def nrm(shape, s):
        return jax.random.normal(next(keys), shape, f32) * s

    D = D_MODEL
    inp = {}
    inp['x_prompt'] = nrm((BATCH, SEQ, D), 1.0)
    inp['x_sample'] = nrm((DEC_BATCH, DEC_SEQ, D), 1.0)
    inp['c'] = nrm((DEC_BATCH, D), 1.0)
    inp['cache_attn_k'] = nrm((DEC_BATCH, DEPTH, PAST_LEN, ATT_KV_HEADS, ATT_HD), 1.0)
    inp['cache_attn_v'] = nrm((DEC_BATCH, DEPTH, PAST_LEN, ATT_KV_HEADS, ATT_HD), 1.0)
    inp['state_s5_re'] = nrm((DEC_BATCH, DEPTH, N_DIR, S5_GROUPS, S5_STATE), 0.1)
    inp['state_s5_im'] = nrm((DEC_BATCH, DEPTH, N_DIR, S5_GROUPS, S5_STATE), 0.1)
    inp['state_mlstm_C'] = nrm((DEC_BATCH, DEPTH, N_DIR, M_HEADS, M_HD, M_HD), 0.1)
    inp['state_mlstm_n'] = nrm((DEC_BATCH, DEPTH, N_DIR, M_HEADS, M_HD), 0.1)
    inp['state_mlstm_m'] = nrm((DEC_BATCH, DEPTH, N_DIR, M_HEADS), 0.5)
    inp['c_ctx'] = nrm((D,), 1.0)
    inp['ada_w'] = nrm((DEPTH, D, 6 * D), D ** -0.5)
    inp['ada_b'] = nrm((DEPTH, 6 * D), 0.02)
    inp['norm1_g'] = 1.0 + nrm((DEPTH, D), 0.02)
    inp['norm2_g'] = 1.0 + nrm((DEPTH, D), 0.02)
    inp['w_in'] = nrm((DEPTH, D, N_IN), D ** -0.5)
    inp['q_norm_g'] = 1.0 + nrm((DEPTH, ATT_HD), 0.02)
    inp['k_norm_g'] = 1.0 + nrm((DEPTH, ATT_HD), 0.02)
    inp['s5_a_re'] = -0.5 + nrm((DEPTH, N_DIR, S5_GROUPS, S5_STATE), 0.01)
    inp['s5_a_im'] = jnp.pi * jnp.arange(S5_STATE, dtype=f32) + nrm((DEPTH, N_DIR, S5_GROUPS, S5_STATE), 0.01)
    inp['s5_log_dt'] = jax.random.uniform(next(keys), (DEPTH, N_DIR, S5_GROUPS), f32, math.log(1e-3), math.log(1e-1))
    inp['s5_b_re'] = nrm((DEPTH, N_DIR, S5_GROUPS, S5_STATE, S5_CH), (2 * S5_CH) ** -0.5)
    inp['s5_b_im'] = nrm((DEPTH, N_DIR, S5_GROUPS, S5_STATE, S5_CH), (2 * S5_CH) ** -0.5)
    inp['s5_c_re'] = nrm((DEPTH, N_DIR, S5_GROUPS, S5_CH, S5_STATE), S5_STATE ** -0.5)
    inp['s5_c_im'] = nrm((DEPTH, N_DIR, S5_GROUPS, S5_CH, S5_STATE), S5_STATE ** -0.5)
    inp['s5_d'] = nrm((DEPTH, S5_WIDTH), 1.0)
    inp['s5_glu_w'] = nrm((DEPTH, S5_WIDTH, S5_WIDTH), S5_WIDTH ** -0.5)
    inp['s5_glu_b'] = nrm((DEPTH, S5_WIDTH), 0.02)
    ig = nrm((DEPTH, N_DIR, M_HEADS), 0.1)
    fg = jnp.linspace(3.0, 6.0, M_HEADS, dtype=f32) + nrm((DEPTH, N_DIR, M_HEADS), 0.1)
    inp['m_gate_b'] = jnp.stack([ig, fg], axis=1)
    inp['m_norm_g'] = 1.0 + nrm((DEPTH, M_HD), 0.02)
    inp['w_out'] = nrm((DEPTH, MIX_WIDTH, D), MIX_WIDTH ** -0.5)
    inp['ffn_w_gate'] = nrm((DEPTH, D, D_FF), D ** -0.5)
    inp['ffn_w_up'] = nrm((DEPTH, D, D_FF), D ** -0.5)
    inp['ffn_conv_w'] = nrm((DEPTH, CONV_W, D_FF), CONV_W ** -0.5)
    inp['ffn_conv_b'] = nrm((DEPTH, D_FF), 0.02)
    inp['ffn_w_down'] = nrm((DEPTH, D_FF, D), D_FF ** -0.5)
    return inp


def reference(x_prompt, x_sample, c, cache_attn_k, cache_attn_v, state_s5_re, state_s5_im,
              state_mlstm_C, state_mlstm_n, state_mlstm_m, c_ctx, ada_w, ada_b, norm1_g, norm2_g,
              w_in, q_norm_g, k_norm_g, s5_a_re, s5_a_im, s5_log_dt, s5_b_re, s5_b_im, s5_c_re, s5_c_im,
              s5_d, s5_glu_w, s5_glu_b, m_gate_b, m_norm_g, w_out, ffn_w_gate, ffn_w_up, ffn_conv_w,
              ffn_conv_b, ffn_w_down):
    xp = x_prompt
    xs = x_sample
    ctx_out = []
    for l in range(DEPTH):
        lp = dict(ada_w=ada_w[l], ada_b=ada_b[l], norm1_g=norm1_g[l], norm2_g=norm2_g[l], w_in=w_in[l],
                  q_norm_g=q_norm_g[l], k_norm_g=k_norm_g[l], s5_a_re=s5_a_re[l], s5_a_im=s5_a_im[l],
                  s5_log_dt=s5_log_dt[l], s5_b_re=s5_b_re[l], s5_b_im=s5_b_im[l], s5_c_re=s5_c_re[l],
                  s5_c_im=s5_c_im[l], s5_d=s5_d[l], s5_glu_w=s5_glu_w[l], s5_glu_b=s5_glu_b[l],
                  m_gate_b=m_gate_b[l], m_norm_g=m_norm_g[l], w_out=w_out[l], ffn_w_gate=ffn_w_gate[l],
                  ffn_w_up=ffn_w_up[l], ffn_conv_w=ffn_conv_w[l], ffn_conv_b=ffn_conv_b[l], ffn_w_down=ffn_w_down[l])
        xp, st = trunk_layer(xp, c_ctx[None, :], lp, None)
        ctx_out.append(st)
        ctx = (cache_attn_k[:, l], cache_attn_v[:, l], state_s5_re[:, l], state_s5_im[:, l],
               state_mlstm_C[:, l], state_mlstm_n[:, l], state_mlstm_m[:, l])
        xs, _ = trunk_layer(xs, c, lp, ctx)
    new_attn_k = jnp.stack([s[0] for s in ctx_out], axis=1)
    new_attn_v = jnp.stack([s[1] for s in ctx_out], axis=1)
    new_s5_re = jnp.stack([s[2] for s in ctx_out], axis=1)
    new_s5_im = jnp.stack([s[3] for s in ctx_out], axis=1)
    new_mlstm_C = jnp.stack([s[4] for s in ctx_out], axis=1)
    new_mlstm_n = jnp.stack([s[5] for s in ctx_out], axis=1)
    new_mlstm_m = jnp.stack([s[6] for s in ctx_out], axis=1)
    return (xp, xs, new_attn_k, new_attn_v, new_s5_re, new_s5_im, new_mlstm_C, new_mlstm_n, new_mlstm_m)
```

```cpp
#include <hip/hip_runtime.h>
#include <hip/hip_bf16.h>
#include <cstdio>
#include <cstdint>
#include <cmath>
namespace pg8 {
#define PG8_LAS __attribute__((address_space(3)))
typedef unsigned short bf16_t;
typedef short bf16x8 __attribute__((ext_vector_type(8)));
typedef float f32x4 __attribute__((ext_vector_type(4)));
typedef unsigned u32x4 __attribute__((ext_vector_type(4)));
constexpr int BM = 256, BK = 64, HALF = 128, HTB = HALF * BK * 2  , STAGE_BYTES = 8 * HTB, NXCD = 8, WGM = 8;

__host__ __device__ __forceinline__ int lds_byte(int r, int c) { const int st = (r >> 4) * 2 + (c >> 5), rr = r & 15, cc = c & 31, ob = rr * 64 + cc * 2; return st * 1024 + (ob ^ (((ob >> 9) & 1) << 5)); }
__host__ __device__ __forceinline__ void stage_rc(int b, int& R, int& C) { const int st = b / 1024, sb = b % 1024, swz = sb ^ (((sb >> 9) & 1) << 5); R = (st >> 1) * 16 + swz / 64; C = (st & 1) * 32 + (swz % 64) / 2; }
__host__ __device__ __forceinline__ int perm32(int rho) { const int n = rho >> 4, i = rho & 15; return 8 * (i >> 2) + 4 * n + (i & 3); }

struct Unit { int pm, pn; };
struct Gemm { const bf16_t* A; const bf16_t* Bt; int M, N, K; int lda; int amode; };

struct StaticOrder {
    int nM, nN, nwg, G, c;
    __host__ __device__ void init(int M, int N, int G_, int c_) { nM = M / BM; nN = N / BM; nwg = nM * nN; G = G_; c = c_; }
    __host__ __device__ bool next(int i, Unit& u) const {
        const long L = (long)i * G + c; if (L >= nwg) return false;
        int wgid = (int)L; { const int q = nwg / NXCD, r = nwg % NXCD, xcd = wgid % NXCD, off = wgid / NXCD; wgid = (xcd < r ? xcd * (q + 1) : r * (q + 1) + (xcd - r) * q) + off; }
        const int nig = WGM * nN, gid = wgid / nig, fm = gid * WGM, gsz = (nM - fm) < WGM ? (nM - fm) : WGM;
        u.pm = fm + ((wgid % nig) % gsz); u.pn = (wgid % nig) / gsz; return true;
    }
    __device__ __forceinline__ void a_ready(const Unit&) const {}
    __device__ __forceinline__ void done(const Unit&) const {}
};

__device__ __forceinline__ unsigned cvt_pk_bf16(float lo, float hi) { unsigned r; asm volatile("v_cvt_pk_bf16_f32 %0, %1, %2" : "=v"(r) : "v"(lo), "v"(hi)); return r; }
typedef float f32x2 __attribute__((ext_vector_type(2)));
__device__ __forceinline__ f32x2 gelu_pk(f32x2 v) {
    const f32x2 av = __builtin_elementwise_abs(v), d = av * 0.2316418882f + 1.0f;
    f32x2 t; t.x = __builtin_amdgcn_rcpf(d.x); t.y = __builtin_amdgcn_rcpf(d.y);
    f32x2 q = t * 0.5307027145f + (-0.7265760135f); q = q * t + 0.7107068705f; q = q * t + (-0.142248368f); q = q * t + 0.127414796f; q = q * t;
    const f32x2 s = (v * v) * (-0.72134752044f);
    f32x2 e; e.x = __builtin_amdgcn_exp2f(s.x); e.y = __builtin_amdgcn_exp2f(s.y);
    const f32x2 m = v * (q * e), r = v - m;
    f32x2 o; o.x = v.x < 0.f ? m.x : r.x; o.y = v.y < 0.f ? m.y : r.y; return o;
}

template <int ACT  > struct EpiBf16 {
    static constexpr bool PERM = true, AFTER_DRAIN = false; static_assert(ACT == 0 || ACT == 1, "EpiBf16: ACT is 0 (none) or 1 (gelu_pk)");
    bf16_t* O; int ldc; const float* bias; int split_cols; size_t split_stride; float scale0;
    __device__ __forceinline__ void operator()(const f32x4 (&acc)[2][2][4][2], const Unit& u, int wr, int wc, int fr, int fq) const {
        const int row0 = u.pm * BM + wr * 64 + fr; int colt = u.pn * BM; bf16_t* base = O;
        float sc = 1.f; if (split_cols) { const int t = colt / split_cols; base += (size_t)t * split_stride; colt -= t * split_cols; if (t == 0) sc = scale0; }
        const int col0 = colt + wc * 32 + 8 * fq, bcol0 = u.pn * BM + wc * 32 + 8 * fq;
        f32x4 bv[2][2];
#pragma unroll
        for (int bj = 0; bj < 2; ++bj)
#pragma unroll
            for (int n = 0; n < 2; ++n) bv[bj][n] = bias ? *(const f32x4*)(bias + bcol0 + bj * HALF + 4 * n) : (f32x4){0.f, 0.f, 0.f, 0.f};
#pragma unroll
        for (int ai = 0; ai < 2; ++ai)
#pragma unroll
            for (int m = 0; m < 4; ++m) { bf16_t* rowp = base + (size_t)(row0 + ai * HALF + m * 16) * ldc + col0;
#pragma unroll
                for (int bj = 0; bj < 2; ++bj) { f32x4 v0 = acc[ai][bj][m][0] + bv[bj][0], v1 = acc[ai][bj][m][1] + bv[bj][1];
                    if (ACT == 1) { f32x2 a = gelu_pk((f32x2){v0[0], v0[1]}), b = gelu_pk((f32x2){v0[2], v0[3]}), c = gelu_pk((f32x2){v1[0], v1[1]}), d = gelu_pk((f32x2){v1[2], v1[3]});
                        v0 = (f32x4){a.x, a.y, b.x, b.y}; v1 = (f32x4){c.x, c.y, d.x, d.y}; }
                    v0 = v0 * sc; v1 = v1 * sc; u32x4 w; w.x = cvt_pk_bf16(v0[0], v0[1]); w.y = cvt_pk_bf16(v0[2], v0[3]); w.z = cvt_pk_bf16(v1[0], v1[1]); w.w = cvt_pk_bf16(v1[2], v1[3]);
                    *(u32x4*)(rowp + bj * HALF) = w; } }
    }
};


template <class Epi, class Sched, bool ALIGN_EPI = false, bool SP2 = false>
__device__ __forceinline__ void gemm_phase(const int tid, PG8_LAS unsigned char* lds, const Gemm g, const Sched& S, const Epi& E) {
    const int wid = __builtin_amdgcn_readfirstlane(tid >> 6), lane = tid & 63, wr = wid >> 2, wc = wid & 3, fr = lane & 15, fq = lane >> 4;
    const int K = g.K, nt = K / BK;
    unsigned voffA[2], voffB[2];
#pragma unroll
    for (int i = 0; i < 2; ++i) { int R, C; stage_rc(tid * 16 + i * 8192, R, C); const int Rb = Epi::PERM ? ((R & ~31) + perm32(R & 31)) : R;
        voffA[i] = (unsigned)(R * g.lda + C) * 2u; voffB[i] = (unsigned)(Rb * K + C) * 2u; }
    const size_t kstep = (size_t)(BK * 2);
    const size_t hstepA = (size_t)HALF * g.lda * 2, hstepB = (size_t)HALF * K * 2;
    const size_t tstepA = 2 * hstepA, tstepB = 2 * hstepB;
    const int amode = g.amode;
#define PG8_AK(t) ((size_t)(amode ? (((t) >> 1) * 512 + ((t) & 1) * 128) : ((t) * 128)))
    const unsigned ldsw = (unsigned)wid * 1024u;
    const int aoff = lds_byte(wr * 64 + fr, fq * 8), boff = lds_byte(wc * 32 + fr, fq * 8);
#define PG8_SA(b, h) (((b) * 2 + (h)) * HTB)
#define PG8_SB(b, h) ((4 + (b) * 2 + (h)) * HTB)
#define PG8_STAGE(bufoff, gbase, voff) do { _Pragma("unroll") for (int _i = 0; _i < 2; ++_i) \
        __builtin_amdgcn_global_load_lds((const unsigned*)((const char*)(gbase) + (voff)[_i]), (PG8_LAS unsigned*)(lds + (bufoff) + ldsw + _i * 8192), 16, 0, 0); } while (0)
#define PG8_LDA(dst, b, h) do { _Pragma("unroll") for (int m = 0; m < 4; ++m) _Pragma("unroll") for (int k = 0; k < 2; ++k) dst[m][k] = *(const PG8_LAS bf16x8*)(lds + PG8_SA(b, h) + aoff + m * 2048 + k * 1024); } while (0)
#define PG8_LDB(dst, b, h) do { _Pragma("unroll") for (int n = 0; n < 2; ++n) _Pragma("unroll") for (int k = 0; k < 2; ++k) dst[n][k] = *(const PG8_LAS bf16x8*)(lds + PG8_SB(b, h) + boff + n * 2048 + k * 1024); } while (0)
#define PG8_MMA(ai, bj, At, Bt) do { __builtin_amdgcn_s_setprio(1); _Pragma("unroll") for (int m = 0; m < 4; ++m) _Pragma("unroll") for (int n = 0; n < 2; ++n) _Pragma("unroll") for (int k = 0; k < 2; ++k) \
        acc[ai][bj][m][n] = __builtin_amdgcn_mfma_f32_16x16x32_bf16(Bt[n][k], At[m][k], acc[ai][bj][m][n], 0, 0, 0); __builtin_amdgcn_s_setprio(0); } while (0)
#define PG8_WAIT_V(n) asm volatile("s_waitcnt vmcnt(" #n ")" ::: "memory")
#define PG8_WAIT_L(n) asm volatile("s_waitcnt lgkmcnt(" #n ")" ::: "memory")
#define PG8_BAR __builtin_amdgcn_s_barrier()
#define PG8_SCHED __builtin_amdgcn_sched_barrier(0)
    Unit cur, nxt; int ui = 0;
    if (!S.next(0, cur)) return;
    f32x4 acc[2][2][4][2];
#pragma unroll
    for (int a = 0; a < 2; ++a)
#pragma unroll
        for (int b = 0; b < 2; ++b)
#pragma unroll
            for (int m = 0; m < 4; ++m)
#pragma unroll
                for (int n = 0; n < 2; ++n) acc[a][b][m][n] = (f32x4){0.f, 0.f, 0.f, 0.f};
    bf16x8 At[4][2], B0[2][2], B1[2][2];
    const char* cA = (const char*)g.A + (size_t)cur.pm * tstepA; const char* cB = (const char*)g.Bt + (size_t)cur.pn * tstepB;
    S.a_ready(cur);
    if constexpr (SP2) {
        PG8_STAGE(PG8_SB(0, 0), cB, voffB); PG8_STAGE(PG8_SB(0, 1), cB + hstepB, voffB); PG8_STAGE(PG8_SA(0, 0), cA, voffA); PG8_STAGE(PG8_SA(0, 1), cA + hstepA, voffA);
        if (wr == 1) PG8_BAR;
        PG8_WAIT_V(2); PG8_BAR;
        PG8_STAGE(PG8_SB(1, 0), cB + kstep, voffB); PG8_STAGE(PG8_SA(1, 0), cA + kstep, voffA); PG8_STAGE(PG8_SB(1, 1), cB + hstepB + kstep, voffB);
        PG8_WAIT_V(6); PG8_BAR;
    } else {
        PG8_STAGE(PG8_SB(0, 0), cB, voffB); PG8_STAGE(PG8_SA(0, 0), cA, voffA); PG8_STAGE(PG8_SB(0, 1), cB + hstepB, voffB); PG8_STAGE(PG8_SA(0, 1), cA + hstepA, voffA);
        if (wr == 1) PG8_BAR;
        PG8_WAIT_V(4); PG8_BAR;
        PG8_STAGE(PG8_SB(1, 0), cB + kstep, voffB); PG8_STAGE(PG8_SA(1, 0), cA + kstep, voffA); PG8_STAGE(PG8_SB(1, 1), cB + hstepB + kstep, voffB);
        PG8_WAIT_V(6); PG8_BAR;
    }
    for (;;) {
        const bool has_next = S.next(ui + 1, nxt);
        const char* nA = has_next ? (const char*)g.A + (size_t)nxt.pm * tstepA : cA; const char* nB = has_next ? (const char*)g.Bt + (size_t)nxt.pn * tstepB : cB;
        for (int t = 0; t < nt; t += 2) {
            const bool last = (t == nt - 2);
            const char* a1 = cA + PG8_AK(t + 1);
            const char* a2 = last ? nA : cA + PG8_AK(t + 2); const char* b2 = last ? nB : cB + (size_t)(t + 2) * kstep;
            const char* a3 = a2 + kstep; const char* b3 = b2 + kstep;
            if (last && has_next) S.a_ready(nxt);
            if constexpr (SP2) {
            PG8_LDB(B0, 0, 0); PG8_LDB(B1, 0, 1); PG8_SCHED; PG8_LDA(At, 0, 0); PG8_STAGE(PG8_SA(1, 1), a1 + hstepA, voffA);
            PG8_WAIT_V(8); PG8_WAIT_L(0); PG8_BAR; PG8_MMA(0, 0, At, B0); PG8_MMA(0, 1, At, B1); PG8_BAR; PG8_SCHED;
            PG8_LDA(At, 0, 1); PG8_STAGE(PG8_SB(0, 0), b2, voffB); PG8_STAGE(PG8_SB(0, 1), b2 + hstepB, voffB); PG8_STAGE(PG8_SA(0, 0), a2, voffA);
            PG8_WAIT_V(8); PG8_WAIT_L(0); PG8_BAR; PG8_MMA(1, 0, At, B0); PG8_MMA(1, 1, At, B1); PG8_BAR; PG8_SCHED;
            PG8_LDB(B0, 1, 0); PG8_LDB(B1, 1, 1); PG8_SCHED; PG8_LDA(At, 1, 0); PG8_STAGE(PG8_SA(0, 1), a2 + hstepA, voffA);
            PG8_WAIT_V(8); PG8_WAIT_L(0); PG8_BAR; PG8_MMA(0, 0, At, B0); PG8_MMA(0, 1, At, B1); PG8_BAR; PG8_SCHED;
            PG8_LDA(At, 1, 1); PG8_STAGE(PG8_SB(1, 0), b3, voffB); PG8_STAGE(PG8_SB(1, 1), b3 + hstepB, voffB); PG8_STAGE(PG8_SA(1, 0), a3, voffA);
            PG8_WAIT_V(8); PG8_WAIT_L(0); PG8_BAR; PG8_MMA(1, 0, At, B0); PG8_MMA(1, 1, At, B1); PG8_BAR; PG8_SCHED;
            } else {
            PG8_LDB(B0, 0, 0); PG8_SCHED; PG8_LDA(At, 0, 0); PG8_STAGE(PG8_SA(1, 1), a1 + hstepA, voffA);
            PG8_WAIT_L(8); PG8_BAR; PG8_WAIT_L(0); PG8_MMA(0, 0, At, B0); PG8_BAR; PG8_SCHED;
            PG8_LDB(B1, 0, 1); PG8_STAGE(PG8_SB(0, 0), b2, voffB);
            PG8_BAR; PG8_WAIT_L(0); PG8_MMA(0, 1, At, B1); PG8_BAR;
            PG8_LDA(At, 0, 1); PG8_STAGE(PG8_SA(0, 0), a2, voffA);
            PG8_BAR; PG8_WAIT_L(0); PG8_MMA(1, 0, At, B0); PG8_BAR; PG8_SCHED;
            PG8_STAGE(PG8_SB(0, 1), b2 + hstepB, voffB);
            PG8_WAIT_V(6); PG8_BAR; PG8_MMA(1, 1, At, B1); PG8_BAR;
            PG8_LDB(B0, 1, 0); PG8_SCHED; PG8_LDA(At, 1, 0); PG8_STAGE(PG8_SA(0, 1), a2 + hstepA, voffA);
            PG8_WAIT_L(8); PG8_BAR; PG8_WAIT_L(0); PG8_MMA(0, 0, At, B0); PG8_BAR; PG8_SCHED;
            PG8_LDB(B1, 1, 1); PG8_STAGE(PG8_SB(1, 0), b3, voffB);
            PG8_BAR; PG8_WAIT_L(0); PG8_MMA(0, 1, At, B1); PG8_BAR;
            PG8_LDA(At, 1, 1); PG8_STAGE(PG8_SA(1, 0), a3, voffA);
            PG8_BAR; PG8_WAIT_L(0); PG8_MMA(1, 0, At, B0); PG8_BAR; PG8_SCHED;
            PG8_STAGE(PG8_SB(1, 1), b3 + hstepB, voffB);
            PG8_WAIT_V(6); PG8_BAR; PG8_MMA(1, 1, At, B1); PG8_BAR;
            }
        }
        if constexpr (ALIGN_EPI) { if (wr == 0) PG8_BAR; }
        if constexpr (!Epi::AFTER_DRAIN) { int fr_ = fr, fq_ = fq; asm volatile("" : "+v"(fr_), "+v"(fq_));
            E(acc, cur, wr, wc, fr_, fq_); S.done(cur); }
        if (!has_next) break;
#pragma unroll
        for (int a = 0; a < 2; ++a)
#pragma unroll
            for (int b = 0; b < 2; ++b)
#pragma unroll
                for (int m = 0; m < 4; ++m)
#pragma unroll
                    for (int n = 0; n < 2; ++n) acc[a][b][m][n] = (f32x4){0.f, 0.f, 0.f, 0.f};
        cur = nxt; cA = nA; cB = nB; ++ui;
        if constexpr (ALIGN_EPI) { if (wr == 1) PG8_BAR; }
    }
    PG8_WAIT_V(0);
    if constexpr (!ALIGN_EPI) { if (wr == 0) PG8_BAR; }
    PG8_BAR;
    if constexpr (Epi::AFTER_DRAIN) { E.fused(acc, cur, wr, wc, fr, fq, lds, wid, lane); S.done(cur); }
#undef PG8_AK
#undef PG8_SA
#undef PG8_SB
#undef PG8_STAGE
#undef PG8_LDA
#undef PG8_LDB
#undef PG8_MMA
#undef PG8_WAIT_V
#undef PG8_WAIT_L
#undef PG8_BAR
#undef PG8_SCHED
}
}

#include <hip/hip_bf16.h>
#include <cmath>
namespace attn_body {
using bf16=__hip_bfloat16;
using bf16x8=__attribute__((ext_vector_type(8)))short;
using s16x4=__attribute__((ext_vector_type(4)))short;
using f32x16=__attribute__((ext_vector_type(16)))float;
using u32x4=__attribute__((ext_vector_type(4)))unsigned;
constexpr int D=64;
constexpr int NW=8,QBLK=32,QB=QBLK*NW,KVBLK=64;
constexpr int ATTN_UNIT_ROWS=QB;
__device__ __forceinline__ int crow(int r,int hi){return (r&3)+8*(r>>2)+4*hi;}
#define SBAR() __builtin_amdgcn_sched_barrier(0)
__device__ __forceinline__ void cmask(f32x16&p0,f32x16&p1,int jb,int qrel,int hi){
  const float NEG=-INFINITY; int kb=64*jb+4*hi;
  #pragma unroll
  for(int r=0;r<16;++r){int kv=kb+(r&3)+8*(r>>2); if(kv>qrel)p0[r]=NEG; if(kv+32>qrel)p1[r]=NEG;}
}

constexpr int NSLOT=3, SLOTB=8192;
constexpr int LDS_K=0, LDS_V=NSLOT*SLOTB, LDS_WS=2*NSLOT*SLOTB, LDS_OST=LDS_WS+NW*64*4, LDS_BYTES=LDS_OST+NW*4096;
constexpr float C2=0.125f*1.4426950408889634f;
__device__ __forceinline__ void glds16(const void*gsrc,unsigned lds_dst){unsigned keep;
  asm volatile("s_mov_b32 %0, m0\n\ts_mov_b32 m0, %2\n\ts_nop 0\n\tglobal_load_lds_dwordx4 %1, off\n\ts_mov_b32 m0, %0":"=&s"(keep):"v"(gsrc),"s"(lds_dst):"memory");}
__device__ __forceinline__ float max3f(float a,float b,float c){float r;asm("v_max3_f32 %0, %1, %2, %3":"=v"(r):"v"(a),"v"(b),"v"(c));return r;}
__device__ __forceinline__ float max2f(float a,float b){float r;asm("v_max_f32_e32 %0, %1, %2":"=v"(r):"v"(a),"v"(b));return r;}
__device__ __forceinline__ float fadd_s(float a,float b){float r;asm("v_add_f32_e32 %0, %1, %2":"=v"(r):"v"(a),"v"(b));return r;}
__device__ __forceinline__ float fsub_s(float a,float b){float r;asm("v_sub_f32_e32 %0, %1, %2":"=v"(r):"v"(a),"v"(b));return r;}
typedef float f32x2_t __attribute__((ext_vector_type(2))); typedef __bf16 bf16x2_t __attribute__((ext_vector_type(2)));
__device__ __forceinline__ unsigned cvtpk_s(float lo,float hi){f32x2_t v={lo,hi};bf16x2_t b=__builtin_convertvector(v,bf16x2_t);return __builtin_bit_cast(unsigned,b);}
#define WAIT_BAR(N) asm volatile("s_waitcnt vmcnt(" #N ") lgkmcnt(0)\n\ts_barrier":::"memory")

__device__ __forceinline__ void qkt(f32x16&p0,f32x16&p1,const char*Kslot,const bf16x8*qr,const f32x16&negm,int r32,int hi){
  const char*kb=Kslot+hi*1024+r32*16;
  #pragma unroll
  for(int d0=0;d0<4;++d0){
    const bf16x8 b0=*reinterpret_cast<const bf16x8*>(kb+d0*2048);
    const bf16x8 b1=*reinterpret_cast<const bf16x8*>(kb+d0*2048+512);
    if(d0==0){p0=__builtin_amdgcn_mfma_f32_32x32x16_bf16(b0,qr[0],negm,0,0,0);p1=__builtin_amdgcn_mfma_f32_32x32x16_bf16(b1,qr[0],negm,0,0,0);}
    else{p0=__builtin_amdgcn_mfma_f32_32x32x16_bf16(b0,qr[d0],p0,0,0,0);p1=__builtin_amdgcn_mfma_f32_32x32x16_bf16(b1,qr[d0],p1,0,0,0);}}
}
typedef __attribute__((address_space(3))) const char* lds_cptr;
typedef short v4i16_t __attribute__((ext_vector_type(4)));
__device__ __forceinline__ void kload8(bf16x8*kf,lds_cptr kp){
  kf[0]=*(const __attribute__((address_space(3))) bf16x8*)(kp);      kf[1]=*(const __attribute__((address_space(3))) bf16x8*)(kp+512);
  kf[2]=*(const __attribute__((address_space(3))) bf16x8*)(kp+2048); kf[3]=*(const __attribute__((address_space(3))) bf16x8*)(kp+2560);
  kf[4]=*(const __attribute__((address_space(3))) bf16x8*)(kp+4096); kf[5]=*(const __attribute__((address_space(3))) bf16x8*)(kp+4608);
  kf[6]=*(const __attribute__((address_space(3))) bf16x8*)(kp+6144); kf[7]=*(const __attribute__((address_space(3))) bf16x8*)(kp+6656);
}
__device__ __forceinline__ void kload2(bf16x8*kf,lds_cptr kp,int j){ kf[2*j]=*(const __attribute__((address_space(3))) bf16x8*)(kp+j*2048); kf[2*j+1]=*(const __attribute__((address_space(3))) bf16x8*)(kp+j*2048+512); }
__device__ __forceinline__ s16x4 vtr(lds_cptr p){ return __builtin_bit_cast(s16x4,__builtin_amdgcn_ds_read_tr16_b64_v4i16((__attribute__((address_space(3))) v4i16_t*)p)); }
__device__ __forceinline__ float rowmax(const f32x16&p0,const f32x16&p1){
  float a=max3f(p0[0],p0[1],p1[0]),b=max3f(p0[2],p0[3],p1[1]);a=max3f(a,p1[2],p1[3]);
  #pragma unroll
  for(int r=4;r<16;r+=4){a=max3f(a,p0[r],p0[r+1]);b=max3f(b,p0[r+2],p0[r+3]);a=max3f(a,p1[r],p1[r+1]);b=max3f(b,p1[r+2],p1[r+3]);}
  const float m=max2f(a,b);
  auto rr=__builtin_amdgcn_permlane32_swap(__float_as_uint(m),__float_as_uint(m),false,false);
  return max2f(__uint_as_float(rr[0]),__uint_as_float(rr[1]));
}
__device__ __forceinline__ void pv(f32x16*o,int vb,bf16x8 pa0,bf16x8 pa1,bf16x8 pa2,bf16x8 pa3){
  #pragma unroll
  for(int d0=0;d0<2;++d0){s16x4 lo[4],hi[4];
    #pragma unroll
    for(int ks=0;ks<4;++ks){
      asm volatile("ds_read_b64_tr_b16 %0,%1 offset:%c2":"=&v"(lo[ks]):"v"(vb),"i"(d0*4096+ks*1024):"memory");
      asm volatile("ds_read_b64_tr_b16 %0,%1 offset:%c2":"=&v"(hi[ks]):"v"(vb),"i"(d0*4096+ks*1024+512):"memory");}
    asm volatile("s_waitcnt lgkmcnt(0)":::"memory");SBAR();
    #define PK(k) (bf16x8){lo[k][0],lo[k][1],lo[k][2],lo[k][3],hi[k][0],hi[k][1],hi[k][2],hi[k][3]}
    o[d0]=__builtin_amdgcn_mfma_f32_32x32x16_bf16(pa0,PK(0),o[d0],0,0,0);
    o[d0]=__builtin_amdgcn_mfma_f32_32x32x16_bf16(pa1,PK(1),o[d0],0,0,0);
    o[d0]=__builtin_amdgcn_mfma_f32_32x32x16_bf16(pa2,PK(2),o[d0],0,0,0);
    o[d0]=__builtin_amdgcn_mfma_f32_32x32x16_bf16(pa3,PK(3),o[d0],0,0,0);
    #undef PK
  }
}

#ifndef ATTN_STORE16
#define ATTN_STORE16(p,v) (*(u32x4*)(p)=(v))
#endif
template<int THRL> __device__ __forceinline__ void attn_unit(const bf16*Q0,const int QP,const bf16*__restrict__ Kh,const bf16*__restrict__ Vh,const int KP,bf16*O0,const int OP,const int NT,char*shm,const int tid){
  const int lane=tid&63,r32=lane&31,hi=lane>>5; const int wid=__builtin_amdgcn_readfirstlane(tid>>6);
  const bf16*Qw=Q0+(long)(wid*QBLK)*QP;
  const unsigned lds0=(unsigned)(uintptr_t)shm;
  float*wsf=(float*)(shm+LDS_WS)+wid*64;
  const bf16*ksrc=Kh+(long)lane*KP+wid*8;
  const bf16*vsrc=Vh+(long)(16*(wid&3)+(lane>>2))*KP+(wid>>2)*32+(lane&3)*8;
  const unsigned kdst=lds0+LDS_K+wid*1024, vdst=lds0+LDS_V+wid*1024;
  #define DMA_K(t,slot) glds16(ksrc+(long)(t)*KVBLK*KP,(unsigned)__builtin_amdgcn_readfirstlane(kdst+(slot)))
  #define DMA_V(t,slot) glds16(vsrc+(long)(t)*KVBLK*KP,(unsigned)__builtin_amdgcn_readfirstlane(vdst+(slot)))
  const int vb0=(int)(lds0+LDS_V)+((lane>>4)&1)*32+(lane&3)*8+(4*hi+((lane&15)>>2))*64;
  const char*Kbase=shm+LDS_K; bf16x8 kf[8];
  const lds_cptr shm3=(lds_cptr)shm; const lds_cptr kp0=shm3+LDS_K+hi*1024+r32*16; const lds_cptr vp0=shm3+LDS_V+((lane>>4)&1)*32+(lane&3)*8+(4*hi+((lane&15)>>2))*64;
  DMA_K(0,0);DMA_V(0,0);DMA_K(1,SLOTB);
  bf16x8 qr[4];
  #pragma unroll
  for(int d0=0;d0<4;++d0)qr[d0]=*reinterpret_cast<const bf16x8*>(&Qw[(long)r32*QP+d0*16+hi*8]);
  float mhat=0.f,l_reg=0.f;f32x16 o[2];o[0]=f32x16{};o[1]=f32x16{};f32x16 negm=f32x16{};asm volatile("":"+v"(negm));
  #define CMASK(P0,P1,t) do{}while(0)
  bool resc=false;
  #define START(P0,P1) do{ const float rm=rowmax(P0,P1); resc=false; \
    { const float dl=rm; mhat=fadd_s(mhat,dl); \
      _Pragma("unroll") for(int r=0;r<16;++r){P0[r]=fsub_s(P0[r],dl);P1[r]=fsub_s(P1[r],dl);} \
      _Pragma("unroll") for(int r=0;r<16;++r)negm[r]=-mhat; asm volatile("":"+v"(negm)); } \
    _Pragma("unroll") for(int r=0;r<16;++r)P0[r]=__builtin_amdgcn_exp2f(P0[r]); }while(0)
  #define RESC() do{ if(resc){ asm volatile("s_waitcnt lgkmcnt(0)":::"memory"); \
      _Pragma("unroll") for(int d_=0;d_<2;++d_) _Pragma("unroll") for(int r=0;r<16;++r)o[d_][r]*=wsf[crow(r,hi)]; } }while(0)
  f32x16 pA0,pA1,pB0,pB1;
  int sl_prev=0,sl_cur=0,sl_next=SLOTB;
  #define ROT() do{sl_prev=sl_cur;sl_cur=sl_next;sl_next=(sl_next==(NSLOT-1)*SLOTB)?0:sl_next+SLOTB;}while(0)
  DMA_K(2,2*SLOTB);
  WAIT_BAR(3);
  qkt(pA0,pA1,Kbase,qr,negm,r32,hi);asm volatile("s_nop 15\n\ts_nop 7":"+v"(pA0),"+v"(pA1));CMASK(pA0,pA1,0);
  START(pA0,pA1);
  _Pragma("unroll") for(int r=0;r<16;++r)pA1[r]=__builtin_amdgcn_exp2f(pA1[r]);
  WAIT_BAR(0);
  DMA_K(3,0);DMA_V(1,SLOTB);
  ROT();
  kload8(kf,kp0+sl_cur);
  WAIT_BAR(2);
  s16x4 vlo[8],vhi[8]; u32x4 pw0,pw1,pw2,pw3;
  #define PKW(P,B) cvtpk_s(P[B],P[B+1])
  #define PAF(k) __builtin_bit_cast(bf16x8,pw##k)
  #define VFR(i) (bf16x8){vlo[i][0],vlo[i][1],vlo[i][2],vlo[i][3],vhi[i][0],vhi[i][1],vhi[i][2],vhi[i][3]}
  #define PIN(x) asm volatile("":"+v"(x))
  #define MX3(a,b,c) __builtin_fmaxf(__builtin_fmaxf((a),(b)),(c))
  #define GAPA(MF,A0,A1,A2,A3,W0,W1,PW) do{ MF; sacc+=A0; sacc+=A1; sacc+=A2; sacc+=A3; PIN(sacc); W0; W1; PIN(PW); SBAR(); }while(0)
  #define EX(v) __builtin_amdgcn_exp2f(v)
  #define GAPB(MF,X,B) do{ MF; X[B]=EX(X[B]); X[B+1]=EX(X[B+1]); X[B+2]=EX(X[B+2]); X[B+3]=EX(X[B+3]); PIN(X); SBAR(); }while(0)
  #define VRD(i) do{ vlo[i]=vtr(vp_+(((i)>>2)*4096+((i)&3)*1024)); vhi[i]=vtr(vp_+(((i)>>2)*4096+((i)&3)*1024+512)); }while(0)
  #define KRD(G,j) do{ if(G){ kload2(kf,kp0+sl_next,j); SBAR(); } }while(0)
  #define STEP(C0,C1,P0,P1,t,GK,GV,GL) do{ SBAR(); \
    const lds_cptr vp_=vp0+sl_prev; \
    VRD(0); SBAR(); float sacc=(P0[0]+P0[1]); \
    GAPA(C0=__builtin_amdgcn_mfma_f32_32x32x16_bf16(kf[0],qr[0],negm,0,0,0), P0[2],P0[3],P0[4],P0[5],     pw0[0]=PKW(P0,0), pw0[1]=PKW(P0,2), pw0); \
    VRD(4); SBAR(); GAPA(C1=__builtin_amdgcn_mfma_f32_32x32x16_bf16(kf[1],qr[0],negm,0,0,0), P0[6],P0[7],P0[8],P0[9],     pw0[2]=PKW(P0,4), pw0[3]=PKW(P0,6), pw0); \
    VRD(1); SBAR(); GAPA(C0=__builtin_amdgcn_mfma_f32_32x32x16_bf16(kf[2],qr[1],C0,0,0,0),   P0[10],P0[11],P0[12],P0[13], pw1[0]=PKW(P0,8), pw1[1]=PKW(P0,10), pw1); \
    VRD(5); SBAR(); GAPA(C1=__builtin_amdgcn_mfma_f32_32x32x16_bf16(kf[3],qr[1],C1,0,0,0),   P0[14],P0[15],P1[0],P1[1],   pw1[2]=PKW(P0,12),pw1[3]=PKW(P0,14), pw1); \
    VRD(2); SBAR(); GAPA(C0=__builtin_amdgcn_mfma_f32_32x32x16_bf16(kf[4],qr[2],C0,0,0,0),   P1[2],P1[3],P1[4],P1[5],     pw2[0]=PKW(P1,0), pw2[1]=PKW(P1,2), pw2); \
    VRD(6); SBAR(); GAPA(C1=__builtin_amdgcn_mfma_f32_32x32x16_bf16(kf[5],qr[2],C1,0,0,0),   P1[6],P1[7],P1[8],P1[9],     pw2[2]=PKW(P1,4), pw2[3]=PKW(P1,6), pw2); \
    VRD(3); SBAR(); GAPA(C0=__builtin_amdgcn_mfma_f32_32x32x16_bf16(kf[6],qr[3],C0,0,0,0),   P1[10],P1[11],P1[12],P1[13], pw3[0]=PKW(P1,8), pw3[1]=PKW(P1,10), pw3); \
    VRD(7); SBAR(); GAPA(C1=__builtin_amdgcn_mfma_f32_32x32x16_bf16(kf[7],qr[3],C1,0,0,0),   P1[14],P1[15],0.f,0.f,       pw3[2]=PKW(P1,12),pw3[3]=PKW(P1,14), pw3); \
    l_reg+=sacc; \
    if(GK){DMA_K((t)+3,sl_cur);} if(GV){DMA_V((t)+1,sl_next);} \
    CMASK(C0,C1,t); \
    { float a=MX3(C0[0],C0[1],C1[0]),b=MX3(C0[2],C0[3],C1[1]); a=MX3(a,C1[2],C1[3]); \
      _Pragma("unroll") for(int r=4;r<16;r+=4){a=MX3(a,C0[r],C0[r+1]);b=MX3(b,C0[r+2],C0[r+3]);a=MX3(a,C1[r],C1[r+1]);b=MX3(b,C1[r+2],C1[r+3]);} \
      float rm=__builtin_fmaxf(a,b); { auto rr=__builtin_amdgcn_permlane32_swap(__float_as_uint(rm),__float_as_uint(rm),false,false); rm=__builtin_fmaxf(__uint_as_float(rr[0]),__uint_as_float(rr[1])); } \
      resc=false; \
      if(__builtin_expect(__any(rm>(float)THRL),0)){ const float dl=__builtin_fmaxf(rm,0.f); mhat+=dl; \
        _Pragma("unroll") for(int r=0;r<16;++r){C0[r]-=dl;C1[r]-=dl;} \
        _Pragma("unroll") for(int r=0;r<16;++r)negm[r]=-mhat; asm volatile("":"+v"(negm)); \
        const float f=__builtin_amdgcn_exp2f(-dl); l_reg*=f; if(hi==0)wsf[r32]=f; resc=true; } } \
    SBAR(); \
    GAPB(o[0]=__builtin_amdgcn_mfma_f32_32x32x16_bf16(PAF(0),VFR(0),o[0],0,0,0), C0,0); \
    GAPB(o[1]=__builtin_amdgcn_mfma_f32_32x32x16_bf16(PAF(0),VFR(4),o[1],0,0,0), C0,4); \
    KRD(GL,0); GAPB(o[0]=__builtin_amdgcn_mfma_f32_32x32x16_bf16(PAF(1),VFR(1),o[0],0,0,0), C0,8); \
    KRD(GL,1); GAPB(o[1]=__builtin_amdgcn_mfma_f32_32x32x16_bf16(PAF(1),VFR(5),o[1],0,0,0), C0,12); \
    KRD(GL,2); GAPB(o[0]=__builtin_amdgcn_mfma_f32_32x32x16_bf16(PAF(2),VFR(2),o[0],0,0,0), C1,0); \
    KRD(GL,3); GAPB(o[1]=__builtin_amdgcn_mfma_f32_32x32x16_bf16(PAF(2),VFR(6),o[1],0,0,0), C1,4); \
    GAPB(o[0]=__builtin_amdgcn_mfma_f32_32x32x16_bf16(PAF(3),VFR(3),o[0],0,0,0), C1,8); \
    GAPB(o[1]=__builtin_amdgcn_mfma_f32_32x32x16_bf16(PAF(3),VFR(7),o[1],0,0,0), C1,12); \
    }while(0)
  int t=1;
  #undef CMASK
  #define CMASK(P0,P1,t) do{}while(0)
  for(;t+5<NT;t+=2){
    STEP(pB0,pB1,pA0,pA1,t,true,true,true);     WAIT_BAR(2); RESC(); ROT();
    STEP(pA0,pA1,pB0,pB1,t+1,true,true,true);   WAIT_BAR(2); RESC(); ROT();
  }
  #undef CMASK
  #define CMASK(P0,P1,t) do{}while(0)
  #define ENDW(tt) do{ if((tt)+3<NT){WAIT_BAR(2);} else if((tt)+2<NT){WAIT_BAR(1);} else {WAIT_BAR(0);} }while(0)
  for(;t+1<NT;t+=2){
    STEP(pB0,pB1,pA0,pA1,t,(t+3<NT),(t+1<NT),(t+1<NT));       ENDW(t);   RESC(); ROT();
    STEP(pA0,pA1,pB0,pB1,t+1,(t+4<NT),(t+2<NT),(t+2<NT));     ENDW(t+1); RESC(); ROT();
  }
  STEP(pB0,pB1,pA0,pA1,NT-1,false,false,false); RESC();
  { float sacc=pB0[0]+pB0[1]; _Pragma("unroll") for(int r=2;r<16;++r)sacc+=pB0[r]; _Pragma("unroll") for(int r=0;r<16;++r)sacc+=pB1[r]; l_reg+=sacc;
    pw0=(u32x4){PKW(pB0,0),PKW(pB0,2),PKW(pB0,4),PKW(pB0,6)};pw1=(u32x4){PKW(pB0,8),PKW(pB0,10),PKW(pB0,12),PKW(pB0,14)};pw2=(u32x4){PKW(pB1,0),PKW(pB1,2),PKW(pB1,4),PKW(pB1,6)};pw3=(u32x4){PKW(pB1,8),PKW(pB1,10),PKW(pB1,12),PKW(pB1,14)};
    SBAR(); pv(o,vb0+sl_cur,PAF(0),PAF(1),PAF(2),PAF(3)); }
  #undef PKW
  #undef PAF
  #undef VFR
  #undef PIN
  #undef MX3
  #undef GAPA
  #undef GAPB
  #undef EX
  #undef VRD
  #undef KRD
  #undef STEP
  #undef ENDW
  {auto rr=__builtin_amdgcn_permlane32_swap(__float_as_uint(l_reg),__float_as_uint(l_reg),false,false);l_reg=__uint_as_float(rr[0])+__uint_as_float(rr[1]);}
  if(hi==0)wsf[32+r32]=l_reg;asm volatile("s_waitcnt lgkmcnt(0)":::"memory");
  float rli[16];
  #pragma unroll
  for(int r=0;r<16;++r)rli[r]=__builtin_amdgcn_rcpf(wsf[32+crow(r,hi)]);
  bf16*Ow=O0+(long)(wid*QBLK)*OP;
  { bf16*stg=(bf16*)(shm+LDS_OST)+wid*2048;
    #pragma unroll
    for(int r=0;r<16;++r){const int orow=crow(r,hi);
      #pragma unroll
      for(int d0=0;d0<2;++d0)stg[orow*64+d0*32+r32]=__float2bfloat16(o[d0][r]*rli[r]);}
    asm volatile("s_waitcnt lgkmcnt(0)":::"memory");
    #pragma unroll
    for(int i=0;i<4;++i){const int row=i*8+(lane>>3),ch=lane&7; const u32x4 v=*(const u32x4*)(stg+row*64+ch*8); ATTN_STORE16(Ow+(long)row*OP+ch*8,v);} }
  asm volatile("s_waitcnt lgkmcnt(0)\n\ts_barrier":::"memory");
  #undef DMA_K
  #undef DMA_V
  #undef CMASK
  #undef START
  #undef RESC
  #undef ROT
}
constexpr int ATTN_LDS_BYTES=LDS_BYTES;
#undef SBAR
#undef WAIT_BAR
}

#define GAS __attribute__((address_space(1)))
#define LAS __attribute__((address_space(3)))
typedef unsigned short bf16;
typedef unsigned v4u __attribute__((ext_vector_type(4)));
typedef float f32x4 __attribute__((ext_vector_type(4)));
typedef short bf16x8 __attribute__((ext_vector_type(8)));
typedef GAS unsigned gu32;
typedef GAS unsigned long long gu64;
#define RLX_AGENT __ATOMIC_RELAXED, __HIP_MEMORY_SCOPE_AGENT
#define LDS_WAIT() asm volatile("s_waitcnt lgkmcnt(0)" ::: "memory")
#define VM_WAIT() asm volatile("s_waitcnt vmcnt(0)" ::: "memory")
__device__ __forceinline__ unsigned long long rt() { return __builtin_amdgcn_s_memrealtime(); }
__device__ __forceinline__ unsigned f2bf(float f) { unsigned u = __builtin_bit_cast(unsigned, f); return (u + 0x7fffu + ((u >> 16) & 1u)) >> 16; }
__device__ __forceinline__ unsigned pk2(float lo, float hi) { return f2bf(lo) | (f2bf(hi) << 16); }

#define XB_TMO      128
#define XB_XCNT(j)  (256  + 64 * (j))
#define XB_XSUB(j)  (1280 + 64 * (j))
#define XB_XGEN(j)  (2304 + 64 * (j))
#define XB_TOP      3328
#define XB_TOPGEN   3392
#define XCD_BAR_WORDS 3456
#define XB_SPIN_CAP (1u << 18)

__device__ __forceinline__ unsigned xb_ld(unsigned* p)              { return __hip_atomic_load(p, __ATOMIC_RELAXED, __HIP_MEMORY_SCOPE_AGENT); }
__device__ __forceinline__ unsigned xb_add(unsigned* p, unsigned v) { return __hip_atomic_fetch_add(p, v, __ATOMIC_RELAXED, __HIP_MEMORY_SCOPE_AGENT); }
__device__ __forceinline__ unsigned xb_xcc_id() { return (unsigned)__builtin_amdgcn_s_getreg((3 << 11) | 20) & 0xFu; }
#define XB_SPIN(cond, bar) do { unsigned _sp = 0; while (cond) { __builtin_amdgcn_s_sleep(1); \
    if ((++_sp & 255u) == 0u) { if (xb_ld(&(bar)[XB_TMO])) break; if (_sp > XB_SPIN_CAP) { atomicAdd(&(bar)[XB_TMO], 1u); break; } } } } while (0)

struct XcdBarrier {
    unsigned* bar; unsigned x;
    volatile LAS unsigned* st;
};

__device__ __forceinline__ XcdBarrier xcd_barrier_post(unsigned* bar, volatile LAS unsigned* st) {
    XcdBarrier b; b.bar = bar; b.x = xb_xcc_id(); b.st = st;
    if (threadIdx.x == 0) (void)xb_add(&bar[XB_XCNT(b.x)], 1u);
    return b;
}
__device__ __forceinline__ void xcd_barrier_complete(unsigned* bar, unsigned x, unsigned& nloc, unsigned& nx) {
    const unsigned G = gridDim.x * gridDim.y * gridDim.z;
    unsigned sum, cnt, mine, sp = 0u;
    for (;;) {
        sum = 0u; cnt = 0u; mine = 0u;
#pragma unroll
        for (unsigned j = 0; j < 16; ++j) { const unsigned c = xb_ld(&bar[XB_XCNT(j)]); sum += c; cnt += (c > 0u) ? 1u : 0u; mine = (j == x) ? c : mine; }
        if (sum == G) break;
        __builtin_amdgcn_s_sleep(1);
        if ((++sp & 255u) == 0u) { if (xb_ld(&bar[XB_TMO])) break; if (sp > XB_SPIN_CAP) { atomicAdd(&bar[XB_TMO], 1u); break; } }
    }
    nloc = mine > 0u ? mine : 1u; nx = cnt > 0u ? cnt : 1u;
}

__device__ __forceinline__ void xcd_barrier(const XcdBarrier& b) {
    asm volatile("s_waitcnt vmcnt(0)" ::: "memory");
    __syncthreads();
    if (threadIdx.x == 0) {
        unsigned* bar = b.bar;
        __builtin_amdgcn_s_waitcnt(0);
        unsigned nloc = b.st[0], nx = b.st[1];
        if (nloc == 0u) { xcd_barrier_complete(bar, b.x, nloc, nx); b.st[0] = nloc; b.st[1] = nx; }
        const unsigned old = xb_add(&bar[XB_XSUB(b.x)], 1u);
        const unsigned gen = old / nloc;
        if (old + 1u == (gen + 1u) * nloc) {
            __builtin_amdgcn_fence(__ATOMIC_RELEASE, "agent");
            asm volatile("s_waitcnt vmcnt(0)" ::: "memory");
            const unsigned og = xb_add(&bar[XB_TOP], 1u);
            const unsigned tg = og / nx;
            if (og + 1u == (tg + 1u) * nx) xb_add(&bar[XB_TOPGEN], 1u);
            else XB_SPIN(xb_ld(&bar[XB_TOPGEN]) == tg, bar);
            __builtin_amdgcn_fence(__ATOMIC_ACQUIRE, "agent");
            xb_add(&bar[XB_XGEN(b.x)], 1u);
            asm volatile("s_waitcnt vmcnt(0)" ::: "memory");
        } else {
            XB_SPIN(xb_ld(&bar[XB_XGEN(b.x)]) == gen, bar);
            __builtin_amdgcn_fence(__ATOMIC_ACQUIRE, "agent");
            asm volatile("s_waitcnt vmcnt(0)" ::: "memory");
        }
    }
    __syncthreads();
}

constexpr int NWAVES = 8;
#ifndef EN
#define EN 0xFFFF
#endif
#define ENB(b) ((EN >> (b)) & 1)
constexpr int DM = 1024, NPROMPT = 4096, NSAMPLE = 8192, MTOK = 12288, DFF = 2816, NGU = 5632;
constexpr float EPS = 1e-6f;
constexpr float QSCALE = 0.125f * 1.4426950408889634f;
typedef unsigned u32x2 __attribute__((ext_vector_type(2)));

constexpr size_t OUT_Y = 0;
constexpr size_t OUT_K = 12582912, OUT_V = 13631488, OUT_S5RE = 14680064, OUT_S5IM = 14745600, OUT_MC = 14811136, OUT_MN = 15859712, OUT_MM = 15876096;

constexpr size_t MiB = 1u << 20;
constexpr size_t WS_CTL = 0, CTL_ZERO_BYTES = 1 * MiB;
constexpr size_t WS_MOD = 1 * MiB;
constexpr size_t WS_ROPE = 1 * MiB + 512 * 1024;
constexpr size_t WS_S5W1 = 2 * MiB;
constexpr size_t WS_S5W2 = 10 * MiB;
constexpr size_t WS_S5A16 = 14 * MiB;
constexpr size_t WS_GLUT = 15 * MiB;
constexpr size_t WS_WGT = 15 * MiB + 512 * 1024;
constexpr size_t WS_WIN = 16 * MiB;
constexpr size_t WS_WOUT = 24 * MiB;
constexpr size_t WS_WGU = 28 * MiB;
constexpr size_t WS_WDN = 50 * MiB;
constexpr size_t WS_GATES = 61 * MiB;
constexpr size_t WS_H = 62 * MiB;
constexpr size_t WS_BIG = 86 * MiB;
constexpr size_t WS_Q = 86 * MiB;
constexpr size_t WS_KP = 98 * MiB, WS_KS = 99 * MiB, WS_VP = 102 * MiB, WS_VS = 103 * MiB;
constexpr size_t WS_SU = 106 * MiB, WS_MQ = 112 * MiB, WS_MK = 118 * MiB, WS_MV = 124 * MiB, WS_MO = 130 * MiB;
constexpr size_t WS_MIX = 136 * MiB;
constexpr size_t WS_Y5 = 160 * MiB;
constexpr size_t WS_HF = 172 * MiB, WS_HB = 184 * MiB;
constexpr size_t WS_END = 256 * MiB;
static_assert(WS_BIG + (size_t)MTOK * NGU * 2 <= WS_END && WS_HB + (size_t)MTOK * 256 * 4 <= WS_BIG + (size_t)MTOK * NGU * 2, "d_ws map");

constexpr int CW_BAR = 4096;
constexpr int CW_QUEUE = 16384;

constexpr int RING_BYTES = 131072, LDSCTL_OFF = RING_BYTES, MISC_OFF = LDSCTL_OFF + 320, LDS_BYTES = 147456;

struct Args { const float* in[36]; float* out; unsigned char* ws; int ph_lo, ph_hi; };
struct Ctx { float* out; unsigned char* ws; const LAS unsigned long long* tbl; int bid; };
__device__ __forceinline__ const float* inp(const Ctx& a, int i) { const unsigned long long v = a.tbl[i];
    const unsigned lo = __builtin_amdgcn_readfirstlane((unsigned)v), hi = __builtin_amdgcn_readfirstlane((unsigned)(v >> 32)); return (const float*)(((unsigned long long)hi << 32) | lo); }
enum { I_XP = 0, I_XS, I_C, I_CK, I_CV, I_S5RE, I_S5IM, I_MC, I_MN, I_MM, I_CCTX, I_ADAW, I_ADAB, I_N1G, I_N2G, I_WIN, I_QG, I_KG,
       I_ARE, I_AIM, I_LDT, I_BRE, I_BIM, I_CRE, I_CIM, I_S5D, I_GLUW, I_GLUB, I_MGB, I_MNG, I_WOUT, I_WG, I_WU, I_CW, I_CB, I_WD };

__device__ __forceinline__ float bf2f(unsigned short x) { return __uint_as_float(((unsigned)x) << 16); }
__device__ __forceinline__ float wave_sum(float v) {
#pragma unroll
    for (int o = 1; o < 64; o <<= 1) v += __shfl_xor(v, o);
    return v;
}
__device__ __forceinline__ float sigmoidf_(float x) { return 1.0f / (1.0f + __expf(-x)); }
__device__ __forceinline__ int bc_of_row(int r) { return r < NPROMPT ? 0 : 1 + ((r - NPROMPT) >> 10); }

__device__ __forceinline__ void p0_transpose_item(const float* W, int K, int ldn, int k0, int n0, bf16* WT, int drow0, LAS float* scr, int lane) {
#pragma unroll 8
    for (int i = 0; i < 32; ++i) { const int kk = 2 * i + (lane >> 5); scr[kk * 33 + (lane & 31)] = W[(size_t)(k0 + kk) * ldn + n0 + (lane & 31)]; }
    LDS_WAIT(); asm volatile("" ::: "memory");
    const int c = lane & 7;
#pragma unroll
    for (int j = 0; j < 4; ++j) { const int n = (lane >> 3) + 8 * j; const LAS float* s = scr + (8 * c) * 33 + n;
        v4u o; o.x = pk2(s[0 * 33], s[1 * 33]); o.y = pk2(s[2 * 33], s[3 * 33]); o.z = pk2(s[4 * 33], s[5 * 33]); o.w = pk2(s[6 * 33], s[7 * 33]);
        *(GAS v4u*)(WT + (size_t)(drow0 + n) * K + k0 + 8 * c) = o; }
    LDS_WAIT(); asm volatile("" ::: "memory");
}

__device__ __forceinline__ void p0_adaln_unit(const Ctx& a, int u, unsigned char* ldsg, int tid, int lane, int wave) {
    const int l = u / 96, n0 = (u % 96) * 64;
    float* sil = (float*)ldsg;
    float* red = sil + 9 * 1024;
    for (int i = tid; i < 9 * 1024; i += 512) { const int bc = i >> 10, k = i & 1023; const float c = (bc == 0) ? inp(a, I_CCTX)[k] : inp(a, I_C)[(bc - 1) * 1024 + k]; sil[i] = c / (1.0f + expf(-c)); }
    __syncthreads();
    const float* W = inp(a, I_ADAW) + (size_t)l * 1024 * 6144 + n0 + lane;
    float acc[9];
#pragma unroll
    for (int bc = 0; bc < 9; ++bc) acc[bc] = 0.f;
    const int k0 = wave * 128;
#pragma unroll 8
    for (int k = k0; k < k0 + 128; ++k) { const float w = W[(size_t)k * 6144];
#pragma unroll
        for (int bc = 0; bc < 9; ++bc) acc[bc] += sil[bc * 1024 + k] * w; }
#pragma unroll
    for (int bc = 0; bc < 9; ++bc) red[(wave * 9 + bc) * 64 + lane] = acc[bc];
    __syncthreads();
    for (int i = tid; i < 9 * 64; i += 512) { const int bc = i >> 6, ln = i & 63; float s = inp(a, I_ADAB)[l * 6144 + n0 + ln];
#pragma unroll
        for (int w = 0; w < 8; ++w) s += red[(w * 9 + bc) * 64 + ln];
        ((float*)(a.ws + WS_MOD))[(size_t)(l * 9 + bc) * 6144 + n0 + ln] = s; }
    __syncthreads();
}

__device__ __forceinline__ void p0_s5_unit(const Ctx& a, int u, unsigned char* ldsg, int tid) {
    const int l = u >> 4, g = u & 15;
    float2* Pw = (float2*)ldsg;
    float2* Bb = Pw + 2 * 17 * 64;
    float2* Cc = Bb + 2 * 64 * 16;
    float* Kt = (float*)(Cc + 2 * 16 * 64);
    if (tid < 128) {
        const int d = tid >> 6, p = tid & 63; const int gi = (l * 2 + d) * 16 + g, idx = gi * 64 + p;
        const float are = inp(a, I_ARE)[idx], aim = inp(a, I_AIM)[idx], dt = expf(inp(a, I_LDT)[gi]);
        for (int t = 0; t <= 16; ++t) { const float mag = expf((float)t * dt * are), ang = (float)t * dt * aim; float sn, cs; sincosf(ang, &sn, &cs); Pw[(d * 17 + t) * 64 + p] = make_float2(mag * cs, mag * sn); }
        const float2 ab = Pw[(d * 17 + 1) * 64 + p], a16 = Pw[(d * 17 + 16) * 64 + p];
        ((float2*)(a.ws + WS_S5A16))[idx] = a16;
        const float nr = ab.x - 1.0f, ni = ab.y, den = are * are + aim * aim;
        const float fre = (nr * are + ni * aim) / den, fim = (ni * are - nr * aim) / den;
        for (int c = 0; c < 16; ++c) { const float bre = inp(a, I_BRE)[(size_t)idx * 16 + c], bim = inp(a, I_BIM)[(size_t)idx * 16 + c];
            Bb[(d * 64 + p) * 16 + c] = make_float2(fre * bre - fim * bim, fre * bim + fim * bre); }
    }
    for (int i = tid; i < 2048; i += 512) { const int d = i >> 10, c = (i >> 6) & 15, p = i & 63; const size_t s = ((size_t)((l * 2 + d) * 16 + g) * 16 + c) * 64 + p;
        Cc[i] = make_float2(inp(a, I_CRE)[s], inp(a, I_CIM)[s]); }
    __syncthreads();
    {
        const int d = tid >> 8, tau = (tid >> 4) & 15, c = tid & 15;
        float acc[16];
#pragma unroll
        for (int j = 0; j < 16; ++j) acc[j] = 0.f;
        for (int p = 0; p < 64; ++p) { const float2 cc = Cc[(d * 16 + c) * 64 + p], pw = Pw[(d * 17 + tau) * 64 + p];
            const float xr = cc.x * pw.x - cc.y * pw.y, xi = cc.x * pw.y + cc.y * pw.x;
#pragma unroll
            for (int j = 0; j < 16; ++j) { const float2 bb = Bb[(d * 64 + p) * 16 + j]; acc[j] += xr * bb.x - xi * bb.y; } }
#pragma unroll
        for (int j = 0; j < 16; ++j) Kt[((d * 16 + tau) * 16 + c) * 16 + j] = acc[j];
    }
    __syncthreads();
    bf16* W1 = (bf16*)(a.ws + WS_S5W1) + (size_t)u * 512 * 256;
    bf16* W2 = (bf16*)(a.ws + WS_S5W2) + (size_t)u * 256 * 256;
    const float* dsk = inp(a, I_S5D) + l * 256 + g * 16;
    for (int e = tid; e < 65536; e += 512) {
        const int row = e >> 8, col = e & 255, i = row >> 4, c = row & 15, j = col >> 4, c2 = col & 15;
        float v = 0.f;
        if (i >= j) v += Kt[((0 * 16 + (i - j)) * 16 + c) * 16 + c2];
        if (j >= i) v += Kt[((1 * 16 + (j - i)) * 16 + c) * 16 + c2];
        if (row == col) v += dsk[c];
        W1[e] = (bf16)f2bf(v);
    }
    for (int e = tid; e < 65536; e += 512) {
        const int rr = e >> 8, col = e & 255, d = rr >> 7, im = (rr >> 6) & 1, p = rr & 63, j = col >> 4, c2 = col & 15;
        const int ex = d == 0 ? 15 - j : j;
        const float2 pw = Pw[(d * 17 + ex) * 64 + p], bb = Bb[(d * 64 + p) * 16 + c2];
        const float v = im ? (pw.x * bb.y + pw.y * bb.x) : (pw.x * bb.x - pw.y * bb.y);
        W1[65536 + e] = (bf16)f2bf(v);
    }
    for (int e = tid; e < 65536; e += 512) {
        const int row = e >> 8, col = e & 255, i = row >> 4, c = row & 15, d = col >> 7, im = (col >> 6) & 1, p = col & 63;
        const int n = d == 0 ? i + 1 : 16 - i;
        const float2 cc = Cc[(d * 16 + c) * 64 + p], pw = Pw[(d * 17 + n) * 64 + p];
        const float v = im ? -(cc.x * pw.y + cc.y * pw.x) : (cc.x * pw.x - cc.y * pw.y);
        W2[e] = (bf16)f2bf(v);
    }
    __syncthreads();
}

__device__ __forceinline__ void p0_prologue(const Ctx& a, unsigned char* ldsg, int G, const int tid) {
    const int lane = tid & 63, wave = __builtin_amdgcn_readfirstlane(tid >> 6);
    for (int u = a.bid; u < 225; u += G) {
        if (u < 192) p0_adaln_unit(a, u, ldsg, tid, lane, wave);
        else if (u < 224) p0_s5_unit(a, u - 192, ldsg, tid);
        else { float* rp = (float*)(a.ws + WS_ROPE);
            for (int i = tid; i < 1024; i += 512) { const int pos = i >> 4, j = i & 15; const float inv = powf(10000.0f, -(float)j / 16.0f); float sn, cs; sincosf((float)pos * inv, &sn, &cs); rp[i] = cs; rp[1024 + i] = sn; } }
    }
    __syncthreads();
    LAS float* scr = (LAS float*)((LAS unsigned char*)ldsg + wave * 16384);
    const int gw = a.bid * NWAVES + wave, NGW = G * NWAVES;
    constexpr int IT_IN = 16 * 64, IT_OUT = 16 * 32, IT_G = 16 * 88, IT_D = 44 * 32, IT_GLU = 4 * 8, IT_L = IT_IN + IT_OUT + 2 * IT_G + IT_D + IT_GLU;
    for (int it = gw; it < 2 * IT_L; it += NGW) {
        const int l = it / IT_L; int r = it % IT_L;
        if (r < IT_IN) { const int kb = r / 64, nb = r % 64, tile = nb >> 3, cb = nb & 7;
            p0_transpose_item(inp(a, I_WIN) + (size_t)l * 1024 * 2064, 1024, 2064, 64 * kb, 32 * nb, (bf16*)(a.ws + WS_WIN) + (size_t)l * 2048 * 1024, 256 * tile + 128 * (cb & 1) + 32 * (cb >> 1), scr, lane); continue; } r -= IT_IN;
        if (r < IT_OUT) { const int kb = r / 32, nb = r % 32;
            p0_transpose_item(inp(a, I_WOUT) + (size_t)l * 1024 * 1024, 1024, 1024, 64 * kb, 32 * nb, (bf16*)(a.ws + WS_WOUT) + (size_t)l * 1024 * 1024, 32 * nb, scr, lane); continue; } r -= IT_OUT;
        if (r < IT_G) { const int kb = r / 88, nb = r % 88;
            p0_transpose_item(inp(a, I_WG) + (size_t)l * 1024 * DFF, 1024, DFF, 64 * kb, 32 * nb, (bf16*)(a.ws + WS_WGU) + (size_t)l * NGU * 1024, 256 * (nb >> 2) + 32 * (nb & 3), scr, lane); continue; } r -= IT_G;
        if (r < IT_G) { const int kb = r / 88, nb = r % 88;
            p0_transpose_item(inp(a, I_WU) + (size_t)l * 1024 * DFF, 1024, DFF, 64 * kb, 32 * nb, (bf16*)(a.ws + WS_WGU) + (size_t)l * NGU * 1024, 256 * (nb >> 2) + 128 + 32 * (nb & 3), scr, lane); continue; } r -= IT_G;
        if (r < IT_D) { const int kb = r / 32, nb = r % 32;
            p0_transpose_item(inp(a, I_WD) + (size_t)l * DFF * 1024, DFF, 1024, 64 * kb, 32 * nb, (bf16*)(a.ws + WS_WDN) + (size_t)l * 1024 * DFF, 32 * nb, scr, lane); continue; } r -= IT_D;
        { const int kb = r / 8, nb = r % 8;
            p0_transpose_item(inp(a, I_GLUW) + (size_t)l * 256 * 256, 256, 256, 64 * kb, 32 * nb, (bf16*)(a.ws + WS_GLUT) + (size_t)l * 256 * 256, 32 * nb, scr, lane); }
    }
    for (int i = a.bid * 512 + tid; i < 2 * 16 * 1024; i += G * 512) { const int l = i >> 14, j = (i >> 10) & 15, k = i & 1023;
        ((bf16*)(a.ws + WS_WGT))[i] = (bf16)f2bf(inp(a, I_WIN)[((size_t)l * 1024 + k) * 2064 + 2048 + j]); }
}

__device__ __forceinline__ void norm_phase(const Ctx& a, int l, int which  , int G, const int tid) {
    const int lane = tid & 63, wave = __builtin_amdgcn_readfirstlane(tid >> 6);
    const int gw = a.bid * NWAVES + wave, NGW = G * NWAVES;
    const float* gvec = inp(a, which ? I_N2G : I_N1G) + l * 1024;
    const float* mod = (const float*)(a.ws + WS_MOD) + (size_t)l * 9 * 6144;
    bf16* H = (bf16*)(a.ws + WS_H);
    f32x4 gv[4];
#pragma unroll
    for (int j = 0; j < 4; ++j) gv[j] = *(const f32x4*)(gvec + 4 * lane + 256 * j);
    for (int m = gw; m < MTOK; m += NGW) {
        const float* xrow = (l == 0 && which == 0) ? (m < NPROMPT ? inp(a, I_XP) + (size_t)m * DM : inp(a, I_XS) + (size_t)(m - NPROMPT) * DM) : a.out + OUT_Y + (size_t)m * DM;
        const float* mb = mod + (size_t)bc_of_row(m) * 6144 + (which ? 3 * 1024 : 0);
        f32x4 v[4]; float s = 0.f;
#pragma unroll
        for (int j = 0; j < 4; ++j) { v[j] = *(const f32x4*)(xrow + 4 * lane + 256 * j); s += (v[j].x * v[j].x + v[j].y * v[j].y) + (v[j].z * v[j].z + v[j].w * v[j].w); }
        const float r = rsqrtf(wave_sum(s) * (1.0f / DM) + EPS);
#pragma unroll
        for (int j = 0; j < 4; ++j) { const f32x4 sh = *(const f32x4*)(mb + 4 * lane + 256 * j), sc = *(const f32x4*)(mb + 1024 + 4 * lane + 256 * j);
            const f32x4 o = v[j] * r * gv[j] * (sc + 1.0f) + sh;
            u32x2 w; w.x = pk2(o.x, o.y); w.y = pk2(o.z, o.w);
            *(u32x2*)(H + (size_t)m * DM + 4 * lane + 256 * j) = w; }
    }
    if (which == 0) {
        bf16* KS = (bf16*)(a.ws + WS_KS); bf16* VS = (bf16*)(a.ws + WS_VS);
        for (int i = a.bid * 512 + tid; i < 2 * 8 * 8192; i += G * 512) {
            const int kv = i >> 16, b = (i >> 13) & 7, e = (i & 8191) * 8;
            const float* src = inp(a, kv ? I_CV : I_CK) + ((size_t)(b * 2 + l) * 512) * 128 + e;
            const f32x4 x0 = *(const f32x4*)src, x1 = *(const f32x4*)(src + 4);
            v4u o; o.x = pk2(x0.x, x0.y); o.y = pk2(x0.z, x0.w); o.z = pk2(x1.x, x1.y); o.w = pk2(x1.z, x1.w);
            *(v4u*)((kv ? VS : KS) + (size_t)b * 1536 * 128 + e) = o;
        }
    }
}

struct EpiG1 {
    static constexpr bool PERM = false, AFTER_DRAIN = false;
    int l; unsigned char* ws; float* out; const float* qg; const float* kg;
    __device__ __forceinline__ void operator()(const pg8::f32x4 (&acc)[2][2][4][2], const pg8::Unit& u, int wr, int wc, int fr, int fq) const {
        const int pn = u.pn; const bool samp = u.pm >= 16;
        const int kind = (pn <= 1) ? 0 : (pn == 2 ? (wc < 2 ? 1 : 2) : 3);
        const float* rope = (const float*)(ws + WS_ROPE);
        f32x4 gvv[2][2];
        if (kind <= 1) {
#pragma unroll
            for (int bj = 0; bj < 2; ++bj)
#pragma unroll
                for (int n = 0; n < 2; ++n) gvv[bj][n] = *(const f32x4*)((kind == 0 ? qg : kg) + 32 * bj + 16 * n + 4 * fq);
        }
#pragma unroll
        for (int ai = 0; ai < 2; ++ai)
#pragma unroll
            for (int m = 0; m < 4; ++m) {
                const int r = u.pm * 256 + ai * 128 + wr * 64 + m * 16 + fr;
                f32x4 v[2][2];
#pragma unroll
                for (int bj = 0; bj < 2; ++bj)
#pragma unroll
                    for (int n = 0; n < 2; ++n) v[bj][n] = acc[ai][bj][m][n];
                if (kind <= 1) {
                    float ss = 0.f;
#pragma unroll
                    for (int bj = 0; bj < 2; ++bj)
#pragma unroll
                        for (int n = 0; n < 2; ++n) ss += (v[bj][n].x * v[bj][n].x + v[bj][n].y * v[bj][n].y) + (v[bj][n].z * v[bj][n].z + v[bj][n].w * v[bj][n].w);
                    ss += __shfl_xor(ss, 16); ss += __shfl_xor(ss, 32);
                    const float rinv = rsqrtf(ss * (1.0f / 64.0f) + EPS);
#pragma unroll
                    for (int bj = 0; bj < 2; ++bj)
#pragma unroll
                        for (int n = 0; n < 2; ++n) v[bj][n] = v[bj][n] * rinv * gvv[bj][n];
                }
                if (!samp && (kind == 1 || kind == 2)) {
                    const int b = r >> 8, t = r & 255, kvh = wc & 1;
                    float* dst = out + (kind == 1 ? OUT_K : OUT_V) + ((((size_t)b * 2 + l) * 256 + t) * 2 + kvh) * 64 + 4 * fq;
#pragma unroll
                    for (int bj = 0; bj < 2; ++bj)
#pragma unroll
                        for (int n = 0; n < 2; ++n) *(f32x4*)(dst + 32 * bj + 16 * n) = v[bj][n];
                }
                if (samp && kind <= 1) {
                    const int t = (r - NPROMPT) & 1023;
#pragma unroll
                    for (int bj = 0; bj < 2; ++bj) { const int pos = bj == 0 ? (t >> 6) : (t & 63);
                        const f32x4 cs = *(const f32x4*)(rope + pos * 16 + 4 * fq), sn = *(const f32x4*)(rope + 1024 + pos * 16 + 4 * fq);
                        const f32x4 x1 = v[bj][0], x2 = v[bj][1];
                        v[bj][0] = x1 * cs - x2 * sn; v[bj][1] = x2 * cs + x1 * sn; }
                }
                bf16* dst; float scl = 1.0f;
                if (kind == 0) { dst = (bf16*)(ws + WS_Q) + (size_t)r * 512 + (4 * pn + wc) * 64; scl = QSCALE; }
                else if (kind == 3) { dst = (bf16*)(ws + WS_SU + (size_t)(pn - 3) * (6 * MiB)) + (size_t)r * 256 + wc * 64; if (pn == 5) scl = 0.125f; }
                else { const int kvh = wc & 1;
                    if (!samp) dst = (bf16*)(ws + (kind == 1 ? WS_KP : WS_VP)) + (size_t)r * 128 + kvh * 64;
                    else { const int b = (r - NPROMPT) >> 10, t = (r - NPROMPT) & 1023; dst = (bf16*)(ws + (kind == 1 ? WS_KS : WS_VS)) + ((size_t)b * 1536 + 512 + t) * 128 + kvh * 64; } }
#pragma unroll
                for (int bj = 0; bj < 2; ++bj)
#pragma unroll
                    for (int n = 0; n < 2; ++n) { const f32x4 o = v[bj][n] * scl; u32x2 w; w.x = pk2(o.x, o.y); w.y = pk2(o.z, o.w);
                        *(u32x2*)(dst + 32 * bj + 16 * n + 4 * fq) = w; }
                asm volatile("" ::: "memory");
            }
    }
};
struct EpiGlu {
    static constexpr bool PERM = false, AFTER_DRAIN = false;
    const bf16* Z; bf16* MIX; const float* bias;
    __device__ __forceinline__ void operator()(const pg8::f32x4 (&acc)[2][2][4][2], const pg8::Unit& u, int wr, int wc, int fr, int fq) const {
#pragma unroll
        for (int ai = 0; ai < 2; ++ai)
#pragma unroll
            for (int m = 0; m < 4; ++m) { const int r = u.pm * 256 + ai * 128 + wr * 64 + m * 16 + fr;
#pragma unroll
                for (int bj = 0; bj < 2; ++bj)
#pragma unroll
                    for (int n = 0; n < 2; ++n) { const int c = 128 * bj + 32 * wc + 16 * n + 4 * fq;
                        const f32x4 bv = *(const f32x4*)(bias + c); const u32x2 zz = *(const u32x2*)(Z + (size_t)r * 256 + c);
                        const f32x4 s = acc[ai][bj][m][n] + bv;
                        const float z0 = __uint_as_float(zz.x << 16), z1 = __uint_as_float(zz.x & 0xffff0000u), z2 = __uint_as_float(zz.y << 16), z3 = __uint_as_float(zz.y & 0xffff0000u);
                        u32x2 w; w.x = pk2(z0 * sigmoidf_(s.x), z1 * sigmoidf_(s.y)); w.y = pk2(z2 * sigmoidf_(s.z), z3 * sigmoidf_(s.w));
                        *(u32x2*)(MIX + (size_t)r * 1024 + 512 + c) = w; }
                asm volatile("" ::: "memory"); }
    }
};
struct EpiResid {
    static constexpr bool PERM = false, AFTER_DRAIN = false;
    const float* xp; const float* xs; float* xout; const float* gate;
    __device__ __forceinline__ void operator()(const pg8::f32x4 (&acc)[2][2][4][2], const pg8::Unit& u, int wr, int wc, int fr, int fq) const {
        const int bc = u.pm < 16 ? 0 : 1 + ((u.pm - 16) >> 2);
        const float* gp = gate + (size_t)bc * 6144 + u.pn * 256 + wc * 32 + 4 * fq;
        f32x4 gv[2][2];
#pragma unroll
        for (int bj = 0; bj < 2; ++bj)
#pragma unroll
            for (int n = 0; n < 2; ++n) gv[bj][n] = *(const f32x4*)(gp + bj * 128 + n * 16);
#pragma unroll
        for (int ai = 0; ai < 2; ++ai)
#pragma unroll
            for (int m = 0; m < 4; ++m) { const int r = u.pm * 256 + ai * 128 + wr * 64 + m * 16 + fr;
                const float* xi = (r < NPROMPT ? xp + (size_t)r * DM : xs + (size_t)(r - NPROMPT) * DM) + u.pn * 256 + wc * 32 + 4 * fq;
                float* xo = xout + (size_t)r * DM + u.pn * 256 + wc * 32 + 4 * fq;
#pragma unroll
                for (int bj = 0; bj < 2; ++bj)
#pragma unroll
                    for (int n = 0; n < 2; ++n) { const f32x4 b = *(const f32x4*)(xi + bj * 128 + n * 16); *(f32x4*)(xo + bj * 128 + n * 16) = b + gv[bj][n] * acc[ai][bj][m][n]; }
                if (m & 1) asm volatile("" ::: "memory"); }
    }
};

__device__ __forceinline__ void gates_phase(const Ctx& a, int l, int G, const int tid) {
    const int lane = tid & 63, wave = __builtin_amdgcn_readfirstlane(tid >> 6);
    const int gw = a.bid * NWAVES + wave, NGW = G * NWAVES;
    const bf16* H = (const bf16*)(a.ws + WS_H); const bf16* WG = (const bf16*)(a.ws + WS_WGT) + (size_t)l * 16 * 1024;
    float* GT = (float*)(a.ws + WS_GATES);
    const int j = lane & 15; const float bias = inp(a, I_MGB)[l * 16 + j];
    for (int uu = gw; uu < MTOK / 16; uu += NGW) {
        const int r0 = uu * 16;
        const bf16* Ap = H + (size_t)(r0 + (lane & 15)) * DM + 8 * (lane >> 4);
        const bf16* Bp = WG + (size_t)(lane & 15) * DM + 8 * (lane >> 4);
        f32x4 acc = {0.f, 0.f, 0.f, 0.f};
#pragma unroll 8
        for (int ks = 0; ks < 32; ++ks) { const bf16x8 av = *(const bf16x8*)(Ap + ks * 32), bv = *(const bf16x8*)(Bp + ks * 32); acc = __builtin_amdgcn_mfma_f32_16x16x32_bf16(av, bv, acc, 0, 0, 0); }
#pragma unroll
        for (int rg = 0; rg < 4; ++rg) { float v = acc[rg] + bias; if (j >= 8) v = fminf(v, 0.f) - log1pf(expf(-fabsf(v)));
            GT[(size_t)(r0 + 4 * (lane >> 4) + rg) * 16 + j] = v; }
    }
}

template <int NCB> __device__ __forceinline__ void s5_unit(const Ctx& a, int l, int s, int g, unsigned char* ldsg, const int tid) {
    constexpr int NCH = 16 * NCB;
    const int lane = tid & 63, wave = __builtin_amdgcn_readfirstlane(tid >> 6);
    const bool samp = s >= 16; const int row0 = samp ? NPROMPT + (s - 16) * 1024 : s * 256;
    const bf16* U = (const bf16*)(a.ws + WS_SU) + (size_t)row0 * 256 + g * 16;
    const bf16* W1 = (const bf16*)(a.ws + WS_S5W1) + (size_t)(l * 16 + g) * 512 * 256;
    const bf16* W2 = (const bf16*)(a.ws + WS_S5W2) + (size_t)(l * 16 + g) * 256 * 256;
    float* dS = (float*)ldsg;
    bf16* Sin = (bf16*)(ldsg + 256 * 65 * 4);
    const int lr = lane & 15, lq = lane >> 4;
    f32x4 accY[2][NCB], accS[2][NCB];
#pragma unroll
    for (int i = 0; i < 2; ++i)
#pragma unroll
        for (int cb = 0; cb < NCB; ++cb) { accY[i][cb] = (f32x4){0.f, 0.f, 0.f, 0.f}; accS[i][cb] = (f32x4){0.f, 0.f, 0.f, 0.f}; }
#pragma unroll 2
    for (int ks = 0; ks < 8; ++ks) {
        bf16x8 bfr[NCB];
#pragma unroll
        for (int cb = 0; cb < NCB; ++cb) bfr[cb] = *(const bf16x8*)(U + (size_t)((cb * 16 + lr) * 16 + 2 * ks + (lq >> 1)) * 256 + 8 * (lq & 1));
#pragma unroll
        for (int i = 0; i < 2; ++i) {
            const bf16x8 ay = *(const bf16x8*)(W1 + (size_t)((2 * wave + i) * 16 + lr) * 256 + ks * 32 + 8 * lq);
            const bf16x8 as = *(const bf16x8*)(W1 + (size_t)((16 + 2 * wave + i) * 16 + lr) * 256 + ks * 32 + 8 * lq);
#pragma unroll
            for (int cb = 0; cb < NCB; ++cb) { accY[i][cb] = __builtin_amdgcn_mfma_f32_16x16x32_bf16(ay, bfr[cb], accY[i][cb], 0, 0, 0);
                                               accS[i][cb] = __builtin_amdgcn_mfma_f32_16x16x32_bf16(as, bfr[cb], accS[i][cb], 0, 0, 0); }
        }
    }
#pragma unroll
    for (int i = 0; i < 2; ++i)
#pragma unroll
        for (int cb = 0; cb < NCB; ++cb)
#pragma unroll
            for (int rg = 0; rg < 4; ++rg) dS[((2 * wave + i) * 16 + 4 * lq + rg) * (NCH + 1) + cb * 16 + lr] = accS[i][cb][rg];
    __syncthreads();
    if (tid < 128) {
        const int d = tid >> 6, p = tid & 63; const int gi = (l * 2 + d) * 16 + g;
        const float2 a16 = ((const float2*)(a.ws + WS_S5A16))[gi * 64 + p];
        float sr = 0.f, si = 0.f;
        if (samp) { const size_t ix = ((size_t)(((s - 16) * 2 + l) * 2 + d) * 16 + g) * 64 + p; sr = inp(a, I_S5RE)[ix]; si = inp(a, I_S5IM)[ix]; }
        for (int kk = 0; kk < NCH; ++kk) { const int k = d == 0 ? kk : NCH - 1 - kk;
            Sin[k * 264 + 128 * d + p] = (bf16)f2bf(sr); Sin[k * 264 + 128 * d + 64 + p] = (bf16)f2bf(si);
            const float xr = dS[(128 * d + p) * (NCH + 1) + k], xi = dS[(128 * d + 64 + p) * (NCH + 1) + k];
            const float nr = a16.x * sr - a16.y * si + xr, ni = a16.x * si + a16.y * sr + xi; sr = nr; si = ni; }
        if (!samp) { const size_t ox = ((size_t)((s * 2 + l) * 2 + d) * 16 + g) * 64 + p; a.out[OUT_S5RE + ox] = sr; a.out[OUT_S5IM + ox] = si; }
    }
    __syncthreads();
#pragma unroll 2
    for (int ks = 0; ks < 8; ++ks) {
        bf16x8 bfr[NCB];
#pragma unroll
        for (int cb = 0; cb < NCB; ++cb) bfr[cb] = *(const bf16x8*)(Sin + (cb * 16 + lr) * 264 + ks * 32 + 8 * lq);
#pragma unroll
        for (int i = 0; i < 2; ++i) { const bf16x8 ay = *(const bf16x8*)(W2 + (size_t)((2 * wave + i) * 16 + lr) * 256 + ks * 32 + 8 * lq);
#pragma unroll
            for (int cb = 0; cb < NCB; ++cb) accY[i][cb] = __builtin_amdgcn_mfma_f32_16x16x32_bf16(ay, bfr[cb], accY[i][cb], 0, 0, 0); }
    }
    float* Y5 = (float*)(a.ws + WS_Y5);
#pragma unroll
    for (int i = 0; i < 2; ++i)
#pragma unroll
        for (int cb = 0; cb < NCB; ++cb) { const int tok = (cb * 16 + lr) * 16 + (2 * wave + i);
            *(f32x4*)(Y5 + (size_t)(row0 + tok) * 256 + g * 16 + 4 * lq) = accY[i][cb]; }
    __syncthreads();
}

__device__ __forceinline__ void mlstm_unit(const Ctx& a, int l, int s, int h, int dir, unsigned char* ldsg, const int tid) {
    const int lane = tid & 63, wave = __builtin_amdgcn_readfirstlane(tid >> 6);
    const bool samp = s >= 16; const int L = samp ? 1024 : 256, nck = L / 64; const int row0 = samp ? NPROMPT + (s - 16) * 1024 : s * 256;
    constexpr int P = 72;
    bf16* Qs = (bf16*)ldsg;
    bf16* Ks = Qs + 64 * P;
    bf16* KT = Ks + 64 * P;
    bf16* VT = KT + 64 * P;
    bf16* SC = VT + 80 * P;
    bf16* Cb = SC + 64 * P;
    float* fl = (float*)(Cb + 80 * P);
    float* av = fl, *Mv = fl + 64, *sint = fl + 128, *wkv = fl + 192, *emn = fl + 256, *denv = fl + 320, *misc = fl + 384;
    const bf16* MQ = (const bf16*)(a.ws + WS_MQ), *MKb = (const bf16*)(a.ws + WS_MK), *MVb = (const bf16*)(a.ws + WS_MV);
    const float* GT = (const float*)(a.ws + WS_GATES);
    float* HO = (float*)(a.ws + (dir ? WS_HB : WS_HF));
    const int lr = lane & 15, lq = lane >> 4;
    f32x4 accC[3];
    float mrun = 0.f;
#pragma unroll
    for (int i = 0; i < 3; ++i) { accC[i] = (f32x4){0.f, 0.f, 0.f, 0.f};
        const int j = wave + 8 * i;
        if (samp && j < 20) { const int db = j >> 2, eb = j & 3; const size_t sb = (size_t)((((s - 16) * 2 + l) * 2 + dir) * 4 + h);
            if (db < 4) {
#pragma unroll
                for (int rg = 0; rg < 4; ++rg) accC[i][rg] = inp(a, I_MC)[(sb * 64 + db * 16 + 4 * lq + rg) * 64 + eb * 16 + lr];
            } else if (lq == 0) accC[i][0] = inp(a, I_MN)[sb * 64 + eb * 16 + lr]; }
    }
    if (samp) mrun = inp(a, I_MM)[(((s - 16) * 2 + l) * 2 + dir) * 4 + h];
    for (int i = tid; i < 16 * 64; i += 512) { const int d = 64 + (i >> 6), sidx = i & 63; VT[d * P + sidx] = (d == 64) ? (bf16)0x3f80 : (bf16)0; }
#pragma unroll
    for (int i = 0; i < 3; ++i) { const int j = wave + 8 * i; if (j < 20) { const int db = j >> 2, eb = j & 3;
#pragma unroll
        for (int rg = 0; rg < 4; ++rg) Cb[(db * 16 + 4 * lq + rg) * P + eb * 16 + lr] = (bf16)f2bf(accC[i][rg]); } }
    __syncthreads();
    for (int ck = 0; ck < nck; ++ck) {
        {
            const int pos = tid >> 3, seg = tid & 7; const int tok = dir ? L - 1 - (64 * ck + pos) : 64 * ck + pos;
            const size_t go = (size_t)(row0 + tok) * 256 + h * 64 + seg * 8;
            const v4u qv = *(const v4u*)(MQ + go), kv = *(const v4u*)(MKb + go), vv = *(const v4u*)(MVb + go);
            *(v4u*)(Qs + pos * P + seg * 8) = qv; *(v4u*)(Ks + pos * P + seg * 8) = kv;
            const unsigned vw[4] = {vv.x, vv.y, vv.z, vv.w};
#pragma unroll
            for (int e = 0; e < 4; ++e) { VT[(seg * 8 + 2 * e) * P + pos] = (bf16)(vw[e] & 0xffffu); VT[(seg * 8 + 2 * e + 1) * P + pos] = (bf16)(vw[e] >> 16); }
        }
        if (wave == 0) {
            const int tok = dir ? L - 1 - (64 * ck + lane) : 64 * ck + lane;
            const float li = GT[(size_t)(row0 + tok) * 16 + dir * 4 + h], lf = GT[(size_t)(row0 + tok) * 16 + 8 + dir * 4 + h];
            float b = lf;
#pragma unroll
            for (int o = 1; o < 64; o <<= 1) { const float t = __shfl_up(b, o); if (lane >= o) b += t; }
            const float aa = li - b;
            float cm = aa;
#pragma unroll
            for (int o = 1; o < 64; o <<= 1) { const float t = __shfl_up(cm, o); if (lane >= o) cm = fmaxf(cm, t); }
            const float Mt = fmaxf(mrun, cm);
            const float blast = __shfl(b, 63), amax = __shfl(cm, 63);
            const float Mn = fmaxf(mrun, amax);
            av[lane] = aa; Mv[lane] = Mt; sint[lane] = __expf(mrun - Mt); wkv[lane] = __expf(aa - Mn); emn[lane] = __expf(-(b + Mt));
            if (lane == 0) { misc[0] = __expf(mrun - Mn); misc[1] = blast + Mn; }
        }
        __syncthreads();
        const float decay = misc[0]; const float mnew = misc[1];
        {
            const int pos = tid >> 3, seg = tid & 7; const float wk = wkv[pos];
            const v4u kv = *(const v4u*)(Ks + pos * P + seg * 8); const unsigned kw[4] = {kv.x, kv.y, kv.z, kv.w};
#pragma unroll
            for (int e = 0; e < 4; ++e) { KT[(seg * 8 + 2 * e) * P + pos] = (bf16)f2bf(wk * __uint_as_float(kw[e] << 16)); KT[(seg * 8 + 2 * e + 1) * P + pos] = (bf16)f2bf(wk * __uint_as_float(kw[e] & 0xffff0000u)); }
        }
        {
            const int tb = wave >> 1;
#pragma unroll
            for (int i = 0; i < 2; ++i) { const int sb = 2 * (wave & 1) + i; f32x4 sacc = {0.f, 0.f, 0.f, 0.f};
#pragma unroll
                for (int ks = 0; ks < 2; ++ks) { const bf16x8 qa = *(const bf16x8*)(Qs + (tb * 16 + lr) * P + ks * 32 + 8 * lq), kb = *(const bf16x8*)(Ks + (sb * 16 + lr) * P + ks * 32 + 8 * lq);
                    sacc = __builtin_amdgcn_mfma_f32_16x16x32_bf16(qa, kb, sacc, 0, 0, 0); }
                const int sidx = sb * 16 + lr; const float as = av[sidx];
#pragma unroll
                for (int rg = 0; rg < 4; ++rg) { const int t = tb * 16 + 4 * lq + rg; const float w = (sidx <= t) ? __expf(as - Mv[t]) : 0.f; SC[t * P + sidx] = (bf16)f2bf(sacc[rg] * w); } }
        }
        __syncthreads();
        f32x4 nacc[3];
#pragma unroll
        for (int i = 0; i < 3; ++i) { nacc[i] = (f32x4){0.f, 0.f, 0.f, 0.f}; const int j = wave + 8 * i;
            if (j < 20) { const int tb = j / 5, db = j % 5;
#pragma unroll
                for (int ks = 0; ks < 2; ++ks) { const bf16x8 qa = *(const bf16x8*)(Qs + (tb * 16 + lr) * P + ks * 32 + 8 * lq), cbv = *(const bf16x8*)(Cb + (db * 16 + lr) * P + ks * 32 + 8 * lq);
                    nacc[i] = __builtin_amdgcn_mfma_f32_16x16x32_bf16(qa, cbv, nacc[i], 0, 0, 0); }
#pragma unroll
                for (int rg = 0; rg < 4; ++rg) nacc[i][rg] *= sint[tb * 16 + 4 * lq + rg];
#pragma unroll
                for (int ks = 0; ks < 2; ++ks) { const bf16x8 sa = *(const bf16x8*)(SC + (tb * 16 + lr) * P + ks * 32 + 8 * lq), vb = *(const bf16x8*)(VT + (db * 16 + lr) * P + ks * 32 + 8 * lq);
                    nacc[i] = __builtin_amdgcn_mfma_f32_16x16x32_bf16(sa, vb, nacc[i], 0, 0, 0); }
                if (db == 4 && lr == 0) {
#pragma unroll
                    for (int rg = 0; rg < 4; ++rg) denv[tb * 16 + 4 * lq + rg] = nacc[i][rg]; } } }
#pragma unroll
        for (int i = 0; i < 3; ++i) { const int j = wave + 8 * i;
            if (j < 20) { const int db = j >> 2, eb = j & 3;
#pragma unroll
                for (int rg = 0; rg < 4; ++rg) accC[i][rg] *= decay;
#pragma unroll
                for (int ks = 0; ks < 2; ++ks) { const bf16x8 va = *(const bf16x8*)(VT + (db * 16 + lr) * P + ks * 32 + 8 * lq), kb = *(const bf16x8*)(KT + (eb * 16 + lr) * P + ks * 32 + 8 * lq);
                    accC[i] = __builtin_amdgcn_mfma_f32_16x16x32_bf16(va, kb, accC[i], 0, 0, 0); } } }
        __syncthreads();
#pragma unroll
        for (int i = 0; i < 3; ++i) { const int j = wave + 8 * i;
            if (j < 20) { const int tb = j / 5, db = j % 5;
                if (db < 4) {
#pragma unroll
                    for (int rg = 0; rg < 4; ++rg) { const int t = tb * 16 + 4 * lq + rg; const int tok = dir ? L - 1 - (64 * ck + t) : 64 * ck + t;
                        HO[(size_t)(row0 + tok) * 256 + h * 64 + db * 16 + lr] = nacc[i][rg] / fmaxf(fabsf(denv[t]), emn[t]); } }
                const int db2 = j >> 2, eb2 = j & 3;
#pragma unroll
                for (int rg = 0; rg < 4; ++rg) Cb[(db2 * 16 + 4 * lq + rg) * P + eb2 * 16 + lr] = (bf16)f2bf(accC[i][rg]); } }
        mrun = mnew;
        __syncthreads();
    }
    if (!samp) {
        const size_t sb = (size_t)(((s * 2 + l) * 2 + dir) * 4 + h);
#pragma unroll
        for (int i = 0; i < 3; ++i) { const int j = wave + 8 * i;
            if (j < 20) { const int db = j >> 2, eb = j & 3;
                if (db < 4) {
#pragma unroll
                    for (int rg = 0; rg < 4; ++rg) a.out[OUT_MC + (sb * 64 + db * 16 + 4 * lq + rg) * 64 + eb * 16 + lr] = accC[i][rg];
                } else if (lq == 0) a.out[OUT_MN + sb * 64 + eb * 16 + lr] = accC[i][0]; } }
        if (tid == 0) a.out[OUT_MM + sb] = mrun;
    }
    __syncthreads();
}

__device__ __forceinline__ void mix_phase(const Ctx& a, int l, unsigned char* ldsg, volatile LAS unsigned* MISC, const int tid0) {
    gu32* head = (gu32*)(a.ws + WS_CTL) + CW_QUEUE + 64 * l;
    const bf16* Q = (const bf16*)(a.ws + WS_Q); bf16* MIX = (bf16*)(a.ws + WS_MIX);
    for (;;) {
        if (tid0 == 0) MISC[16] = __hip_atomic_fetch_add(head, 1u, RLX_AGENT);
        __syncthreads();
        const int u = (int)MISC[16];
        __syncthreads();
        if (u >= 960) break;
        int tid = tid0; asm volatile("" : "+v"(tid));
        if (u < 64) { if (ENB(11)) mlstm_unit(a, l, 16 + (u >> 3), (u >> 1) & 3, u & 1, ldsg, tid); }
        else if (u < 320) { if (ENB(12)) { const int v = u - 64, b = v >> 5, hq = (v >> 2) & 7, qb = v & 3; const int r0 = NPROMPT + b * 1024 + qb * 256;
            attn_body::attn_unit<8>((const attn_body::bf16*)(Q + (size_t)r0 * 512 + hq * 64), 512, (const attn_body::bf16*)((const bf16*)(a.ws + WS_KS) + (size_t)b * 1536 * 128 + (hq >> 2) * 64),
                                    (const attn_body::bf16*)((const bf16*)(a.ws + WS_VS) + (size_t)b * 1536 * 128 + (hq >> 2) * 64), 128, (attn_body::bf16*)(MIX + (size_t)r0 * 1024 + hq * 64), 1024, 24, (char*)ldsg, tid); } }
        else if (u < 448) { const int v = u - 320; if (ENB(13)) s5_unit<4>(a, l, 16 + (v >> 4), v & 15, ldsg, tid); }
        else if (u < 576) { const int v = u - 448; if (ENB(11)) mlstm_unit(a, l, v >> 3, (v >> 1) & 3, v & 1, ldsg, tid); }
        else if (u < 704) { if (ENB(12)) { const int v = u - 576, b = v >> 3, hq = v & 7; const int r0 = b * 256;
            attn_body::attn_unit<8>((const attn_body::bf16*)(Q + (size_t)r0 * 512 + hq * 64), 512, (const attn_body::bf16*)((const bf16*)(a.ws + WS_KP) + (size_t)r0 * 128 + (hq >> 2) * 64),
                                    (const attn_body::bf16*)((const bf16*)(a.ws + WS_VP) + (size_t)r0 * 128 + (hq >> 2) * 64), 128, (attn_body::bf16*)(MIX + (size_t)r0 * 1024 + hq * 64), 1024, 4, (char*)ldsg, tid); } }
        else { const int v = u - 704; if (ENB(13)) s5_unit<1>(a, l, v >> 4, v & 15, ldsg, tid); }
    }
}

__device__ __forceinline__ float gelu_tanh(float x) { const float t = 0.7978845608028654f * (x + 0.044715f * x * x * x); return 0.5f * x * (1.0f + tanhf(t)); }
__device__ __forceinline__ void fin_phase(const Ctx& a, int l, int G, const int tid) {
    const int lane = tid & 63, wave = __builtin_amdgcn_readfirstlane(tid >> 6);
    const int gw = a.bid * NWAVES + wave, NGW = G * NWAVES;
    const float* Y5 = (const float*)(a.ws + WS_Y5); const float* HF = (const float*)(a.ws + WS_HF); const float* HB = (const float*)(a.ws + WS_HB);
    const bf16* MO = (const bf16*)(a.ws + WS_MO); bf16* Z = (bf16*)(a.ws + WS_SU); bf16* MIX = (bf16*)(a.ws + WS_MIX);
    const f32x4 ng = *(const f32x4*)(inp(a, I_MNG) + l * 64 + 4 * (lane & 15));
    for (int m = gw; m < MTOK; m += NGW) {
        const f32x4 y = *(const f32x4*)(Y5 + (size_t)m * 256 + 4 * lane);
        u32x2 zw; zw.x = pk2(gelu_tanh(y.x), gelu_tanh(y.y)); zw.y = pk2(gelu_tanh(y.z), gelu_tanh(y.w));
        *(u32x2*)(Z + (size_t)m * 256 + 4 * lane) = zw;
        const f32x4 hv = *(const f32x4*)(HF + (size_t)m * 256 + 4 * lane) + *(const f32x4*)(HB + (size_t)m * 256 + 4 * lane);
        float ss = (hv.x * hv.x + hv.y * hv.y) + (hv.z * hv.z + hv.w * hv.w);
        ss += __shfl_xor(ss, 1); ss += __shfl_xor(ss, 2); ss += __shfl_xor(ss, 4); ss += __shfl_xor(ss, 8);
        const float r = rsqrtf(ss * (1.0f / 64.0f) + EPS);
        const u32x2 mo = *(const u32x2*)(MO + (size_t)m * 256 + 4 * lane);
        const float o0 = __uint_as_float(mo.x << 16), o1 = __uint_as_float(mo.x & 0xffff0000u), o2 = __uint_as_float(mo.y << 16), o3 = __uint_as_float(mo.y & 0xffff0000u);
        u32x2 w; w.x = pk2(hv.x * r * ng.x * sigmoidf_(o0), hv.y * r * ng.y * sigmoidf_(o1)); w.y = pk2(hv.z * r * ng.z * sigmoidf_(o2), hv.w * r * ng.w * sigmoidf_(o3));
        *(u32x2*)(MIX + (size_t)m * 1024 + 768 + 4 * lane) = w;
    }
}

__device__ __forceinline__ void conv_phase(const Ctx& a, int l, int G, const int tid) {
    bf16* AU = (bf16*)(a.ws + WS_BIG);
    const float* cw = inp(a, I_CW) + (size_t)l * 3 * DFF; const float* cb = inp(a, I_CB) + (size_t)l * DFF;
    const int NIT = MTOK * (DFF / 8);
    for (int it = a.bid * 512 + tid; it < NIT; it += G * 512) {
        const int m = it / (DFF / 8), f0 = (it % (DFF / 8)) * 8;
        const int t = m < NPROMPT ? (m & 255) : ((m - NPROMPT) & 1023); const int Ls = m < NPROMPT ? 256 : 1024;
        bf16* pa = AU + (size_t)m * NGU + (f0 >> 7) * 256 + (f0 & 127);
        const v4u ac = *(const v4u*)pa, uu = *(const v4u*)(pa + 128);
        v4u ap = {0u, 0u, 0u, 0u}, an = {0u, 0u, 0u, 0u};
        if (t > 0) ap = *(const v4u*)(pa - NGU);
        if (t < Ls - 1) an = *(const v4u*)(pa + NGU);
        const unsigned acw[4] = {ac.x, ac.y, ac.z, ac.w}, apw[4] = {ap.x, ap.y, ap.z, ap.w}, anw[4] = {an.x, an.y, an.z, an.w}, uw[4] = {uu.x, uu.y, uu.z, uu.w};
        float w0[8], w1[8], w2[8], bb[8];
        *(f32x4*)&w0[0] = *(const f32x4*)(cw + f0); *(f32x4*)&w0[4] = *(const f32x4*)(cw + f0 + 4);
        *(f32x4*)&w1[0] = *(const f32x4*)(cw + DFF + f0); *(f32x4*)&w1[4] = *(const f32x4*)(cw + DFF + f0 + 4);
        *(f32x4*)&w2[0] = *(const f32x4*)(cw + 2 * DFF + f0); *(f32x4*)&w2[4] = *(const f32x4*)(cw + 2 * DFF + f0 + 4);
        *(f32x4*)&bb[0] = *(const f32x4*)(cb + f0); *(f32x4*)&bb[4] = *(const f32x4*)(cb + f0 + 4);
        unsigned ow[4];
#pragma unroll
        for (int e = 0; e < 4; ++e) {
            const float c0 = w0[2 * e] * __uint_as_float(apw[e] << 16) + w1[2 * e] * __uint_as_float(acw[e] << 16) + w2[2 * e] * __uint_as_float(anw[e] << 16) + bb[2 * e];
            const float c1 = w0[2 * e + 1] * __uint_as_float(apw[e] & 0xffff0000u) + w1[2 * e + 1] * __uint_as_float(acw[e] & 0xffff0000u) + w2[2 * e + 1] * __uint_as_float(anw[e] & 0xffff0000u) + bb[2 * e + 1];
            ow[e] = pk2(c0 * sigmoidf_(c0) * __uint_as_float(uw[e] << 16), c1 * sigmoidf_(c1) * __uint_as_float(uw[e] & 0xffff0000u));
        }
        v4u o; o.x = ow[0]; o.y = ow[1]; o.z = ow[2]; o.w = ow[3];
        *(v4u*)(pa + 128) = o;
    }
}

constexpr int N_PHASES = 21;
#ifndef MK_SPLIT
#define MK_SPLIT 0
#endif

__global__ void __launch_bounds__(NWAVES * 64, 2) hyb_fwd(Args args) {
    extern __shared__ __attribute__((aligned(16))) unsigned char lds[];
    const int tid0 = threadIdx.x; const int G0 = gridDim.x;
    LAS unsigned char* ldsl = (LAS unsigned char*)lds;
    volatile LAS unsigned* MISC = (volatile LAS unsigned*)(ldsl + MISC_OFF);
    for (int u = tid0; u < (LDS_BYTES - LDSCTL_OFF) / 4; u += NWAVES * 64) ((LAS unsigned*)(ldsl + LDSCTL_OFF))[u] = 0u;
    __syncthreads();
    LAS unsigned long long* ptab = (LAS unsigned long long*)(ldsl + MISC_OFF + 256);
    if (tid0 < 36) ptab[tid0] = (unsigned long long)args.in[tid0];
    __syncthreads();
    gu32* ctl = (gu32*)(args.ws + WS_CTL);
    XcdBarrier bar; bar.bar = (unsigned*)(ctl + CW_BAR); bar.x = 0; bar.st = nullptr;
    if (!MK_SPLIT) bar = xcd_barrier_post((unsigned*)(ctl + CW_BAR), MISC + 8);
    const int lo = args.ph_lo, hi = args.ph_hi;
    const int wave_s = __builtin_amdgcn_readfirstlane(tid0 >> 6);
    for (int ph = lo; ph < hi; ++ph) {
        unsigned ones = ~0u; asm volatile("" : "+s"(ones));
        int tid = wave_s * 64 + (int)__builtin_amdgcn_mbcnt_hi(ones, __builtin_amdgcn_mbcnt_lo(ones, 0u)); asm volatile("" : "+v"(tid));
        Ctx a; a.ws = args.ws; a.out = args.out; a.tbl = ptab; a.bid = blockIdx.x; asm volatile("" : "+s"(a.ws)); asm volatile("" : "+s"(a.out)); asm volatile("" : "+s"(a.bid));
        int G = G0; asm volatile("" : "+s"(G));
        const float* modb = (const float*)(a.ws + WS_MOD);
        if (ph == 0) { if (ENB(0)) p0_prologue(a, lds, G, tid); }
        else {
            const int l = (ph - 1) / 10, q = (ph - 1) % 10;
            switch (q) {
            case 0: if (ENB(1)) norm_phase(a, l, 0, G, tid); break;
            case 1: if (ENB(2)) { gates_phase(a, l, G, tid);
                pg8::Gemm g{(const pg8::bf16_t*)(a.ws + WS_H), (const pg8::bf16_t*)(a.ws + WS_WIN) + (size_t)l * 2048 * 1024, MTOK, 2048, 1024, 1024, 0};
                pg8::StaticOrder S; S.init(MTOK, 2048, G, a.bid);
                EpiG1 E{l, a.ws, a.out, inp(a, I_QG) + l * 64, inp(a, I_KG) + l * 64};
                pg8::gemm_phase<EpiG1, pg8::StaticOrder, true, true>(tid, ldsl, g, S, E); } break;
            case 2: if (ENB(3)) mix_phase(a, l, lds, MISC, tid); break;
            case 3: if (ENB(4)) fin_phase(a, l, G, tid); break;
            case 4: if (ENB(5)) { pg8::Gemm g{(const pg8::bf16_t*)(a.ws + WS_SU), (const pg8::bf16_t*)(a.ws + WS_GLUT) + (size_t)l * 256 * 256, MTOK, 256, 256, 256, 0};
                pg8::StaticOrder S; S.init(MTOK, 256, G, a.bid);
                EpiGlu E{(const bf16*)(a.ws + WS_SU), (bf16*)(a.ws + WS_MIX), inp(a, I_GLUB) + l * 256};
                pg8::gemm_phase<EpiGlu, pg8::StaticOrder, true, true>(tid, ldsl, g, S, E); } break;
            case 5: if (ENB(6)) { pg8::Gemm g{(const pg8::bf16_t*)(a.ws + WS_MIX), (const pg8::bf16_t*)(a.ws + WS_WOUT) + (size_t)l * 1024 * 1024, MTOK, 1024, 1024, 1024, 0};
                pg8::StaticOrder S; S.init(MTOK, 1024, G, a.bid);
                EpiResid E{l == 0 ? inp(a, I_XP) : a.out + OUT_Y, l == 0 ? inp(a, I_XS) : a.out + OUT_Y + (size_t)NPROMPT * DM, a.out + OUT_Y, modb + (size_t)l * 9 * 6144 + 2 * 1024};
                pg8::gemm_phase<EpiResid, pg8::StaticOrder, true, true>(tid, ldsl, g, S, E); } break;
            case 6: if (ENB(7)) norm_phase(a, l, 1, G, tid); break;
            case 7: if (ENB(8)) { pg8::Gemm g{(const pg8::bf16_t*)(a.ws + WS_H), (const pg8::bf16_t*)(a.ws + WS_WGU) + (size_t)l * NGU * 1024, MTOK, NGU, 1024, 1024, 0};
                pg8::StaticOrder S; S.init(MTOK, NGU, G, a.bid);
                pg8::EpiBf16<0> E{(pg8::bf16_t*)(a.ws + WS_BIG), NGU, nullptr, 0, 0, 1.f};
                pg8::gemm_phase<pg8::EpiBf16<0>, pg8::StaticOrder, true, true>(tid, ldsl, g, S, E); } break;
            case 8: if (ENB(9)) conv_phase(a, l, G, tid); break;
            case 9: if (ENB(10)) { pg8::Gemm g{(const pg8::bf16_t*)(a.ws + WS_BIG) + 128, (const pg8::bf16_t*)(a.ws + WS_WDN) + (size_t)l * 1024 * DFF, MTOK, 1024, DFF, NGU, 1};
                pg8::StaticOrder S; S.init(MTOK, 1024, G, a.bid);
                EpiResid E{a.out + OUT_Y, a.out + OUT_Y + (size_t)NPROMPT * DM, a.out + OUT_Y, modb + (size_t)l * 9 * 6144 + 5 * 1024};
                pg8::gemm_phase<EpiResid, pg8::StaticOrder, true, true>(tid, ldsl, g, S, E); } break;
            }
        }
        if (ph + 1 < hi) xcd_barrier(bar);
    }
}

extern "C" void kernel_launch(void* const* d_in, const int* in_sizes, int n_in, void* d_out, int out_size, void* d_ws, size_t ws_size, hipStream_t stream) {
    static int grid = 0;
    if (grid == 0) {
        if (n_in != 36 || ws_size < WS_END) { fprintf(stderr, "kernel_launch: unexpected inputs (n_in %d, ws %zu)\n", n_in, ws_size); grid = -1; return; }
        int dev = 0, cus = 0, per_cu = 0;
        if (hipGetDevice(&dev) != hipSuccess || hipDeviceGetAttribute(&cus, hipDeviceAttributeMultiprocessorCount, dev) != hipSuccess) { grid = -1; return; }
        if (hipFuncSetAttribute((const void*)hyb_fwd, hipFuncAttributeMaxDynamicSharedMemorySize, LDS_BYTES) != hipSuccess) { fprintf(stderr, "kernel_launch: hipFuncSetAttribute failed\n"); grid = -1; return; }
        if (hipOccupancyMaxActiveBlocksPerMultiprocessor(&per_cu, (const void*)hyb_fwd, NWAVES * 64, LDS_BYTES) != hipSuccess || per_cu < 1) { fprintf(stderr, "kernel_launch: occupancy query says %d\n", per_cu); }
        (void)hipGetLastError();
        grid = cus;
    }
    if (grid < 0) return;
    (void)hipMemsetAsync((char*)d_ws + WS_CTL, 0, CTL_ZERO_BYTES, stream);
    Args a{};
    for (int i = 0; i < 36; ++i) a.in[i] = (const float*)d_in[i];
    a.out = (float*)d_out; a.ws = (unsigned char*)d_ws;
#if MK_SPLIT
    for (int ph = 0; ph < N_PHASES; ++ph) { a.ph_lo = ph; a.ph_hi = ph + 1; hipLaunchKernelGGL(hyb_fwd, dim3(grid), dim3(NWAVES * 64), LDS_BYTES, stream, a); }
#else
    a.ph_lo = 0; a.ph_hi = N_PHASES;
    hipLaunchKernelGGL(hyb_fwd, dim3(grid), dim3(NWAVES * 64), LDS_BYTES, stream, a);
#endif
}
```

```cpp
#include <hip/hip_runtime.h>
#include <hip/hip_bf16.h>
#include <cstdio>
#include <cstdint>
#include <cmath>
namespace pg8 {
#define PG8_LAS __attribute__((address_space(3)))
typedef unsigned short bf16_t;
typedef short bf16x8 __attribute__((ext_vector_type(8)));
typedef float f32x4 __attribute__((ext_vector_type(4)));
typedef unsigned u32x4 __attribute__((ext_vector_type(4)));
constexpr int BM = 256, BK = 64, HALF = 128, HTB = HALF * BK * 2  , STAGE_BYTES = 8 * HTB, NXCD = 8, WGM = 8;

__host__ __device__ __forceinline__ int lds_byte(int r, int c) { const int st = (r >> 4) * 2 + (c >> 5), rr = r & 15, cc = c & 31, ob = rr * 64 + cc * 2; return st * 1024 + (ob ^ (((ob >> 9) & 1) << 5)); }
__host__ __device__ __forceinline__ void stage_rc(int b, int& R, int& C) { const int st = b / 1024, sb = b % 1024, swz = sb ^ (((sb >> 9) & 1) << 5); R = (st >> 1) * 16 + swz / 64; C = (st & 1) * 32 + (swz % 64) / 2; }
__host__ __device__ __forceinline__ int perm32(int rho) { const int n = rho >> 4, i = rho & 15; return 8 * (i >> 2) + 4 * n + (i & 3); }

struct Unit { int pm, pn; };
struct Gemm { const bf16_t* A; const bf16_t* Bt; int M, N, K; int lda; int amode; };

struct StaticOrder {
    int nM, nN, nwg, G, c;
    __host__ __device__ void init(int M, int N, int G_, int c_) { nM = M / BM; nN = N / BM; nwg = nM * nN; G = G_; c = c_; }
    __host__ __device__ bool next(int i, Unit& u) const {
        const long L = (long)i * G + c; if (L >= nwg) return false;
        int wgid = (int)L; { const int q = nwg / NXCD, r = nwg % NXCD, xcd = wgid % NXCD, off = wgid / NXCD; wgid = (xcd < r ? xcd * (q + 1) : r * (q + 1) + (xcd - r) * q) + off; }
        const int nig = WGM * nN, gid = wgid / nig, fm = gid * WGM, gsz = (nM - fm) < WGM ? (nM - fm) : WGM;
        u.pm = fm + ((wgid % nig) % gsz); u.pn = (wgid % nig) / gsz; return true;
    }
    __device__ __forceinline__ void a_ready(const Unit&) const {}
    __device__ __forceinline__ void done(const Unit&) const {}
};

__device__ __forceinline__ unsigned cvt_pk_bf16(float lo, float hi) { unsigned r; asm volatile("v_cvt_pk_bf16_f32 %0, %1, %2" : "=v"(r) : "v"(lo), "v"(hi)); return r; }
typedef float f32x2 __attribute__((ext_vector_type(2)));
__device__ __forceinline__ f32x2 gelu_pk(f32x2 v) {
    const f32x2 av = __builtin_elementwise_abs(v), d = av * 0.2316418882f + 1.0f;
    f32x2 t; t.x = __builtin_amdgcn_rcpf(d.x); t.y = __builtin_amdgcn_rcpf(d.y);
    f32x2 q = t * 0.5307027145f + (-0.7265760135f); q = q * t + 0.7107068705f; q = q * t + (-0.142248368f); q = q * t + 0.127414796f; q = q * t;
    const f32x2 s = (v * v) * (-0.72134752044f);
    f32x2 e; e.x = __builtin_amdgcn_exp2f(s.x); e.y = __builtin_amdgcn_exp2f(s.y);
    const f32x2 m = v * (q * e), r = v - m;
    f32x2 o; o.x = v.x < 0.f ? m.x : r.x; o.y = v.y < 0.f ? m.y : r.y; return o;
}

template <int ACT  > struct EpiBf16 {
    static constexpr bool PERM = true, AFTER_DRAIN = false; static_assert(ACT == 0 || ACT == 1, "EpiBf16: ACT is 0 (none) or 1 (gelu_pk)");
    bf16_t* O; int ldc; const float* bias; int split_cols; size_t split_stride; float scale0;
    __device__ __forceinline__ void operator()(const f32x4 (&acc)[2][2][4][2], const Unit& u, int wr, int wc, int fr, int fq) const {
        const int row0 = u.pm * BM + wr * 64 + fr; int colt = u.pn * BM; bf16_t* base = O;
        float sc = 1.f; if (split_cols) { const int t = colt / split_cols; base += (size_t)t * split_stride; colt -= t * split_cols; if (t == 0) sc = scale0; }
        const int col0 = colt + wc * 32 + 8 * fq, bcol0 = u.pn * BM + wc * 32 + 8 * fq;
        f32x4 bv[2][2];
#pragma unroll
        for (int bj = 0; bj < 2; ++bj)
#pragma unroll
            for (int n = 0; n < 2; ++n) bv[bj][n] = bias ? *(const f32x4*)(bias + bcol0 + bj * HALF + 4 * n) : (f32x4){0.f, 0.f, 0.f, 0.f};
#pragma unroll
        for (int ai = 0; ai < 2; ++ai)
#pragma unroll
            for (int m = 0; m < 4; ++m) { bf16_t* rowp = base + (size_t)(row0 + ai * HALF + m * 16) * ldc + col0;
#pragma unroll
                for (int bj = 0; bj < 2; ++bj) { f32x4 v0 = acc[ai][bj][m][0] + bv[bj][0], v1 = acc[ai][bj][m][1] + bv[bj][1];
                    if (ACT == 1) { f32x2 a = gelu_pk((f32x2){v0[0], v0[1]}), b = gelu_pk((f32x2){v0[2], v0[3]}), c = gelu_pk((f32x2){v1[0], v1[1]}), d = gelu_pk((f32x2){v1[2], v1[3]});
                        v0 = (f32x4){a.x, a.y, b.x, b.y}; v1 = (f32x4){c.x, c.y, d.x, d.y}; }
                    v0 = v0 * sc; v1 = v1 * sc; u32x4 w; w.x = cvt_pk_bf16(v0[0], v0[1]); w.y = cvt_pk_bf16(v0[2], v0[3]); w.z = cvt_pk_bf16(v1[0], v1[1]); w.w = cvt_pk_bf16(v1[2], v1[3]);
                    *(u32x4*)(rowp + bj * HALF) = w; } }
    }
};


template <class Epi, class Sched, bool ALIGN_EPI = false, bool SP2 = false>
__device__ __forceinline__ void gemm_phase(const int tid, PG8_LAS unsigned char* lds, const Gemm g, const Sched& S, const Epi& E) {
    const int wid = __builtin_amdgcn_readfirstlane(tid >> 6), lane = tid & 63, wr = wid >> 2, wc = wid & 3, fr = lane & 15, fq = lane >> 4;
    const int K = g.K, nt = K / BK;
    unsigned voffA[2], voffB[2];
#pragma unroll
    for (int i = 0; i < 2; ++i) { int R, C; stage_rc(tid * 16 + i * 8192, R, C); const int Rb = Epi::PERM ? ((R & ~31) + perm32(R & 31)) : R;
        voffA[i] = (unsigned)(R * g.lda + C) * 2u; voffB[i] = (unsigned)(Rb * K + C) * 2u; }
    const size_t kstep = (size_t)(BK * 2);
    const size_t hstepA = (size_t)HALF * g.lda * 2, hstepB = (size_t)HALF * K * 2;
    const size_t tstepA = 2 * hstepA, tstepB = 2 * hstepB;
    const int amode = g.amode;
#define PG8_AK(t) ((size_t)(amode ? (((t) >> 1) * 512 + ((t) & 1) * 128) : ((t) * 128)))
    const unsigned ldsw = (unsigned)wid * 1024u;
    const int aoff = lds_byte(wr * 64 + fr, fq * 8), boff = lds_byte(wc * 32 + fr, fq * 8);
#define PG8_SA(b, h) (((b) * 2 + (h)) * HTB)
#define PG8_SB(b, h) ((4 + (b) * 2 + (h)) * HTB)
#define PG8_STAGE(bufoff, gbase, voff) do { _Pragma("unroll") for (int _i = 0; _i < 2; ++_i) \
        __builtin_amdgcn_global_load_lds((const unsigned*)((const char*)(gbase) + (voff)[_i]), (PG8_LAS unsigned*)(lds + (bufoff) + ldsw + _i * 8192), 16, 0, 0); } while (0)
#define PG8_LDA(dst, b, h) do { _Pragma("unroll") for (int m = 0; m < 4; ++m) _Pragma("unroll") for (int k = 0; k < 2; ++k) dst[m][k] = *(const PG8_LAS bf16x8*)(lds + PG8_SA(b, h) + aoff + m * 2048 + k * 1024); } while (0)
#define PG8_LDB(dst, b, h) do { _Pragma("unroll") for (int n = 0; n < 2; ++n) _Pragma("unroll") for (int k = 0; k < 2; ++k) dst[n][k] = *(const PG8_LAS bf16x8*)(lds + PG8_SB(b, h) + boff + n * 2048 + k * 1024); } while (0)
#define PG8_MMA(ai, bj, At, Bt) do { __builtin_amdgcn_s_setprio(1); _Pragma("unroll") for (int m = 0; m < 4; ++m) _Pragma("unroll") for (int n = 0; n < 2; ++n) _Pragma("unroll") for (int k = 0; k < 2; ++k) \
        acc[ai][bj][m][n] = __builtin_amdgcn_mfma_f32_16x16x32_bf16(Bt[n][k], At[m][k], acc[ai][bj][m][n], 0, 0, 0); __builtin_amdgcn_s_setprio(0); } while (0)
#define PG8_WAIT_V(n) asm volatile("s_waitcnt vmcnt(" #n ")" ::: "memory")
#define PG8_WAIT_L(n) asm volatile("s_waitcnt lgkmcnt(" #n ")" ::: "memory")
#define PG8_BAR __builtin_amdgcn_s_barrier()
#define PG8_SCHED __builtin_amdgcn_sched_barrier(0)
    Unit cur, nxt; int ui = 0;
    if (!S.next(0, cur)) return;
    f32x4 acc[2][2][4][2];
#pragma unroll
    for (int a = 0; a < 2; ++a)
#pragma unroll
        for (int b = 0; b < 2; ++b)
#pragma unroll
            for (int m = 0; m < 4; ++m)
#pragma unroll
                for (int n = 0; n < 2; ++n) acc[a][b][m][n] = (f32x4){0.f, 0.f, 0.f, 0.f};
    bf16x8 At[4][2], B0[2][2], B1[2][2];
    const char* cA = (const char*)g.A + (size_t)cur.pm * tstepA; const char* cB = (const char*)g.Bt + (size_t)cur.pn * tstepB;
    S.a_ready(cur);
    if constexpr (SP2) {
        PG8_STAGE(PG8_SB(0, 0), cB, voffB); PG8_STAGE(PG8_SB(0, 1), cB + hstepB, voffB); PG8_STAGE(PG8_SA(0, 0), cA, voffA); PG8_STAGE(PG8_SA(0, 1), cA + hstepA, voffA);
        if (wr == 1) PG8_BAR;
        PG8_WAIT_V(2); PG8_BAR;
        PG8_STAGE(PG8_SB(1, 0), cB + kstep, voffB); PG8_STAGE(PG8_SA(1, 0), cA + kstep, voffA); PG8_STAGE(PG8_SB(1, 1), cB + hstepB + kstep, voffB);
        PG8_WAIT_V(6); PG8_BAR;
    } else {
        PG8_STAGE(PG8_SB(0, 0), cB, voffB); PG8_STAGE(PG8_SA(0, 0), cA, voffA); PG8_STAGE(PG8_SB(0, 1), cB + hstepB, voffB); PG8_STAGE(PG8_SA(0, 1), cA + hstepA, voffA);
        if (wr == 1) PG8_BAR;
        PG8_WAIT_V(4); PG8_BAR;
        PG8_STAGE(PG8_SB(1, 0), cB + kstep, voffB); PG8_STAGE(PG8_SA(1, 0), cA + kstep, voffA); PG8_STAGE(PG8_SB(1, 1), cB + hstepB + kstep, voffB);
        PG8_WAIT_V(6); PG8_BAR;
    }
    for (;;) {
        const bool has_next = S.next(ui + 1, nxt);
        const char* nA = has_next ? (const char*)g.A + (size_t)nxt.pm * tstepA : cA; const char* nB = has_next ? (const char*)g.Bt + (size_t)nxt.pn * tstepB : cB;
        for (int t = 0; t < nt; t += 2) {
            const bool last = (t == nt - 2);
            const char* a1 = cA + PG8_AK(t + 1);
            const char* a2 = last ? nA : cA + PG8_AK(t + 2); const char* b2 = last ? nB : cB + (size_t)(t + 2) * kstep;
            const char* a3 = a2 + kstep; const char* b3 = b2 + kstep;
            if (last && has_next) S.a_ready(nxt);
            if constexpr (SP2) {
            PG8_LDB(B0, 0, 0); PG8_LDB(B1, 0, 1); PG8_SCHED; PG8_LDA(At, 0, 0); PG8_STAGE(PG8_SA(1, 1), a1 + hstepA, voffA);
            PG8_WAIT_V(8); PG8_WAIT_L(0); PG8_BAR; PG8_MMA(0, 0, At, B0); PG8_MMA(0, 1, At, B1); PG8_BAR; PG8_SCHED;
            PG8_LDA(At, 0, 1); PG8_STAGE(PG8_SB(0, 0), b2, voffB); PG8_STAGE(PG8_SB(0, 1), b2 + hstepB, voffB); PG8_STAGE(PG8_SA(0, 0), a2, voffA);
            PG8_WAIT_V(8); PG8_WAIT_L(0); PG8_BAR; PG8_MMA(1, 0, At, B0); PG8_MMA(1, 1, At, B1); PG8_BAR; PG8_SCHED;
            PG8_LDB(B0, 1, 0); PG8_LDB(B1, 1, 1); PG8_SCHED; PG8_LDA(At, 1, 0); PG8_STAGE(PG8_SA(0, 1), a2 + hstepA, voffA);
            PG8_WAIT_V(8); PG8_WAIT_L(0); PG8_BAR; PG8_MMA(0, 0, At, B0); PG8_MMA(0, 1, At, B1); PG8_BAR; PG8_SCHED;
            PG8_LDA(At, 1, 1); PG8_STAGE(PG8_SB(1, 0), b3, voffB); PG8_STAGE(PG8_SB(1, 1), b3 + hstepB, voffB); PG8_STAGE(PG8_SA(1, 0), a3, voffA);
            PG8_WAIT_V(8); PG8_WAIT_L(0); PG8_BAR; PG8_MMA(1, 0, At, B0); PG8_MMA(1, 1, At, B1); PG8_BAR; PG8_SCHED;
            } else {
            PG8_LDB(B0, 0, 0); PG8_SCHED; PG8_LDA(At, 0, 0); PG8_STAGE(PG8_SA(1, 1), a1 + hstepA, voffA);
            PG8_WAIT_L(8); PG8_BAR; PG8_WAIT_L(0); PG8_MMA(0, 0, At, B0); PG8_BAR; PG8_SCHED;
            PG8_LDB(B1, 0, 1); PG8_STAGE(PG8_SB(0, 0), b2, voffB);
            PG8_BAR; PG8_WAIT_L(0); PG8_MMA(0, 1, At, B1); PG8_BAR;
            PG8_LDA(At, 0, 1); PG8_STAGE(PG8_SA(0, 0), a2, voffA);
            PG8_BAR; PG8_WAIT_L(0); PG8_MMA(1, 0, At, B0); PG8_BAR; PG8_SCHED;
            PG8_STAGE(PG8_SB(0, 1), b2 + hstepB, voffB);
            PG8_WAIT_V(6); PG8_BAR; PG8_MMA(1, 1, At, B1); PG8_BAR;
            PG8_LDB(B0, 1, 0); PG8_SCHED; PG8_LDA(At, 1, 0); PG8_STAGE(PG8_SA(0, 1), a2 + hstepA, voffA);
            PG8_WAIT_L(8); PG8_BAR; PG8_WAIT_L(0); PG8_MMA(0, 0, At, B0); PG8_BAR; PG8_SCHED;
            PG8_LDB(B1, 1, 1); PG8_STAGE(PG8_SB(1, 0), b3, voffB);
            PG8_BAR; PG8_WAIT_L(0); PG8_MMA(0, 1, At, B1); PG8_BAR;
            PG8_LDA(At, 1, 1); PG8_STAGE(PG8_SA(1, 0), a3, voffA);
            PG8_BAR; PG8_WAIT_L(0); PG8_MMA(1, 0, At, B0); PG8_BAR; PG8_SCHED;
            PG8_STAGE(PG8_SB(1, 1), b3 + hstepB, voffB);
            PG8_WAIT_V(6); PG8_BAR; PG8_MMA(1, 1, At, B1); PG8_BAR;
            }
        }
        if constexpr (ALIGN_EPI) { if (wr == 0) PG8_BAR; }
        if constexpr (!Epi::AFTER_DRAIN) { int fr_ = fr, fq_ = fq; asm volatile("" : "+v"(fr_), "+v"(fq_));
            E(acc, cur, wr, wc, fr_, fq_); S.done(cur); }
        if (!has_next) break;
#pragma unroll
        for (int a = 0; a < 2; ++a)
#pragma unroll
            for (int b = 0; b < 2; ++b)
#pragma unroll
                for (int m = 0; m < 4; ++m)
#pragma unroll
                    for (int n = 0; n < 2; ++n) acc[a][b][m][n] = (f32x4){0.f, 0.f, 0.f, 0.f};
        cur = nxt; cA = nA; cB = nB; ++ui;
        if constexpr (ALIGN_EPI) { if (wr == 1) PG8_BAR; }
    }
    PG8_WAIT_V(0);
    if constexpr (!ALIGN_EPI) { if (wr == 0) PG8_BAR; }
    PG8_BAR;
    if constexpr (Epi::AFTER_DRAIN) { E.fused(acc, cur, wr, wc, fr, fq, lds, wid, lane); S.done(cur); }
#undef PG8_AK
#undef PG8_SA
#undef PG8_SB
#undef PG8_STAGE
#undef PG8_LDA
#undef PG8_LDB
#undef PG8_MMA
#undef PG8_WAIT_V
#undef PG8_WAIT_L
#undef PG8_BAR
#undef PG8_SCHED
}
}

#include <hip/hip_bf16.h>
#include <cmath>
namespace attn_body {
using bf16=__hip_bfloat16;
using bf16x8=__attribute__((ext_vector_type(8)))short;
using s16x4=__attribute__((ext_vector_type(4)))short;
using f32x16=__attribute__((ext_vector_type(16)))float;
using u32x4=__attribute__((ext_vector_type(4)))unsigned;
constexpr int D=64;
constexpr int NW=8,QBLK=32,QB=QBLK*NW,KVBLK=64;
constexpr int ATTN_UNIT_ROWS=QB;
__device__ __forceinline__ int crow(int r,int hi){return (r&3)+8*(r>>2)+4*hi;}
#define SBAR() __builtin_amdgcn_sched_barrier(0)
__device__ __forceinline__ void cmask(f32x16&p0,f32x16&p1,int jb,int qrel,int hi){
  const float NEG=-INFINITY; int kb=64*jb+4*hi;
  #pragma unroll
  for(int r=0;r<16;++r){int kv=kb+(r&3)+8*(r>>2); if(kv>qrel)p0[r]=NEG; if(kv+32>qrel)p1[r]=NEG;}
}

constexpr int NSLOT=3, SLOTB=8192;
constexpr int LDS_K=0, LDS_V=NSLOT*SLOTB, LDS_WS=2*NSLOT*SLOTB, LDS_OST=LDS_WS+NW*64*4, LDS_BYTES=LDS_OST+NW*4096;
constexpr float C2=0.125f*1.4426950408889634f;
__device__ __forceinline__ void glds16(const void*gsrc,unsigned lds_dst){unsigned keep;
  asm volatile("s_mov_b32 %0, m0\n\ts_mov_b32 m0, %2\n\ts_nop 0\n\tglobal_load_lds_dwordx4 %1, off\n\ts_mov_b32 m0, %0":"=&s"(keep):"v"(gsrc),"s"(lds_dst):"memory");}
__device__ __forceinline__ float max3f(float a,float b,float c){float r;asm("v_max3_f32 %0, %1, %2, %3":"=v"(r):"v"(a),"v"(b),"v"(c));return r;}
__device__ __forceinline__ float max2f(float a,float b){float r;asm("v_max_f32_e32 %0, %1, %2":"=v"(r):"v"(a),"v"(b));return r;}
__device__ __forceinline__ float fadd_s(float a,float b){float r;asm("v_add_f32_e32 %0, %1, %2":"=v"(r):"v"(a),"v"(b));return r;}
__device__ __forceinline__ float fsub_s(float a,float b){float r;asm("v_sub_f32_e32 %0, %1, %2":"=v"(r):"v"(a),"v"(b));return r;}
typedef float f32x2_t __attribute__((ext_vector_type(2))); typedef __bf16 bf16x2_t __attribute__((ext_vector_type(2)));
__device__ __forceinline__ unsigned cvtpk_s(float lo,float hi){f32x2_t v={lo,hi};bf16x2_t b=__builtin_convertvector(v,bf16x2_t);return __builtin_bit_cast(unsigned,b);}
#define WAIT_BAR(N) asm volatile("s_waitcnt vmcnt(" #N ") lgkmcnt(0)\n\ts_barrier":::"memory")

__device__ __forceinline__ void qkt(f32x16&p0,f32x16&p1,const char*Kslot,const bf16x8*qr,const f32x16&negm,int r32,int hi){
  const char*kb=Kslot+hi*1024+r32*16;
  #pragma unroll
  for(int d0=0;d0<4;++d0){
    const bf16x8 b0=*reinterpret_cast<const bf16x8*>(kb+d0*2048);
    const bf16x8 b1=*reinterpret_cast<const bf16x8*>(kb+d0*2048+512);
    if(d0==0){p0=__builtin_amdgcn_mfma_f32_32x32x16_bf16(b0,qr[0],negm,0,0,0);p1=__builtin_amdgcn_mfma_f32_32x32x16_bf16(b1,qr[0],negm,0,0,0);}
    else{p0=__builtin_amdgcn_mfma_f32_32x32x16_bf16(b0,qr[d0],p0,0,0,0);p1=__builtin_amdgcn_mfma_f32_32x32x16_bf16(b1,qr[d0],p1,0,0,0);}}
}
typedef __attribute__((address_space(3))) const char* lds_cptr;
typedef short v4i16_t __attribute__((ext_vector_type(4)));
__device__ __forceinline__ void kload8(bf16x8*kf,lds_cptr kp){
  kf[0]=*(const __attribute__((address_space(3))) bf16x8*)(kp);      kf[1]=*(const __attribute__((address_space(3))) bf16x8*)(kp+512);
  kf[2]=*(const __attribute__((address_space(3))) bf16x8*)(kp+2048); kf[3]=*(const __attribute__((address_space(3))) bf16x8*)(kp+2560);
  kf[4]=*(const __attribute__((address_space(3))) bf16x8*)(kp+4096); kf[5]=*(const __attribute__((address_space(3))) bf16x8*)(kp+4608);
  kf[6]=*(const __attribute__((address_space(3))) bf16x8*)(kp+6144); kf[7]=*(const __attribute__((address_space(3))) bf16x8*)(kp+6656);
}
__device__ __forceinline__ void kload2(bf16x8*kf,lds_cptr kp,int j){ kf[2*j]=*(const __attribute__((address_space(3))) bf16x8*)(kp+j*2048); kf[2*j+1]=*(const __attribute__((address_space(3))) bf16x8*)(kp+j*2048+512); }
__device__ __forceinline__ s16x4 vtr(lds_cptr p){ return __builtin_bit_cast(s16x4,__builtin_amdgcn_ds_read_tr16_b64_v4i16((__attribute__((address_space(3))) v4i16_t*)p)); }
__device__ __forceinline__ float rowmax(const f32x16&p0,const f32x16&p1){
  float a=max3f(p0[0],p0[1],p1[0]),b=max3f(p0[2],p0[3],p1[1]);a=max3f(a,p1[2],p1[3]);
  #pragma unroll
  for(int r=4;r<16;r+=4){a=max3f(a,p0[r],p0[r+1]);b=max3f(b,p0[r+2],p0[r+3]);a=max3f(a,p1[r],p1[r+1]);b=max3f(b,p1[r+2],p1[r+3]);}
  const float m=max2f(a,b);
  auto rr=__builtin_amdgcn_permlane32_swap(__float_as_uint(m),__float_as_uint(m),false,false);
  return max2f(__uint_as_float(rr[0]),__uint_as_float(rr[1]));
}
__device__ __forceinline__ void pv(f32x16*o,int vb,bf16x8 pa0,bf16x8 pa1,bf16x8 pa2,bf16x8 pa3){
  #pragma unroll
  for(int d0=0;d0<2;++d0){s16x4 lo[4],hi[4];
    #pragma unroll
    for(int ks=0;ks<4;++ks){
      asm volatile("ds_read_b64_tr_b16 %0,%1 offset:%c2":"=&v"(lo[ks]):"v"(vb),"i"(d0*4096+ks*1024):"memory");
      asm volatile("ds_read_b64_tr_b16 %0,%1 offset:%c2":"=&v"(hi[ks]):"v"(vb),"i"(d0*4096+ks*1024+512):"memory");}
    asm volatile("s_waitcnt lgkmcnt(0)":::"memory");SBAR();
    #define PK(k) (bf16x8){lo[k][0],lo[k][1],lo[k][2],lo[k][3],hi[k][0],hi[k][1],hi[k][2],hi[k][3]}
    o[d0]=__builtin_amdgcn_mfma_f32_32x32x16_bf16(pa0,PK(0),o[d0],0,0,0);
    o[d0]=__builtin_amdgcn_mfma_f32_32x32x16_bf16(pa1,PK(1),o[d0],0,0,0);
    o[d0]=__builtin_amdgcn_mfma_f32_32x32x16_bf16(pa2,PK(2),o[d0],0,0,0);
    o[d0]=__builtin_amdgcn_mfma_f32_32x32x16_bf16(pa3,PK(3),o[d0],0,0,0);
    #undef PK
  }
}

#ifndef ATTN_STORE16
#define ATTN_STORE16(p,v) (*(u32x4*)(p)=(v))
#endif
template<int THRL> __device__ __forceinline__ void attn_unit(const bf16*Q0,const int QP,const bf16*__restrict__ Kh,const bf16*__restrict__ Vh,const int KP,bf16*O0,const int OP,const int NT,char*shm,const int tid){
  const int lane=tid&63,r32=lane&31,hi=lane>>5; const int wid=__builtin_amdgcn_readfirstlane(tid>>6);
  const bf16*Qw=Q0+(long)(wid*QBLK)*QP;
  const unsigned lds0=(unsigned)(uintptr_t)shm;
  float*wsf=(float*)(shm+LDS_WS)+wid*64;
  const bf16*ksrc=Kh+(long)lane*KP+wid*8;
  const bf16*vsrc=Vh+(long)(16*(wid&3)+(lane>>2))*KP+(wid>>2)*32+(lane&3)*8;
  const unsigned kdst=lds0+LDS_K+wid*1024, vdst=lds0+LDS_V+wid*1024;
  #define DMA_K(t,slot) glds16(ksrc+(long)(t)*KVBLK*KP,(unsigned)__builtin_amdgcn_readfirstlane(kdst+(slot)))
  #define DMA_V(t,slot) glds16(vsrc+(long)(t)*KVBLK*KP,(unsigned)__builtin_amdgcn_readfirstlane(vdst+(slot)))
  const int vb0=(int)(lds0+LDS_V)+((lane>>4)&1)*32+(lane&3)*8+(4*hi+((lane&15)>>2))*64;
  const char*Kbase=shm+LDS_K; bf16x8 kf[8];
  const lds_cptr shm3=(lds_cptr)shm; const lds_cptr kp0=shm3+LDS_K+hi*1024+r32*16; const lds_cptr vp0=shm3+LDS_V+((lane>>4)&1)*32+(lane&3)*8+(4*hi+((lane&15)>>2))*64;
  DMA_K(0,0);DMA_V(0,0);DMA_K(1,SLOTB);
  bf16x8 qr[4];
  #pragma unroll
  for(int d0=0;d0<4;++d0)qr[d0]=*reinterpret_cast<const bf16x8*>(&Qw[(long)r32*QP+d0*16+hi*8]);
  float mhat=0.f,l_reg=0.f;f32x16 o[2];o[0]=f32x16{};o[1]=f32x16{};f32x16 negm=f32x16{};asm volatile("":"+v"(negm));
  #define CMASK(P0,P1,t) do{}while(0)
  bool resc=false;
  #define START(P0,P1) do{ const float rm=rowmax(P0,P1); resc=false; \
    { const float dl=rm; mhat=fadd_s(mhat,dl); \
      _Pragma("unroll") for(int r=0;r<16;++r){P0[r]=fsub_s(P0[r],dl);P1[r]=fsub_s(P1[r],dl);} \
      _Pragma("unroll") for(int r=0;r<16;++r)negm[r]=-mhat; asm volatile("":"+v"(negm)); } \
    _Pragma("unroll") for(int r=0;r<16;++r)P0[r]=__builtin_amdgcn_exp2f(P0[r]); }while(0)
  #define RESC() do{ if(resc){ asm volatile("s_waitcnt lgkmcnt(0)":::"memory"); \
      _Pragma("unroll") for(int d_=0;d_<2;++d_) _Pragma("unroll") for(int r=0;r<16;++r)o[d_][r]*=wsf[crow(r,hi)]; } }while(0)
  f32x16 pA0,pA1,pB0,pB1;
  int sl_prev=0,sl_cur=0,sl_next=SLOTB;
  #define ROT() do{sl_prev=sl_cur;sl_cur=sl_next;sl_next=(sl_next==(NSLOT-1)*SLOTB)?0:sl_next+SLOTB;}while(0)
  DMA_K(2,2*SLOTB);
  WAIT_BAR(3);
  qkt(pA0,pA1,Kbase,qr,negm,r32,hi);asm volatile("s_nop 15\n\ts_nop 7":"+v"(pA0),"+v"(pA1));CMASK(pA0,pA1,0);
  START(pA0,pA1);
  _Pragma("unroll") for(int r=0;r<16;++r)pA1[r]=__builtin_amdgcn_exp2f(pA1[r]);
  WAIT_BAR(0);
  DMA_K(3,0);DMA_V(1,SLOTB);
  ROT();
  kload8(kf,kp0+sl_cur);
  WAIT_BAR(2);
  s16x4 vlo[8],vhi[8]; u32x4 pw0,pw1,pw2,pw3;
  #define PKW(P,B) cvtpk_s(P[B],P[B+1])
  #define PAF(k) __builtin_bit_cast(bf16x8,pw##k)
  #define VFR(i) (bf16x8){vlo[i][0],vlo[i][1],vlo[i][2],vlo[i][3],vhi[i][0],vhi[i][1],vhi[i][2],vhi[i][3]}
  #define PIN(x) asm volatile("":"+v"(x))
  #define MX3(a,b,c) __builtin_fmaxf(__builtin_fmaxf((a),(b)),(c))
  #define GAPA(MF,A0,A1,A2,A3,W0,W1,PW) do{ MF; sacc+=A0; sacc+=A1; sacc+=A2; sacc+=A3; PIN(sacc); W0; W1; PIN(PW); SBAR(); }while(0)
  #define EX(v) __builtin_amdgcn_exp2f(v)
  #define GAPB(MF,X,B) do{ MF; X[B]=EX(X[B]); X[B+1]=EX(X[B+1]); X[B+2]=EX(X[B+2]); X[B+3]=EX(X[B+3]); PIN(X); SBAR(); }while(0)
  #define VRD(i) do{ vlo[i]=vtr(vp_+(((i)>>2)*4096+((i)&3)*1024)); vhi[i]=vtr(vp_+(((i)>>2)*4096+((i)&3)*1024+512)); }while(0)
  #define KRD(G,j) do{ if(G){ kload2(kf,kp0+sl_next,j); SBAR(); } }while(0)
  #define STEP(C0,C1,P0,P1,t,GK,GV,GL) do{ SBAR(); \
    const lds_cptr vp_=vp0+sl_prev; \
    VRD(0); SBAR(); float sacc=(P0[0]+P0[1]); \
    GAPA(C0=__builtin_amdgcn_mfma_f32_32x32x16_bf16(kf[0],qr[0],negm,0,0,0), P0[2],P0[3],P0[4],P0[5],     pw0[0]=PKW(P0,0), pw0[1]=PKW(P0,2), pw0); \
    VRD(4); SBAR(); GAPA(C1=__builtin_amdgcn_mfma_f32_32x32x16_bf16(kf[1],qr[0],negm,0,0,0), P0[6],P0[7],P0[8],P0[9],     pw0[2]=PKW(P0,4), pw0[3]=PKW(P0,6), pw0); \
    VRD(1); SBAR(); GAPA(C0=__builtin_amdgcn_mfma_f32_32x32x16_bf16(kf[2],qr[1],C0,0,0,0),   P0[10],P0[11],P0[12],P0[13], pw1[0]=PKW(P0,8), pw1[1]=PKW(P0,10), pw1); \
    VRD(5); SBAR(); GAPA(C1=__builtin_amdgcn_mfma_f32_32x32x16_bf16(kf[3],qr[1],C1,0,0,0),   P0[14],P0[15],P1[0],P1[1],   pw1[2]=PKW(P0,12),pw1[3]=PKW(P0,14), pw1); \
    VRD(2); SBAR(); GAPA(C0=__builtin_amdgcn_mfma_f32_32x32x16_bf16(kf[4],qr[2],C0,0,0,0),   P1[2],P1[3],P1[4],P1[5],     pw2[0]=PKW(P1,0), pw2[1]=PKW(P1,2), pw2); \
    VRD(6); SBAR(); GAPA(C1=__builtin_amdgcn_mfma_f32_32x32x16_bf16(kf[5],qr[2],C1,0,0,0),   P1[6],P1[7],P1[8],P1[9],     pw2[2]=PKW(P1,4), pw2[3]=PKW(P1,6), pw2); \
    VRD(3); SBAR(); GAPA(C0=__builtin_amdgcn_mfma_f32_32x32x16_bf16(kf[6],qr[3],C0,0,0,0),   P1[10],P1[11],P1[12],P1[13], pw3[0]=PKW(P1,8), pw3[1]=PKW(P1,10), pw3); \
    VRD(7); SBAR(); GAPA(C1=__builtin_amdgcn_mfma_f32_32x32x16_bf16(kf[7],qr[3],C1,0,0,0),   P1[14],P1[15],0.f,0.f,       pw3[2]=PKW(P1,12),pw3[3]=PKW(P1,14), pw3); \
    l_reg+=sacc; \
    if(GK){DMA_K((t)+3,sl_cur);} if(GV){DMA_V((t)+1,sl_next);} \
    CMASK(C0,C1,t); \
    { float a=MX3(C0[0],C0[1],C1[0]),b=MX3(C0[2],C0[3],C1[1]); a=MX3(a,C1[2],C1[3]); \
      _Pragma("unroll") for(int r=4;r<16;r+=4){a=MX3(a,C0[r],C0[r+1]);b=MX3(b,C0[r+2],C0[r+3]);a=MX3(a,C1[r],C1[r+1]);b=MX3(b,C1[r+2],C1[r+3]);} \
      float rm=__builtin_fmaxf(a,b); { auto rr=__builtin_amdgcn_permlane32_swap(__float_as_uint(rm),__float_as_uint(rm),false,false); rm=__builtin_fmaxf(__uint_as_float(rr[0]),__uint_as_float(rr[1])); } \
      resc=false; \
      if(__builtin_expect(__any(rm>(float)THRL),0)){ const float dl=__builtin_fmaxf(rm,0.f); mhat+=dl; \
        _Pragma("unroll") for(int r=0;r<16;++r){C0[r]-=dl;C1[r]-=dl;} \
        _Pragma("unroll") for(int r=0;r<16;++r)negm[r]=-mhat; asm volatile("":"+v"(negm)); \
        const float f=__builtin_amdgcn_exp2f(-dl); l_reg*=f; if(hi==0)wsf[r32]=f; resc=true; } } \
    SBAR(); \
    GAPB(o[0]=__builtin_amdgcn_mfma_f32_32x32x16_bf16(PAF(0),VFR(0),o[0],0,0,0), C0,0); \
    GAPB(o[1]=__builtin_amdgcn_mfma_f32_32x32x16_bf16(PAF(0),VFR(4),o[1],0,0,0), C0,4); \
    KRD(GL,0); GAPB(o[0]=__builtin_amdgcn_mfma_f32_32x32x16_bf16(PAF(1),VFR(1),o[0],0,0,0), C0,8); \
    KRD(GL,1); GAPB(o[1]=__builtin_amdgcn_mfma_f32_32x32x16_bf16(PAF(1),VFR(5),o[1],0,0,0), C0,12); \
    KRD(GL,2); GAPB(o[0]=__builtin_amdgcn_mfma_f32_32x32x16_bf16(PAF(2),VFR(2),o[0],0,0,0), C1,0); \
    KRD(GL,3); GAPB(o[1]=__builtin_amdgcn_mfma_f32_32x32x16_bf16(PAF(2),VFR(6),o[1],0,0,0), C1,4); \
    GAPB(o[0]=__builtin_amdgcn_mfma_f32_32x32x16_bf16(PAF(3),VFR(3),o[0],0,0,0), C1,8); \
    GAPB(o[1]=__builtin_amdgcn_mfma_f32_32x32x16_bf16(PAF(3),VFR(7),o[1],0,0,0), C1,12); \
    }while(0)
  int t=1;
  #undef CMASK
  #define CMASK(P0,P1,t) do{}while(0)
  for(;t+5<NT;t+=2){
    STEP(pB0,pB1,pA0,pA1,t,true,true,true);     WAIT_BAR(2); RESC(); ROT();
    STEP(pA0,pA1,pB0,pB1,t+1,true,true,true);   WAIT_BAR(2); RESC(); ROT();
  }
  #undef CMASK
  #define CMASK(P0,P1,t) do{}while(0)
  #define ENDW(tt) do{ if((tt)+3<NT){WAIT_BAR(2);} else if((tt)+2<NT){WAIT_BAR(1);} else {WAIT_BAR(0);} }while(0)
  for(;t+1<NT;t+=2){
    STEP(pB0,pB1,pA0,pA1,t,(t+3<NT),(t+1<NT),(t+1<NT));       ENDW(t);   RESC(); ROT();
    STEP(pA0,pA1,pB0,pB1,t+1,(t+4<NT),(t+2<NT),(t+2<NT));     ENDW(t+1); RESC(); ROT();
  }
  STEP(pB0,pB1,pA0,pA1,NT-1,false,false,false); RESC();
  { float sacc=pB0[0]+pB0[1]; _Pragma("unroll") for(int r=2;r<16;++r)sacc+=pB0[r]; _Pragma("unroll") for(int r=0;r<16;++r)sacc+=pB1[r]; l_reg+=sacc;
    pw0=(u32x4){PKW(pB0,0),PKW(pB0,2),PKW(pB0,4),PKW(pB0,6)};pw1=(u32x4){PKW(pB0,8),PKW(pB0,10),PKW(pB0,12),PKW(pB0,14)};pw2=(u32x4){PKW(pB1,0),PKW(pB1,2),PKW(pB1,4),PKW(pB1,6)};pw3=(u32x4){PKW(pB1,8),PKW(pB1,10),PKW(pB1,12),PKW(pB1,14)};
    SBAR(); pv(o,vb0+sl_cur,PAF(0),PAF(1),PAF(2),PAF(3)); }
  #undef PKW
  #undef PAF
  #undef VFR
  #undef PIN
  #undef MX3
  #undef GAPA
  #undef GAPB
  #undef EX
  #undef VRD
  #undef KRD
  #undef STEP
  #undef ENDW
  {auto rr=__builtin_amdgcn_permlane32_swap(__float_as_uint(l_reg),__float_as_uint(l_reg),false,false);l_reg=__uint_as_float(rr[0])+__uint_as_float(rr[1]);}
  if(hi==0)wsf[32+r32]=l_reg;asm volatile("s_waitcnt lgkmcnt(0)":::"memory");
  float rli[16];
  #pragma unroll
  for(int r=0;r<16;++r)rli[r]=__builtin_amdgcn_rcpf(wsf[32+crow(r,hi)]);
  bf16*Ow=O0+(long)(wid*QBLK)*OP;
  { bf16*stg=(bf16*)(shm+LDS_OST)+wid*2048;
    #pragma unroll
    for(int r=0;r<16;++r){const int orow=crow(r,hi);
      #pragma unroll
      for(int d0=0;d0<2;++d0)stg[orow*64+d0*32+r32]=__float2bfloat16(o[d0][r]*rli[r]);}
    asm volatile("s_waitcnt lgkmcnt(0)":::"memory");
    #pragma unroll
    for(int i=0;i<4;++i){const int row=i*8+(lane>>3),ch=lane&7; const u32x4 v=*(const u32x4*)(stg+row*64+ch*8); ATTN_STORE16(Ow+(long)row*OP+ch*8,v);} }
  asm volatile("s_waitcnt lgkmcnt(0)\n\ts_barrier":::"memory");
  #undef DMA_K
  #undef DMA_V
  #undef CMASK
  #undef START
  #undef RESC
  #undef ROT
}
constexpr int ATTN_LDS_BYTES=LDS_BYTES;
#undef SBAR
#undef WAIT_BAR
}

#define GAS __attribute__((address_space(1)))
#define LAS __attribute__((address_space(3)))
typedef unsigned short bf16;
typedef unsigned v4u __attribute__((ext_vector_type(4)));
typedef float f32x4 __attribute__((ext_vector_type(4)));
typedef short bf16x8 __attribute__((ext_vector_type(8)));
typedef GAS unsigned gu32;
typedef GAS unsigned long long gu64;
#define RLX_AGENT __ATOMIC_RELAXED, __HIP_MEMORY_SCOPE_AGENT
#define LDS_WAIT() asm volatile("s_waitcnt lgkmcnt(0)" ::: "memory")
#define VM_WAIT() asm volatile("s_waitcnt vmcnt(0)" ::: "memory")
__device__ __forceinline__ unsigned long long rt() { return __builtin_amdgcn_s_memrealtime(); }
__device__ __forceinline__ unsigned f2bf(float f) { unsigned u = __builtin_bit_cast(unsigned, f); return (u + 0x7fffu + ((u >> 16) & 1u)) >> 16; }
__device__ __forceinline__ unsigned pk2(float lo, float hi) { return f2bf(lo) | (f2bf(hi) << 16); }

#define XB_TMO      128
#define XB_XCNT(j)  (256  + 64 * (j))
#define XB_XSUB(j)  (1280 + 64 * (j))
#define XB_XGEN(j)  (2304 + 64 * (j))
#define XB_TOP      3328
#define XB_TOPGEN   3392
#define XCD_BAR_WORDS 3456
#define XB_SPIN_CAP (1u << 18)

__device__ __forceinline__ unsigned xb_ld(unsigned* p)              { return __hip_atomic_load(p, __ATOMIC_RELAXED, __HIP_MEMORY_SCOPE_AGENT); }
__device__ __forceinline__ unsigned xb_add(unsigned* p, unsigned v) { return __hip_atomic_fetch_add(p, v, __ATOMIC_RELAXED, __HIP_MEMORY_SCOPE_AGENT); }
__device__ __forceinline__ unsigned xb_xcc_id() { return (unsigned)__builtin_amdgcn_s_getreg((3 << 11) | 20) & 0xFu; }
#define XB_SPIN(cond, bar) do { unsigned _sp = 0; while (cond) { __builtin_amdgcn_s_sleep(1); \
    if ((++_sp & 255u) == 0u) { if (xb_ld(&(bar)[XB_TMO])) break; if (_sp > XB_SPIN_CAP) { atomicAdd(&(bar)[XB_TMO], 1u); break; } } } } while (0)

struct XcdBarrier {
    unsigned* bar; unsigned x;
    volatile LAS unsigned* st;
};

__device__ __forceinline__ XcdBarrier xcd_barrier_post(unsigned* bar, volatile LAS unsigned* st) {
    XcdBarrier b; b.bar = bar; b.x = xb_xcc_id(); b.st = st;
    if (threadIdx.x == 0) (void)xb_add(&bar[XB_XCNT(b.x)], 1u);
    return b;
}
__device__ __forceinline__ void xcd_barrier_complete(unsigned* bar, unsigned x, unsigned& nloc, unsigned& nx) {
    const unsigned G = gridDim.x * gridDim.y * gridDim.z;
    unsigned sum, cnt, mine, sp = 0u;
    for (;;) {
        sum = 0u; cnt = 0u; mine = 0u;
#pragma unroll
        for (unsigned j = 0; j < 16; ++j) { const unsigned c = xb_ld(&bar[XB_XCNT(j)]); sum += c; cnt += (c > 0u) ? 1u : 0u; mine = (j == x) ? c : mine; }
        if (sum == G) break;
        __builtin_amdgcn_s_sleep(1);
        if ((++sp & 255u) == 0u) { if (xb_ld(&bar[XB_TMO])) break; if (sp > XB_SPIN_CAP) { atomicAdd(&bar[XB_TMO], 1u); break; } }
    }
    nloc = mine > 0u ? mine : 1u; nx = cnt > 0u ? cnt : 1u;
}

__device__ __forceinline__ void xcd_barrier(const XcdBarrier& b) {
    asm volatile("s_waitcnt vmcnt(0)" ::: "memory");
    __syncthreads();
    if (threadIdx.x == 0) {
        unsigned* bar = b.bar;
        __builtin_amdgcn_s_waitcnt(0);
        unsigned nloc = b.st[0], nx = b.st[1];
        if (nloc == 0u) { xcd_barrier_complete(bar, b.x, nloc, nx); b.st[0] = nloc; b.st[1] = nx; }
        const unsigned old = xb_add(&bar[XB_XSUB(b.x)], 1u);
        const unsigned gen = old / nloc;
        if (old + 1u == (gen + 1u) * nloc) {
            __builtin_amdgcn_fence(__ATOMIC_RELEASE, "agent");
            asm volatile("s_waitcnt vmcnt(0)" ::: "memory");
            const unsigned og = xb_add(&bar[XB_TOP], 1u);
            const unsigned tg = og / nx;
            if (og + 1u == (tg + 1u) * nx) xb_add(&bar[XB_TOPGEN], 1u);
            else XB_SPIN(xb_ld(&bar[XB_TOPGEN]) == tg, bar);
            __builtin_amdgcn_fence(__ATOMIC_ACQUIRE, "agent");
            xb_add(&bar[XB_XGEN(b.x)], 1u);
            asm volatile("s_waitcnt vmcnt(0)" ::: "memory");
        } else {
            XB_SPIN(xb_ld(&bar[XB_XGEN(b.x)]) == gen, bar);
            __builtin_amdgcn_fence(__ATOMIC_ACQUIRE, "agent");
            asm volatile("s_waitcnt vmcnt(0)" ::: "memory");
        }
    }
    __syncthreads();
}

constexpr int NWAVES = 8;
#ifndef EN
#define EN 0xFFFF
#endif
#define ENB(b) ((EN >> (b)) & 1)
#ifndef PROBE_REP
#define PROBE_REP (-1)
#endif
#ifndef PROBE_NREP
#define PROBE_NREP 1
#endif
#ifndef PROBE_XBAR
#define PROBE_XBAR 0
#endif
#ifndef PROBE_MIXSEL
#define PROBE_MIXSEL 7
#endif
constexpr int DM = 1024, NPROMPT = 4096, NSAMPLE = 8192, MTOK = 12288, DFF = 2816, NGU = 5632;
constexpr float EPS = 1e-6f;
constexpr float QSCALE = 0.125f * 1.4426950408889634f;
typedef unsigned u32x2 __attribute__((ext_vector_type(2)));

constexpr size_t OUT_Y = 0;
constexpr size_t OUT_K = 12582912, OUT_V = 13631488, OUT_S5RE = 14680064, OUT_S5IM = 14745600, OUT_MC = 14811136, OUT_MN = 15859712, OUT_MM = 15876096;

constexpr size_t MiB = 1u << 20;
constexpr size_t WS_CTL = 0, CTL_ZERO_BYTES = 1 * MiB;
constexpr size_t WS_MOD = 1 * MiB;
constexpr size_t WS_ROPE = 1 * MiB + 512 * 1024;
constexpr size_t WS_S5W1 = 2 * MiB;
constexpr size_t WS_S5W2 = 10 * MiB;
constexpr size_t WS_S5A16 = 14 * MiB;
constexpr size_t WS_GLUT = 15 * MiB;
constexpr size_t WS_WGT = 15 * MiB + 512 * 1024;
constexpr size_t WS_WIN = 16 * MiB;
constexpr size_t WS_WOUT = 24 * MiB;
constexpr size_t WS_WGU = 28 * MiB;
constexpr size_t WS_WDN = 50 * MiB;
constexpr size_t WS_GATES = 61 * MiB;
constexpr size_t WS_H = 62 * MiB;
constexpr size_t WS_BIG = 86 * MiB;
constexpr size_t WS_Q = 86 * MiB;
constexpr size_t WS_KP = 98 * MiB, WS_KS = 99 * MiB, WS_VP = 102 * MiB, WS_VS = 103 * MiB;
constexpr size_t WS_SU = 106 * MiB, WS_MQ = 112 * MiB, WS_MK = 118 * MiB, WS_MV = 124 * MiB, WS_MO = 130 * MiB;
constexpr size_t WS_MIX = 136 * MiB;
constexpr size_t WS_Y5 = 160 * MiB;
constexpr size_t WS_HF = 172 * MiB, WS_HB = 184 * MiB;
constexpr size_t WS_END = 256 * MiB;
static_assert(WS_BIG + (size_t)MTOK * NGU * 2 <= WS_END && WS_HB + (size_t)MTOK * 256 * 4 <= WS_BIG + (size_t)MTOK * NGU * 2, "d_ws map");

constexpr int CW_BAR = 4096;
constexpr int CW_QUEUE = 16384;

constexpr int RING_BYTES = 131072, LDSCTL_OFF = RING_BYTES, MISC_OFF = LDSCTL_OFF + 320, LDS_BYTES = 147456;

struct Args { const float* in[36]; float* out; unsigned char* ws; int ph_lo, ph_hi; };
struct Ctx { float* out; unsigned char* ws; const LAS unsigned long long* tbl; int bid; };
__device__ __forceinline__ const float* inp(const Ctx& a, int i) { const unsigned long long v = a.tbl[i];
    const unsigned lo = __builtin_amdgcn_readfirstlane((unsigned)v), hi = __builtin_amdgcn_readfirstlane((unsigned)(v >> 32)); return (const float*)(((unsigned long long)hi << 32) | lo); }
enum { I_XP = 0, I_XS, I_C, I_CK, I_CV, I_S5RE, I_S5IM, I_MC, I_MN, I_MM, I_CCTX, I_ADAW, I_ADAB, I_N1G, I_N2G, I_WIN, I_QG, I_KG,
       I_ARE, I_AIM, I_LDT, I_BRE, I_BIM, I_CRE, I_CIM, I_S5D, I_GLUW, I_GLUB, I_MGB, I_MNG, I_WOUT, I_WG, I_WU, I_CW, I_CB, I_WD };

__device__ __forceinline__ float bf2f(unsigned short x) { return __uint_as_float(((unsigned)x) << 16); }
__device__ __forceinline__ float wave_sum(float v) {
#pragma unroll
    for (int o = 1; o < 64; o <<= 1) v += __shfl_xor(v, o);
    return v;
}
__device__ __forceinline__ float sigmoidf_(float x) { return 1.0f / (1.0f + __expf(-x)); }
__device__ __forceinline__ int bc_of_row(int r) { return r < NPROMPT ? 0 : 1 + ((r - NPROMPT) >> 10); }

__device__ __forceinline__ void p0_transpose_item(const float* W, int K, int ldn, int k0, int n0, bf16* WT, int drow0, LAS float* scr, int lane) {
#pragma unroll 8
    for (int i = 0; i < 32; ++i) { const int kk = 2 * i + (lane >> 5); scr[kk * 33 + (lane & 31)] = W[(size_t)(k0 + kk) * ldn + n0 + (lane & 31)]; }
    LDS_WAIT(); asm volatile("" ::: "memory");
    const int c = lane & 7;
#pragma unroll
    for (int j = 0; j < 4; ++j) { const int n = (lane >> 3) + 8 * j; const LAS float* s = scr + (8 * c) * 33 + n;
        v4u o; o.x = pk2(s[0 * 33], s[1 * 33]); o.y = pk2(s[2 * 33], s[3 * 33]); o.z = pk2(s[4 * 33], s[5 * 33]); o.w = pk2(s[6 * 33], s[7 * 33]);
        *(GAS v4u*)(WT + (size_t)(drow0 + n) * K + k0 + 8 * c) = o; }
    LDS_WAIT(); asm volatile("" ::: "memory");
}

__device__ __forceinline__ void p0_adaln_unit(const Ctx& a, int u, unsigned char* ldsg, int tid, int lane, int wave) {
    const int l = u / 96, n0 = (u % 96) * 64;
    float* sil = (float*)ldsg;
    float* red = sil + 9 * 1024;
    for (int i = tid; i < 9 * 1024; i += 512) { const int bc = i >> 10, k = i & 1023; const float c = (bc == 0) ? inp(a, I_CCTX)[k] : inp(a, I_C)[(bc - 1) * 1024 + k]; sil[i] = c * sigmoidf_(c); }
    __syncthreads();
    const float* W = inp(a, I_ADAW) + (size_t)l * 1024 * 6144 + n0 + lane;
    float acc[9];
#pragma unroll
    for (int bc = 0; bc < 9; ++bc) acc[bc] = 0.f;
    const int k0 = wave * 128;
#pragma unroll 8
    for (int k = k0; k < k0 + 128; ++k) { const float w = W[(size_t)k * 6144];
#pragma unroll
        for (int bc = 0; bc < 9; ++bc) acc[bc] += sil[bc * 1024 + k] * w; }
#pragma unroll
    for (int bc = 0; bc < 9; ++bc) red[(wave * 9 + bc) * 64 + lane] = acc[bc];
    __syncthreads();
    for (int i = tid; i < 9 * 64; i += 512) { const int bc = i >> 6, ln = i & 63; float s = inp(a, I_ADAB)[l * 6144 + n0 + ln];
#pragma unroll
        for (int w = 0; w < 8; ++w) s += red[(w * 9 + bc) * 64 + ln];
        ((float*)(a.ws + WS_MOD))[(size_t)(l * 9 + bc) * 6144 + n0 + ln] = s; }
    __syncthreads();
}

__device__ __forceinline__ void p0_s5_unit(const Ctx& a, int u, unsigned char* ldsg, int tid) {
    const int l = u >> 4, g = u & 15;
    float2* Pw = (float2*)ldsg;
    float2* Bb = Pw + 2 * 17 * 64;
    float2* Cc = Bb + 2 * 64 * 16;
    float* Kt = (float*)(Cc + 2 * 16 * 64);
    if (tid < 128) {
        const int d = tid >> 6, p = tid & 63; const int gi = (l * 2 + d) * 16 + g, idx = gi * 64 + p;
        const float are = inp(a, I_ARE)[idx], aim = inp(a, I_AIM)[idx], dt = expf(inp(a, I_LDT)[gi]);
        for (int t = 0; t <= 16; ++t) { const float mag = expf((float)t * dt * are), ang = (float)t * dt * aim; float sn, cs; sincosf(ang, &sn, &cs); Pw[(d * 17 + t) * 64 + p] = make_float2(mag * cs, mag * sn); }
        const float2 ab = Pw[(d * 17 + 1) * 64 + p], a16 = Pw[(d * 17 + 16) * 64 + p];
        ((float2*)(a.ws + WS_S5A16))[idx] = a16;
        const float nr = ab.x - 1.0f, ni = ab.y, den = are * are + aim * aim;
        const float fre = (nr * are + ni * aim) / den, fim = (ni * are - nr * aim) / den;
        for (int c = 0; c < 16; ++c) { const float bre = inp(a, I_BRE)[(size_t)idx * 16 + c], bim = inp(a, I_BIM)[(size_t)idx * 16 + c];
            Bb[(d * 64 + p) * 16 + c] = make_float2(fre * bre - fim * bim, fre * bim + fim * bre); }
    }
    for (int i = tid; i < 2048; i += 512) { const int d = i >> 10, c = (i >> 6) & 15, p = i & 63; const size_t s = ((size_t)((l * 2 + d) * 16 + g) * 16 + c) * 64 + p;
        Cc[i] = make_float2(inp(a, I_CRE)[s], inp(a, I_CIM)[s]); }
    __syncthreads();
    {
        const int d = tid >> 8, tau = (tid >> 4) & 15, c = tid & 15;
        float acc[16];
#pragma unroll
        for (int j = 0; j < 16; ++j) acc[j] = 0.f;
        for (int p = 0; p < 64; ++p) { const float2 cc = Cc[(d * 16 + c) * 64 + p], pw = Pw[(d * 17 + tau) * 64 + p];
            const float xr = cc.x * pw.x - cc.y * pw.y, xi = cc.x * pw.y + cc.y * pw.x;
#pragma unroll
            for (int j = 0; j < 16; ++j) { const float2 bb = Bb[(d * 64 + p) * 16 + j]; acc[j] += xr * bb.x - xi * bb.y; } }
#pragma unroll
        for (int j = 0; j < 16; ++j) Kt[((d * 16 + tau) * 16 + c) * 16 + j] = acc[j];
    }
    __syncthreads();
    bf16* W1 = (bf16*)(a.ws + WS_S5W1) + (size_t)u * 512 * 256;
    bf16* W2 = (bf16*)(a.ws + WS_S5W2) + (size_t)u * 256 * 256;
    const float* dsk = inp(a, I_S5D) + l * 256 + g * 16;
    for (int e = tid; e < 65536; e += 512) {
        const int row = e >> 8, col = e & 255, i = row >> 4, c = row & 15, j = col >> 4, c2 = col & 15;
        float v = 0.f;
        if (i >= j) v += Kt[((0 * 16 + (i - j)) * 16 + c) * 16 + c2];
        if (j >= i) v += Kt[((1 * 16 + (j - i)) * 16 + c) * 16 + c2];
        if (row == col) v += dsk[c];
        W1[e] = (bf16)f2bf(v);
    }
    for (int e = tid; e < 65536; e += 512) {
        const int rr = e >> 8, col = e & 255, d = rr >> 7, im = (rr >> 6) & 1, p = rr & 63, j = col >> 4, c2 = col & 15;
        const int ex = d == 0 ? 15 - j : j;
        const float2 pw = Pw[(d * 17 + ex) * 64 + p], bb = Bb[(d * 64 + p) * 16 + c2];
        const float v = im ? (pw.x * bb.y + pw.y * bb.x) : (pw.x * bb.x - pw.y * bb.y);
        W1[65536 + e] = (bf16)f2bf(v);
    }
    for (int e = tid; e < 65536; e += 512) {
        const int row = e >> 8, col = e & 255, i = row >> 4, c = row & 15, d = col >> 7, im = (col >> 6) & 1, p = col & 63;
        const int n = d == 0 ? i + 1 : 16 - i;
        const float2 cc = Cc[(d * 16 + c) * 64 + p], pw = Pw[(d * 17 + n) * 64 + p];
        const float v = im ? -(cc.x * pw.y + cc.y * pw.x) : (cc.x * pw.x - cc.y * pw.y);
        W2[e] = (bf16)f2bf(v);
    }
    __syncthreads();
}

__device__ __forceinline__ void p0_prologue(const Ctx& a, unsigned char* ldsg, int G, const int tid) {
    const int lane = tid & 63, wave = __builtin_amdgcn_readfirstlane(tid >> 6);
    for (int u = a.bid; u < 225; u += G) {
        if (u < 192) p0_adaln_unit(a, u, ldsg, tid, lane, wave);
        else if (u < 224) p0_s5_unit(a, u - 192, ldsg, tid);
        else { float* rp = (float*)(a.ws + WS_ROPE);
            for (int i = tid; i < 1024; i += 512) { const int pos = i >> 4, j = i & 15; const float inv = exp2f(-(float)j * (13.287712379549449f / 16.0f));   float sn, cs; sincosf((float)pos * inv, &sn, &cs); rp[i] = cs; rp[1024 + i] = sn; } }
    }
    __syncthreads();
    LAS float* scr = (LAS float*)((LAS unsigned char*)ldsg + wave * 16384);
    const int gw = a.bid * NWAVES + wave, NGW = G * NWAVES;
    constexpr int IT_IN = 16 * 64, IT_OUT = 16 * 32, IT_G = 16 * 88, IT_D = 44 * 32, IT_GLU = 4 * 8, IT_L = IT_IN + IT_OUT + 2 * IT_G + IT_D + IT_GLU;
    for (int it = gw; it < 2 * IT_L; it += NGW) {
        const int l = it / IT_L; int r = it % IT_L;
        if (r < IT_IN) { const int kb = r / 64, nb = r % 64, tile = nb >> 3, cb = nb & 7;
            p0_transpose_item(inp(a, I_WIN) + (size_t)l * 1024 * 2064, 1024, 2064, 64 * kb, 32 * nb, (bf16*)(a.ws + WS_WIN) + (size_t)l * 2048 * 1024, 256 * tile + 128 * (cb & 1) + 32 * (cb >> 1), scr, lane); continue; } r -= IT_IN;
        if (r < IT_OUT) { const int kb = r / 32, nb = r % 32;
            p0_transpose_item(inp(a, I_WOUT) + (size_t)l * 1024 * 1024, 1024, 1024, 64 * kb, 32 * nb, (bf16*)(a.ws + WS_WOUT) + (size_t)l * 1024 * 1024, 32 * nb, scr, lane); continue; } r -= IT_OUT;
        if (r < IT_G) { const int kb = r / 88, nb = r % 88;
            p0_transpose_item(inp(a, I_WG) + (size_t)l * 1024 * DFF, 1024, DFF, 64 * kb, 32 * nb, (bf16*)(a.ws + WS_WGU) + (size_t)l * NGU * 1024, 256 * (nb >> 2) + 32 * (nb & 3), scr, lane); continue; } r -= IT_G;
        if (r < IT_G) { const int kb = r / 88, nb = r % 88;
            p0_transpose_item(inp(a, I_WU) + (size_t)l * 1024 * DFF, 1024, DFF, 64 * kb, 32 * nb, (bf16*)(a.ws + WS_WGU) + (size_t)l * NGU * 1024, 256 * (nb >> 2) + 128 + 32 * (nb & 3), scr, lane); continue; } r -= IT_G;
        if (r < IT_D) { const int kb = r / 32, nb = r % 32;
            p0_transpose_item(inp(a, I_WD) + (size_t)l * DFF * 1024, DFF, 1024, 64 * kb, 32 * nb, (bf16*)(a.ws + WS_WDN) + (size_t)l * 1024 * DFF, 32 * nb, scr, lane); continue; } r -= IT_D;
        { const int kb = r / 8, nb = r % 8;
            p0_transpose_item(inp(a, I_GLUW) + (size_t)l * 256 * 256, 256, 256, 64 * kb, 32 * nb, (bf16*)(a.ws + WS_GLUT) + (size_t)l * 256 * 256, 32 * nb, scr, lane); }
    }
    for (int i = a.bid * 512 + tid; i < 2 * 16 * 1024; i += G * 512) { const int l = i >> 14, j = (i >> 10) & 15, k = i & 1023;
        ((bf16*)(a.ws + WS_WGT))[i] = (bf16)f2bf(inp(a, I_WIN)[((size_t)l * 1024 + k) * 2064 + 2048 + j]); }
}

__device__ __forceinline__ void norm_phase(const Ctx& a, int l, int which  , int G, const int tid) {
    const int lane = tid & 63, wave = __builtin_amdgcn_readfirstlane(tid >> 6);
    const int gw = a.bid * NWAVES + wave, NGW = G * NWAVES;
    const float* gvec = inp(a, which ? I_N2G : I_N1G) + l * 1024;
    const float* mod = (const float*)(a.ws + WS_MOD) + (size_t)l * 9 * 6144;
    bf16* H = (bf16*)(a.ws + WS_H);
    f32x4 gv[4];
#pragma unroll
    for (int j = 0; j < 4; ++j) gv[j] = *(const f32x4*)(gvec + 4 * lane + 256 * j);
    for (int m = gw; m < MTOK; m += NGW) {
        const float* xrow = (l == 0 && which == 0) ? (m < NPROMPT ? inp(a, I_XP) + (size_t)m * DM : inp(a, I_XS) + (size_t)(m - NPROMPT) * DM) : a.out + OUT_Y + (size_t)m * DM;
        const float* mb = mod + (size_t)bc_of_row(m) * 6144 + (which ? 3 * 1024 : 0);
        f32x4 v[4]; float s = 0.f;
#pragma unroll
        for (int j = 0; j < 4; ++j) { v[j] = *(const f32x4*)(xrow + 4 * lane + 256 * j); s += (v[j].x * v[j].x + v[j].y * v[j].y) + (v[j].z * v[j].z + v[j].w * v[j].w); }
        const float r = rsqrtf(wave_sum(s) * (1.0f / DM) + EPS);
#pragma unroll
        for (int j = 0; j < 4; ++j) { const f32x4 sh = *(const f32x4*)(mb + 4 * lane + 256 * j), sc = *(const f32x4*)(mb + 1024 + 4 * lane + 256 * j);
            const f32x4 o = v[j] * r * gv[j] * (sc + 1.0f) + sh;
            u32x2 w; w.x = pk2(o.x, o.y); w.y = pk2(o.z, o.w);
            *(u32x2*)(H + (size_t)m * DM + 4 * lane + 256 * j) = w; }
    }
    if (which == 0) {
        bf16* KS = (bf16*)(a.ws + WS_KS); bf16* VS = (bf16*)(a.ws + WS_VS);
        for (int i = a.bid * 512 + tid; i < 2 * 8 * 8192; i += G * 512) {
            const int kv = i >> 16, b = (i >> 13) & 7, e = (i & 8191) * 8;
            const float* src = inp(a, kv ? I_CV : I_CK) + ((size_t)(b * 2 + l) * 512) * 128 + e;
            const f32x4 x0 = *(const f32x4*)src, x1 = *(const f32x4*)(src + 4);
            v4u o; o.x = pk2(x0.x, x0.y); o.y = pk2(x0.z, x0.w); o.z = pk2(x1.x, x1.y); o.w = pk2(x1.z, x1.w);
            *(v4u*)((kv ? VS : KS) + (size_t)b * 1536 * 128 + e) = o;
        }
    }
}

struct EpiG1 {
    static constexpr bool PERM = false, AFTER_DRAIN = false;
    int l; unsigned char* ws; float* out; const float* qg; const float* kg;
    __device__ __forceinline__ void operator()(const pg8::f32x4 (&acc)[2][2][4][2], const pg8::Unit& u, int wr, int wc, int fr, int fq) const {
        const int pn = u.pn; const bool samp = u.pm >= 16;
        const int kind = (pn <= 1) ? 0 : (pn == 2 ? (wc < 2 ? 1 : 2) : 3);
        const float* rope = (const float*)(ws + WS_ROPE);
#pragma unroll
        for (int ai = 0; ai < 2; ++ai)
#pragma unroll
            for (int m = 0; m < 4; ++m) {
                const int r = u.pm * 256 + ai * 128 + wr * 64 + m * 16 + fr;
                f32x4 v[2][2];
#pragma unroll
                for (int bj = 0; bj < 2; ++bj)
#pragma unroll
                    for (int n = 0; n < 2; ++n) v[bj][n] = acc[ai][bj][m][n];
                if (kind <= 1) {
                    float ss = 0.f;
#pragma unroll
                    for (int bj = 0; bj < 2; ++bj)
#pragma unroll
                        for (int n = 0; n < 2; ++n) ss += (v[bj][n].x * v[bj][n].x + v[bj][n].y * v[bj][n].y) + (v[bj][n].z * v[bj][n].z + v[bj][n].w * v[bj][n].w);
                    ss += __shfl_xor(ss, 16); ss += __shfl_xor(ss, 32);
                    const float rinv = rsqrtf(ss * (1.0f / 64.0f) + EPS);
#pragma unroll
                    for (int bj = 0; bj < 2; ++bj)
#pragma unroll
                        for (int n = 0; n < 2; ++n) v[bj][n] = v[bj][n] * rinv * *(const f32x4*)((kind == 0 ? qg : kg) + 32 * bj + 16 * n + 4 * fq);
                }
                if (!samp && (kind == 1 || kind == 2)) {
                    const int b = r >> 8, t = r & 255, kvh = wc & 1;
                    float* dst = out + (kind == 1 ? OUT_K : OUT_V) + ((((size_t)b * 2 + l) * 256 + t) * 2 + kvh) * 64 + 4 * fq;
#pragma unroll
                    for (int bj = 0; bj < 2; ++bj)
#pragma unroll
                        for (int n = 0; n < 2; ++n) *(f32x4*)(dst + 32 * bj + 16 * n) = v[bj][n];
                }
                if (samp && kind <= 1) {
                    const int t = (r - NPROMPT) & 1023;
#pragma unroll
                    for (int bj = 0; bj < 2; ++bj) { const int pos = bj == 0 ? (t >> 6) : (t & 63);
                        const f32x4 cs = *(const f32x4*)(rope + pos * 16 + 4 * fq), sn = *(const f32x4*)(rope + 1024 + pos * 16 + 4 * fq);
                        const f32x4 x1 = v[bj][0], x2 = v[bj][1];
                        v[bj][0] = x1 * cs - x2 * sn; v[bj][1] = x2 * cs + x1 * sn; }
                }
                bf16* dst; float scl = 1.0f;
                if (kind == 0) { dst = (bf16*)(ws + WS_Q) + (size_t)r * 512 + (4 * pn + wc) * 64; scl = QSCALE; }
                else if (kind == 3) { dst = (bf16*)(ws + WS_SU + (size_t)(pn - 3) * (6 * MiB)) + (size_t)r * 256 + wc * 64; if (pn == 5) scl = 0.125f; }
                else { const int kvh = wc & 1;
                    if (!samp) dst = (bf16*)(ws + (kind == 1 ? WS_KP : WS_VP)) + (size_t)r * 128 + kvh * 64;
                    else { const int b = (r - NPROMPT) >> 10, t = (r - NPROMPT) & 1023; dst = (bf16*)(ws + (kind == 1 ? WS_KS : WS_VS)) + ((size_t)b * 1536 + 512 + t) * 128 + kvh * 64; } }
#pragma unroll
                for (int bj = 0; bj < 2; ++bj)
#pragma unroll
                    for (int n = 0; n < 2; ++n) { const f32x4 o = v[bj][n] * scl; u32x2 w; w.x = pk2(o.x, o.y); w.y = pk2(o.z, o.w);
                        *(u32x2*)(dst + 32 * bj + 16 * n + 4 * fq) = w; }
                asm volatile("" ::: "memory");
            }
    }
};
struct EpiGlu {
    static constexpr bool PERM = false, AFTER_DRAIN = false;
    const bf16* Z; bf16* MIX; const float* bias;
    __device__ __forceinline__ void operator()(const pg8::f32x4 (&acc)[2][2][4][2], const pg8::Unit& u, int wr, int wc, int fr, int fq) const {
#pragma unroll
        for (int ai = 0; ai < 2; ++ai)
#pragma unroll
            for (int m = 0; m < 4; ++m) { const int r = u.pm * 256 + ai * 128 + wr * 64 + m * 16 + fr;
#pragma unroll
                for (int bj = 0; bj < 2; ++bj)
#pragma unroll
                    for (int n = 0; n < 2; ++n) { const int c = 128 * bj + 32 * wc + 16 * n + 4 * fq;
                        const f32x4 bv = *(const f32x4*)(bias + c); const u32x2 zz = *(const u32x2*)(Z + (size_t)r * 256 + c);
                        const f32x4 s = acc[ai][bj][m][n] + bv;
                        const float z0 = __uint_as_float(zz.x << 16), z1 = __uint_as_float(zz.x & 0xffff0000u), z2 = __uint_as_float(zz.y << 16), z3 = __uint_as_float(zz.y & 0xffff0000u);
                        u32x2 w; w.x = pk2(z0 * sigmoidf_(s.x), z1 * sigmoidf_(s.y)); w.y = pk2(z2 * sigmoidf_(s.z), z3 * sigmoidf_(s.w));
                        *(u32x2*)(MIX + (size_t)r * 1024 + 512 + c) = w; }
                asm volatile("" ::: "memory"); }
    }
};
struct EpiResid {
    static constexpr bool PERM = false, AFTER_DRAIN = false;
    const float* xp; const float* xs; float* xout; const float* gate;
    __device__ __forceinline__ void operator()(const pg8::f32x4 (&acc)[2][2][4][2], const pg8::Unit& u, int wr, int wc, int fr, int fq) const {
        const int bc = u.pm < 16 ? 0 : 1 + ((u.pm - 16) >> 2);
        const float* gp = gate + (size_t)bc * 6144 + u.pn * 256 + wc * 32 + 4 * fq;
        f32x4 gv[2][2];
#pragma unroll
        for (int bj = 0; bj < 2; ++bj)
#pragma unroll
            for (int n = 0; n < 2; ++n) gv[bj][n] = *(const f32x4*)(gp + bj * 128 + n * 16);
#pragma unroll
        for (int ai = 0; ai < 2; ++ai)
#pragma unroll
            for (int m = 0; m < 4; ++m) { const int r = u.pm * 256 + ai * 128 + wr * 64 + m * 16 + fr;
                const float* xi = (r < NPROMPT ? xp + (size_t)r * DM : xs + (size_t)(r - NPROMPT) * DM) + u.pn * 256 + wc * 32 + 4 * fq;
                float* xo = xout + (size_t)r * DM + u.pn * 256 + wc * 32 + 4 * fq;
#pragma unroll
                for (int bj = 0; bj < 2; ++bj)
#pragma unroll
                    for (int n = 0; n < 2; ++n) { const f32x4 b = *(const f32x4*)(xi + bj * 128 + n * 16); *(f32x4*)(xo + bj * 128 + n * 16) = b + gv[bj][n] * acc[ai][bj][m][n]; }
                if (m & 1) asm volatile("" ::: "memory"); }
    }
};


__device__ __forceinline__ float dpp_ror1(float x) { return __builtin_bit_cast(float, __builtin_amdgcn_update_dpp(0, __builtin_bit_cast(int, x), 0x121, 0xf, 0xf, false)); }
__device__ __forceinline__ float dpp_ror15(float x) { return __builtin_bit_cast(float, __builtin_amdgcn_update_dpp(0, __builtin_bit_cast(int, x), 0x12f, 0xf, 0xf, false)); }
__device__ __forceinline__ f32x4 ror1v(f32x4 v) { return (f32x4){dpp_ror1(v.x), dpp_ror1(v.y), dpp_ror1(v.z), dpp_ror1(v.w)}; }
__device__ __forceinline__ f32x4 ror15v(f32x4 v) { return (f32x4){dpp_ror15(v.x), dpp_ror15(v.y), dpp_ror15(v.z), dpp_ror15(v.w)}; }
__device__ __forceinline__ f32x4 siluv(f32x4 c) { return (f32x4){c.x * sigmoidf_(c.x), c.y * sigmoidf_(c.y), c.z * sigmoidf_(c.z), c.w * sigmoidf_(c.w)}; }
constexpr int XR_OFF = 133120;
struct StripOrder {
    int G, c;
    __device__ __forceinline__ bool next(int i, pg8::Unit& u) const {
        if (G == 256) {
            if (c < 176) { if (i < 4) { u.pm = 16 + 4 * (c / 22) + i; u.pn = c % 22; return true; } if (i == 4) { u.pm = c / 22; u.pn = c % 22; return true; } return false; }
            const int s = 176 + (c - 176) + 80 * i; if (i < 3 && s < 352) { u.pm = s / 22; u.pn = s % 22; return true; } return false;
        }
        int rem = i;
        for (int j = c; j < 528; j += G) { const int cnt = j < 176 ? 4 : 1;
            if (rem < cnt) { if (j < 176) { u.pm = 16 + 4 * (j / 22) + rem; u.pn = j % 22; } else { u.pm = (j - 176) / 22; u.pn = (j - 176) % 22; } return true; }
            rem -= cnt; }
        return false;
    }
    __device__ __forceinline__ void a_ready(const pg8::Unit&) const {}
    __device__ __forceinline__ void done(const pg8::Unit&) const {}
};
struct EpiG3 {
    static constexpr bool PERM = true, AFTER_DRAIN = false;
    bf16* HID; const float* cw; const float* cb; LAS float* XR;
    __device__ __forceinline__ void operator()(const pg8::f32x4 (&acc)[2][2][4][2], const pg8::Unit& u, int wr, int wc, int fr, int fq) const {
        const int pm = u.pm, pn = u.pn; const bool samp = pm >= 16; const int qtr = samp ? ((pm - 16) & 3) : 0;
        const bool first = !samp || qtr == 0, last = !samp || qtr == 3;
        LAS float* XF = XR; LAS float* XL = XR + 512; LAS float* CY = XR + 1024 + (qtr & 1) * 384; LAS float* CP = XR + 1024 + ((qtr & 1) ^ 1) * 384;
        const int fl = 32 * wc + 8 * fq;
#pragma unroll
        for (int ai = 0; ai < 2; ++ai) { const int q = 2 * ai + wr;
            if (fr == 0) {
#pragma unroll
                for (int n = 0; n < 2; ++n) *(LAS f32x4*)(XF + q * 128 + fl + 4 * n) = acc[ai][0][0][n]; }
            if (fr == 15) {
#pragma unroll
                for (int n = 0; n < 2; ++n) *(LAS f32x4*)(XL + q * 128 + fl + 4 * n) = acc[ai][0][3][n]; } }
        asm volatile("s_waitcnt lgkmcnt(0)" ::: "memory"); __builtin_amdgcn_s_barrier(); asm volatile("" ::: "memory");
        f32x4 w0[2], w1[2], w2[2], bb[2];
#pragma unroll
        for (int n = 0; n < 2; ++n) { const int f = 128 * pn + fl + 4 * n; w0[n] = *(const f32x4*)(cw + f); w1[n] = *(const f32x4*)(cw + DFF + f); w2[n] = *(const f32x4*)(cw + 2 * DFF + f); bb[n] = *(const f32x4*)(cb + f); }
        const f32x4 zero4 = {0.f, 0.f, 0.f, 0.f};
#pragma unroll
        for (int ai = 0; ai < 2; ++ai) { const int q = 2 * ai + wr;
#pragma unroll
            for (int m = 0; m < 4; ++m) {
                const int r = pm * 256 + ai * 128 + wr * 64 + m * 16 + fr;
                f32x4 hv[2]; bool defer = false;
#pragma unroll
                for (int n = 0; n < 2; ++n) {
                    const f32x4 cur = acc[ai][0][m][n];
                    f32x4 up = ror1v(cur), dn = ror15v(cur);
                    if (m > 0) { const f32x4 t = ror1v(acc[ai][0][m > 0 ? m - 1 : 0][n]); if (fr == 0) up = t; }
                    else if (fr == 0) { up = (q > 0) ? *(const LAS f32x4*)(XL + (q - 1) * 128 + fl + 4 * n) : (first ? zero4 : *(const LAS f32x4*)(CP + fl + 4 * n)); }
                    if (m < 3) { const f32x4 t = ror15v(acc[ai][0][m < 3 ? m + 1 : 3][n]); if (fr == 15) dn = t; }
                    else if (fr == 15) { dn = (q < 3) ? *(const LAS f32x4*)(XF + (q + 1) * 128 + fl + 4 * n) : zero4; }
                    const f32x4 cpart = w0[n] * up + w1[n] * cur + bb[n];
                    const f32x4 uu = acc[ai][1][m][n];
                    hv[n] = siluv(cpart + w2[n] * dn) * uu;
                    if (m == 3 && q == 3 && !last && fr == 15) { defer = true;
                        *(LAS f32x4*)(CY + fl + 4 * n) = cur; *(LAS f32x4*)(CY + 128 + fl + 4 * n) = cpart; *(LAS f32x4*)(CY + 256 + fl + 4 * n) = uu; }
                    if (m == 0 && q == 0 && !first && fr == 0) {
                        const f32x4 pc = *(const LAS f32x4*)(CP + 128 + fl + 4 * n), pu = *(const LAS f32x4*)(CP + 256 + fl + 4 * n);
                        const f32x4 ph = siluv(pc + w2[n] * cur) * pu; u32x2 w; w.x = pk2(ph.x, ph.y); w.y = pk2(ph.z, ph.w);
                        *(u32x2*)(HID + (size_t)(pm * 256 - 1) * DFF + 128 * pn + fl + 4 * n) = w; }
                }
                if (!defer) { v4u w; w.x = pk2(hv[0].x, hv[0].y); w.y = pk2(hv[0].z, hv[0].w); w.z = pk2(hv[1].x, hv[1].y); w.w = pk2(hv[1].z, hv[1].w);
                    *(v4u*)(HID + (size_t)r * DFF + 128 * pn + fl) = w; }
            } }
    }
};
__device__ __forceinline__ void gates_phase(const Ctx& a, int l, int G, const int tid) {
    const int lane = tid & 63, wave = __builtin_amdgcn_readfirstlane(tid >> 6);
    const int gw = a.bid * NWAVES + wave, NGW = G * NWAVES;
    const bf16* H = (const bf16*)(a.ws + WS_H); const bf16* WG = (const bf16*)(a.ws + WS_WGT) + (size_t)l * 16 * 1024;
    float* GT = (float*)(a.ws + WS_GATES);
    const int j = lane & 15; const float bias = inp(a, I_MGB)[l * 16 + j];
    for (int uu = gw; uu < MTOK / 16; uu += NGW) {
        const int r0 = uu * 16;
        const bf16* Ap = H + (size_t)(r0 + (lane & 15)) * DM + 8 * (lane >> 4);
        const bf16* Bp = WG + (size_t)(lane & 15) * DM + 8 * (lane >> 4);
        f32x4 acc = {0.f, 0.f, 0.f, 0.f};
#pragma unroll 8
        for (int ks = 0; ks < 32; ++ks) { const bf16x8 av = *(const bf16x8*)(Ap + ks * 32), bv = *(const bf16x8*)(Bp + ks * 32); acc = __builtin_amdgcn_mfma_f32_16x16x32_bf16(av, bv, acc, 0, 0, 0); }
#pragma unroll
        for (int rg = 0; rg < 4; ++rg) { float v = acc[rg] + bias; if (j >= 8) v = fminf(v, 0.f) - __logf(1.0f + __expf(-fabsf(v)));
            GT[(size_t)(r0 + 4 * (lane >> 4) + rg) * 16 + j] = v; }
    }
}

template <int NCB> __device__ __forceinline__ void s5_unit(const Ctx& a, int l, int s, int g, unsigned char* ldsg, const int tid) {
    constexpr int NCH = 16 * NCB;
    const int lane = tid & 63, wave = __builtin_amdgcn_readfirstlane(tid >> 6);
    const bool samp = s >= 16; const int row0 = samp ? NPROMPT + (s - 16) * 1024 : s * 256;
    const bf16* U = (const bf16*)(a.ws + WS_SU) + (size_t)row0 * 256 + g * 16;
    const bf16* W1 = (const bf16*)(a.ws + WS_S5W1) + (size_t)(l * 16 + g) * 512 * 256;
    const bf16* W2 = (const bf16*)(a.ws + WS_S5W2) + (size_t)(l * 16 + g) * 256 * 256;
    float* dS = (float*)ldsg;
    bf16* Sin = (bf16*)(ldsg + 256 * 65 * 4);
    const int lr = lane & 15, lq = lane >> 4;
    f32x4 accY[2][NCB], accS[2][NCB];
#pragma unroll
    for (int i = 0; i < 2; ++i)
#pragma unroll
        for (int cb = 0; cb < NCB; ++cb) { accY[i][cb] = (f32x4){0.f, 0.f, 0.f, 0.f}; accS[i][cb] = (f32x4){0.f, 0.f, 0.f, 0.f}; }
#pragma unroll 2
    for (int ks = 0; ks < 8; ++ks) {
        bf16x8 bfr[NCB];
#pragma unroll
        for (int cb = 0; cb < NCB; ++cb) bfr[cb] = *(const bf16x8*)(U + (size_t)((cb * 16 + lr) * 16 + 2 * ks + (lq >> 1)) * 256 + 8 * (lq & 1));
#pragma unroll
        for (int i = 0; i < 2; ++i) {
            const bf16x8 ay = *(const bf16x8*)(W1 + (size_t)((2 * wave + i) * 16 + lr) * 256 + ks * 32 + 8 * lq);
            const bf16x8 as = *(const bf16x8*)(W1 + (size_t)((16 + 2 * wave + i) * 16 + lr) * 256 + ks * 32 + 8 * lq);
#pragma unroll
            for (int cb = 0; cb < NCB; ++cb) { accY[i][cb] = __builtin_amdgcn_mfma_f32_16x16x32_bf16(ay, bfr[cb], accY[i][cb], 0, 0, 0);
                                               accS[i][cb] = __builtin_amdgcn_mfma_f32_16x16x32_bf16(as, bfr[cb], accS[i][cb], 0, 0, 0); }
        }
    }
#pragma unroll
    for (int i = 0; i < 2; ++i)
#pragma unroll
        for (int cb = 0; cb < NCB; ++cb)
#pragma unroll
            for (int rg = 0; rg < 4; ++rg) dS[((2 * wave + i) * 16 + 4 * lq + rg) * (NCH + 1) + cb * 16 + lr] = accS[i][cb][rg];
    __syncthreads();
    if (tid < 128) {
        const int d = tid >> 6, p = tid & 63; const int gi = (l * 2 + d) * 16 + g;
        const float2 a16 = ((const float2*)(a.ws + WS_S5A16))[gi * 64 + p];
        float sr = 0.f, si = 0.f;
        if (samp) { const size_t ix = ((size_t)(((s - 16) * 2 + l) * 2 + d) * 16 + g) * 64 + p; sr = inp(a, I_S5RE)[ix]; si = inp(a, I_S5IM)[ix]; }
        for (int kk = 0; kk < NCH; ++kk) { const int k = d == 0 ? kk : NCH - 1 - kk;
            Sin[k * 264 + 128 * d + p] = (bf16)f2bf(sr); Sin[k * 264 + 128 * d + 64 + p] = (bf16)f2bf(si);
            const float xr = dS[(128 * d + p) * (NCH + 1) + k], xi = dS[(128 * d + 64 + p) * (NCH + 1) + k];
            const float nr = a16.x * sr - a16.y * si + xr, ni = a16.x * si + a16.y * sr + xi; sr = nr; si = ni; }
        if (!samp) { const size_t ox = ((size_t)((s * 2 + l) * 2 + d) * 16 + g) * 64 + p; a.out[OUT_S5RE + ox] = sr; a.out[OUT_S5IM + ox] = si; }
    }
    __syncthreads();
#pragma unroll 2
    for (int ks = 0; ks < 8; ++ks) {
        bf16x8 bfr[NCB];
#pragma unroll
        for (int cb = 0; cb < NCB; ++cb) bfr[cb] = *(const bf16x8*)(Sin + (cb * 16 + lr) * 264 + ks * 32 + 8 * lq);
#pragma unroll
        for (int i = 0; i < 2; ++i) { const bf16x8 ay = *(const bf16x8*)(W2 + (size_t)((2 * wave + i) * 16 + lr) * 256 + ks * 32 + 8 * lq);
#pragma unroll
            for (int cb = 0; cb < NCB; ++cb) accY[i][cb] = __builtin_amdgcn_mfma_f32_16x16x32_bf16(ay, bfr[cb], accY[i][cb], 0, 0, 0); }
    }
    float* Y5 = (float*)(a.ws + WS_Y5);
#pragma unroll
    for (int i = 0; i < 2; ++i)
#pragma unroll
        for (int cb = 0; cb < NCB; ++cb) { const int tok = (cb * 16 + lr) * 16 + (2 * wave + i);
            *(f32x4*)(Y5 + (size_t)(row0 + tok) * 256 + g * 16 + 4 * lq) = accY[i][cb]; }
    __syncthreads();
}

__device__ __forceinline__ void mlstm_unit(const Ctx& a, int l, int s, int h, int dir, unsigned char* ldsg, const int tid) {
    const int lane = tid & 63, wave = __builtin_amdgcn_readfirstlane(tid >> 6);
    const bool samp = s >= 16; const int L = samp ? 1024 : 256, nck = L / 64; const int row0 = samp ? NPROMPT + (s - 16) * 1024 : s * 256;
    constexpr int P = 72;
    bf16* Qs = (bf16*)ldsg;
    bf16* Ks = Qs + 64 * P;
    bf16* KT = Ks + 64 * P;
    bf16* VT = KT + 64 * P;
    bf16* SC = VT + 80 * P;
    bf16* Cb = SC + 64 * P;
    float* fl = (float*)(Cb + 80 * P);
    float* av = fl, *Mv = fl + 64, *sint = fl + 128, *wkv = fl + 192, *emn = fl + 256, *denv = fl + 320, *misc = fl + 384;
    const bf16* MQ = (const bf16*)(a.ws + WS_MQ), *MKb = (const bf16*)(a.ws + WS_MK), *MVb = (const bf16*)(a.ws + WS_MV);
    const float* GT = (const float*)(a.ws + WS_GATES);
    float* HO = (float*)(a.ws + (dir ? WS_HB : WS_HF));
    const int lr = lane & 15, lq = lane >> 4;
    f32x4 accC[3];
    float mrun = 0.f;
#pragma unroll
    for (int i = 0; i < 3; ++i) { accC[i] = (f32x4){0.f, 0.f, 0.f, 0.f};
        const int j = wave + 8 * i;
        if (samp && j < 20) { const int db = j >> 2, eb = j & 3; const size_t sb = (size_t)((((s - 16) * 2 + l) * 2 + dir) * 4 + h);
            if (db < 4) {
#pragma unroll
                for (int rg = 0; rg < 4; ++rg) accC[i][rg] = inp(a, I_MC)[(sb * 64 + db * 16 + 4 * lq + rg) * 64 + eb * 16 + lr];
            } else if (lq == 0) accC[i][0] = inp(a, I_MN)[sb * 64 + eb * 16 + lr]; }
    }
    if (samp) mrun = inp(a, I_MM)[(((s - 16) * 2 + l) * 2 + dir) * 4 + h];
    for (int i = tid; i < 16 * 64; i += 512) { const int d = 64 + (i >> 6), sidx = i & 63; VT[d * P + sidx] = (d == 64) ? (bf16)0x3f80 : (bf16)0; }
#pragma unroll
    for (int i = 0; i < 3; ++i) { const int j = wave + 8 * i; if (j < 20) { const int db = j >> 2, eb = j & 3;
#pragma unroll
        for (int rg = 0; rg < 4; ++rg) Cb[(db * 16 + 4 * lq + rg) * P + eb * 16 + lr] = (bf16)f2bf(accC[i][rg]); } }
    __syncthreads();
    for (int ck = 0; ck < nck; ++ck) {
        {
            const int pos = tid >> 3, seg = tid & 7; const int tok = dir ? L - 1 - (64 * ck + pos) : 64 * ck + pos;
            const size_t go = (size_t)(row0 + tok) * 256 + h * 64 + seg * 8;
            const v4u qv = *(const v4u*)(MQ + go), kv = *(const v4u*)(MKb + go), vv = *(const v4u*)(MVb + go);
            *(v4u*)(Qs + pos * P + seg * 8) = qv; *(v4u*)(Ks + pos * P + seg * 8) = kv;
            const unsigned vw[4] = {vv.x, vv.y, vv.z, vv.w};
#pragma unroll
            for (int e = 0; e < 4; ++e) { VT[(seg * 8 + 2 * e) * P + pos] = (bf16)(vw[e] & 0xffffu); VT[(seg * 8 + 2 * e + 1) * P + pos] = (bf16)(vw[e] >> 16); }
        }
        if (wave == 0) {
            const int tok = dir ? L - 1 - (64 * ck + lane) : 64 * ck + lane;
            const float li = GT[(size_t)(row0 + tok) * 16 + dir * 4 + h], lf = GT[(size_t)(row0 + tok) * 16 + 8 + dir * 4 + h];
            float b = lf;
#pragma unroll
            for (int o = 1; o < 64; o <<= 1) { const float t = __shfl_up(b, o); if (lane >= o) b += t; }
            const float aa = li - b;
            float cm = aa;
#pragma unroll
            for (int o = 1; o < 64; o <<= 1) { const float t = __shfl_up(cm, o); if (lane >= o) cm = fmaxf(cm, t); }
            const float Mt = fmaxf(mrun, cm);
            const float blast = __shfl(b, 63), amax = __shfl(cm, 63);
            const float Mn = fmaxf(mrun, amax);
            av[lane] = aa; Mv[lane] = Mt; sint[lane] = __expf(mrun - Mt); wkv[lane] = __expf(aa - Mn); emn[lane] = __expf(-(b + Mt));
            if (lane == 0) { misc[0] = __expf(mrun - Mn); misc[1] = blast + Mn; }
        }
        __syncthreads();
        const float decay = misc[0]; const float mnew = misc[1];
        {
            const int pos = tid >> 3, seg = tid & 7; const float wk = wkv[pos];
            const v4u kv = *(const v4u*)(Ks + pos * P + seg * 8); const unsigned kw[4] = {kv.x, kv.y, kv.z, kv.w};
#pragma unroll
            for (int e = 0; e < 4; ++e) { KT[(seg * 8 + 2 * e) * P + pos] = (bf16)f2bf(wk * __uint_as_float(kw[e] << 16)); KT[(seg * 8 + 2 * e + 1) * P + pos] = (bf16)f2bf(wk * __uint_as_float(kw[e] & 0xffff0000u)); }
        }
        {
            const int tb = wave >> 1;
#pragma unroll
            for (int i = 0; i < 2; ++i) { const int sb = 2 * (wave & 1) + i; f32x4 sacc = {0.f, 0.f, 0.f, 0.f};
#pragma unroll
                for (int ks = 0; ks < 2; ++ks) { const bf16x8 qa = *(const bf16x8*)(Qs + (tb * 16 + lr) * P + ks * 32 + 8 * lq), kb = *(const bf16x8*)(Ks + (sb * 16 + lr) * P + ks * 32 + 8 * lq);
                    sacc = __builtin_amdgcn_mfma_f32_16x16x32_bf16(qa, kb, sacc, 0, 0, 0); }
                const int sidx = sb * 16 + lr; const float as = av[sidx];
#pragma unroll
                for (int rg = 0; rg < 4; ++rg) { const int t = tb * 16 + 4 * lq + rg; const float w = (sidx <= t) ? __expf(as - Mv[t]) : 0.f; SC[t * P + sidx] = (bf16)f2bf(sacc[rg] * w); } }
        }
        __syncthreads();
        f32x4 nacc[3];
#pragma unroll
        for (int i = 0; i < 3; ++i) { nacc[i] = (f32x4){0.f, 0.f, 0.f, 0.f}; const int j = wave + 8 * i;
            if (j < 20) { const int tb = j / 5, db = j % 5;
#pragma unroll
                for (int ks = 0; ks < 2; ++ks) { const bf16x8 qa = *(const bf16x8*)(Qs + (tb * 16 + lr) * P + ks * 32 + 8 * lq), cbv = *(const bf16x8*)(Cb + (db * 16 + lr) * P + ks * 32 + 8 * lq);
                    nacc[i] = __builtin_amdgcn_mfma_f32_16x16x32_bf16(qa, cbv, nacc[i], 0, 0, 0); }
#pragma unroll
                for (int rg = 0; rg < 4; ++rg) nacc[i][rg] *= sint[tb * 16 + 4 * lq + rg];
#pragma unroll
                for (int ks = 0; ks < 2; ++ks) { const bf16x8 sa = *(const bf16x8*)(SC + (tb * 16 + lr) * P + ks * 32 + 8 * lq), vb = *(const bf16x8*)(VT + (db * 16 + lr) * P + ks * 32 + 8 * lq);
                    nacc[i] = __builtin_amdgcn_mfma_f32_16x16x32_bf16(sa, vb, nacc[i], 0, 0, 0); }
                if (db == 4 && lr == 0) {
#pragma unroll
                    for (int rg = 0; rg < 4; ++rg) denv[tb * 16 + 4 * lq + rg] = nacc[i][rg]; } } }
#pragma unroll
        for (int i = 0; i < 3; ++i) { const int j = wave + 8 * i;
            if (j < 20) { const int db = j >> 2, eb = j & 3;
#pragma unroll
                for (int rg = 0; rg < 4; ++rg) accC[i][rg] *= decay;
#pragma unroll
                for (int ks = 0; ks < 2; ++ks) { const bf16x8 va = *(const bf16x8*)(VT + (db * 16 + lr) * P + ks * 32 + 8 * lq), kb = *(const bf16x8*)(KT + (eb * 16 + lr) * P + ks * 32 + 8 * lq);
                    accC[i] = __builtin_amdgcn_mfma_f32_16x16x32_bf16(va, kb, accC[i], 0, 0, 0); } } }
        __syncthreads();
#pragma unroll
        for (int i = 0; i < 3; ++i) { const int j = wave + 8 * i;
            if (j < 20) { const int tb = j / 5, db = j % 5;
                if (db < 4) {
#pragma unroll
                    for (int rg = 0; rg < 4; ++rg) { const int t = tb * 16 + 4 * lq + rg; const int tok = dir ? L - 1 - (64 * ck + t) : 64 * ck + t;
                        HO[(size_t)(row0 + tok) * 256 + h * 64 + db * 16 + lr] = nacc[i][rg] / fmaxf(fabsf(denv[t]), emn[t]); } }
                const int db2 = j >> 2, eb2 = j & 3;
#pragma unroll
                for (int rg = 0; rg < 4; ++rg) Cb[(db2 * 16 + 4 * lq + rg) * P + eb2 * 16 + lr] = (bf16)f2bf(accC[i][rg]); } }
        mrun = mnew;
        __syncthreads();
    }
    if (!samp) {
        const size_t sb = (size_t)(((s * 2 + l) * 2 + dir) * 4 + h);
#pragma unroll
        for (int i = 0; i < 3; ++i) { const int j = wave + 8 * i;
            if (j < 20) { const int db = j >> 2, eb = j & 3;
                if (db < 4) {
#pragma unroll
                    for (int rg = 0; rg < 4; ++rg) a.out[OUT_MC + (sb * 64 + db * 16 + 4 * lq + rg) * 64 + eb * 16 + lr] = accC[i][rg];
                } else if (lq == 0) a.out[OUT_MN + sb * 64 + eb * 16 + lr] = accC[i][0]; } }
        if (tid == 0) a.out[OUT_MM + sb] = mrun;
    }
    __syncthreads();
}

__device__ __forceinline__ void mix_phase(const Ctx& a, int l, int rep, unsigned char* ldsg, volatile LAS unsigned* MISC, const int tid0) {
    gu32* head = (gu32*)(a.ws + WS_CTL) + CW_QUEUE + 64 * (l + 2 * rep);
    const bf16* Q = (const bf16*)(a.ws + WS_Q); bf16* MIX = (bf16*)(a.ws + WS_MIX);
    for (;;) {
        if (tid0 == 0) MISC[16] = __hip_atomic_fetch_add(head, 1u, RLX_AGENT);
        __syncthreads();
        const int u = (int)MISC[16];
        __syncthreads();
        if (u >= 960) break;
        int tid = tid0; asm volatile("" : "+v"(tid));
        const int sel = rep ? PROBE_MIXSEL : 7;
        if (!((sel >> (u < 64 || (u >= 448 && u < 576) ? 0 : ((u >= 64 && u < 320) || (u >= 576 && u < 704)) ? 1 : 2)) & 1)) continue;
        if (u < 64) { if (ENB(11)) mlstm_unit(a, l, 16 + (u >> 3), (u >> 1) & 3, u & 1, ldsg, tid); }
        else if (u < 320) { if (ENB(12)) { const int v = u - 64, b = v >> 5, hq = (v >> 2) & 7, qb = v & 3; const int r0 = NPROMPT + b * 1024 + qb * 256;
            attn_body::attn_unit<8>((const attn_body::bf16*)(Q + (size_t)r0 * 512 + hq * 64), 512, (const attn_body::bf16*)((const bf16*)(a.ws + WS_KS) + (size_t)b * 1536 * 128 + (hq >> 2) * 64),
                                    (const attn_body::bf16*)((const bf16*)(a.ws + WS_VS) + (size_t)b * 1536 * 128 + (hq >> 2) * 64), 128, (attn_body::bf16*)(MIX + (size_t)r0 * 1024 + hq * 64), 1024, 24, (char*)ldsg, tid); } }
        else if (u < 448) { const int v = u - 320; if (ENB(13)) s5_unit<4>(a, l, 16 + (v >> 4), v & 15, ldsg, tid); }
        else if (u < 576) { const int v = u - 448; if (ENB(11)) mlstm_unit(a, l, v >> 3, (v >> 1) & 3, v & 1, ldsg, tid); }
        else if (u < 704) { if (ENB(12)) { const int v = u - 576, b = v >> 3, hq = v & 7; const int r0 = b * 256;
            attn_body::attn_unit<8>((const attn_body::bf16*)(Q + (size_t)r0 * 512 + hq * 64), 512, (const attn_body::bf16*)((const bf16*)(a.ws + WS_KP) + (size_t)r0 * 128 + (hq >> 2) * 64),
                                    (const attn_body::bf16*)((const bf16*)(a.ws + WS_VP) + (size_t)r0 * 128 + (hq >> 2) * 64), 128, (attn_body::bf16*)(MIX + (size_t)r0 * 1024 + hq * 64), 1024, 4, (char*)ldsg, tid); } }
        else { const int v = u - 704; if (ENB(13)) s5_unit<1>(a, l, v >> 4, v & 15, ldsg, tid); }
    }
}

__device__ __forceinline__ float gelu_tanh(float x) { const float t = 0.7978845608028654f * (x + 0.044715f * x * x * x); return x * sigmoidf_(2.0f * t); }
__device__ __forceinline__ void fin_phase(const Ctx& a, int l, int G, const int tid) {
    const int lane = tid & 63, wave = __builtin_amdgcn_readfirstlane(tid >> 6);
    const int gw = a.bid * NWAVES + wave, NGW = G * NWAVES;
    const float* Y5 = (const float*)(a.ws + WS_Y5); const float* HF = (const float*)(a.ws + WS_HF); const float* HB = (const float*)(a.ws + WS_HB);
    const bf16* MO = (const bf16*)(a.ws + WS_MO); bf16* Z = (bf16*)(a.ws + WS_SU); bf16* MIX = (bf16*)(a.ws + WS_MIX);
    const f32x4 ng = *(const f32x4*)(inp(a, I_MNG) + l * 64 + 4 * (lane & 15));
    for (int m = gw; m < MTOK; m += NGW) {
        const f32x4 y = *(const f32x4*)(Y5 + (size_t)m * 256 + 4 * lane);
        u32x2 zw; zw.x = pk2(gelu_tanh(y.x), gelu_tanh(y.y)); zw.y = pk2(gelu_tanh(y.z), gelu_tanh(y.w));
        *(u32x2*)(Z + (size_t)m * 256 + 4 * lane) = zw;
        const f32x4 hv = *(const f32x4*)(HF + (size_t)m * 256 + 4 * lane) + *(const f32x4*)(HB + (size_t)m * 256 + 4 * lane);
        float ss = (hv.x * hv.x + hv.y * hv.y) + (hv.z * hv.z + hv.w * hv.w);
        ss += __shfl_xor(ss, 1); ss += __shfl_xor(ss, 2); ss += __shfl_xor(ss, 4); ss += __shfl_xor(ss, 8);
        const float r = rsqrtf(ss * (1.0f / 64.0f) + EPS);
        const u32x2 mo = *(const u32x2*)(MO + (size_t)m * 256 + 4 * lane);
        const float o0 = __uint_as_float(mo.x << 16), o1 = __uint_as_float(mo.x & 0xffff0000u), o2 = __uint_as_float(mo.y << 16), o3 = __uint_as_float(mo.y & 0xffff0000u);
        u32x2 w; w.x = pk2(hv.x * r * ng.x * sigmoidf_(o0), hv.y * r * ng.y * sigmoidf_(o1)); w.y = pk2(hv.z * r * ng.z * sigmoidf_(o2), hv.w * r * ng.w * sigmoidf_(o3));
        *(u32x2*)(MIX + (size_t)m * 1024 + 768 + 4 * lane) = w;
    }
}

__device__ __forceinline__ void conv_phase(const Ctx& a, int l, int G, const int tid) {
    bf16* AU = (bf16*)(a.ws + WS_BIG);
    const float* cw = inp(a, I_CW) + (size_t)l * 3 * DFF; const float* cb = inp(a, I_CB) + (size_t)l * DFF;
    const int NIT = MTOK * (DFF / 8);
    for (int it = a.bid * 512 + tid; it < NIT; it += G * 512) {
        const int m = it / (DFF / 8), f0 = (it % (DFF / 8)) * 8;
        const int t = m < NPROMPT ? (m & 255) : ((m - NPROMPT) & 1023); const int Ls = m < NPROMPT ? 256 : 1024;
        bf16* pa = AU + (size_t)m * NGU + (f0 >> 7) * 256 + (f0 & 127);
        const v4u ac = *(const v4u*)pa, uu = *(const v4u*)(pa + 128);
        v4u ap = {0u, 0u, 0u, 0u}, an = {0u, 0u, 0u, 0u};
        if (t > 0) ap = *(const v4u*)(pa - NGU);
        if (t < Ls - 1) an = *(const v4u*)(pa + NGU);
        const unsigned acw[4] = {ac.x, ac.y, ac.z, ac.w}, apw[4] = {ap.x, ap.y, ap.z, ap.w}, anw[4] = {an.x, an.y, an.z, an.w}, uw[4] = {uu.x, uu.y, uu.z, uu.w};
        float w0[8], w1[8], w2[8], bb[8];
        *(f32x4*)&w0[0] = *(const f32x4*)(cw + f0); *(f32x4*)&w0[4] = *(const f32x4*)(cw + f0 + 4);
        *(f32x4*)&w1[0] = *(const f32x4*)(cw + DFF + f0); *(f32x4*)&w1[4] = *(const f32x4*)(cw + DFF + f0 + 4);
        *(f32x4*)&w2[0] = *(const f32x4*)(cw + 2 * DFF + f0); *(f32x4*)&w2[4] = *(const f32x4*)(cw + 2 * DFF + f0 + 4);
        *(f32x4*)&bb[0] = *(const f32x4*)(cb + f0); *(f32x4*)&bb[4] = *(const f32x4*)(cb + f0 + 4);
        unsigned ow[4];
#pragma unroll
        for (int e = 0; e < 4; ++e) {
            const float c0 = w0[2 * e] * __uint_as_float(apw[e] << 16) + w1[2 * e] * __uint_as_float(acw[e] << 16) + w2[2 * e] * __uint_as_float(anw[e] << 16) + bb[2 * e];
            const float c1 = w0[2 * e + 1] * __uint_as_float(apw[e] & 0xffff0000u) + w1[2 * e + 1] * __uint_as_float(acw[e] & 0xffff0000u) + w2[2 * e + 1] * __uint_as_float(anw[e] & 0xffff0000u) + bb[2 * e + 1];
            ow[e] = pk2(c0 * sigmoidf_(c0) * __uint_as_float(uw[e] << 16), c1 * sigmoidf_(c1) * __uint_as_float(uw[e] & 0xffff0000u));
        }
        v4u o; o.x = ow[0]; o.y = ow[1]; o.z = ow[2]; o.w = ow[3];
        *(v4u*)(pa + 128) = o;
    }
}

constexpr int N_PHASES = 21;
#ifndef MK_SPLIT
#define MK_SPLIT 0
#endif

__global__ void __launch_bounds__(NWAVES * 64, 2) hyb_fwd(Args args) {
    extern __shared__ __attribute__((aligned(16))) unsigned char lds[];
    const int tid0 = threadIdx.x; const int G0 = gridDim.x;
    LAS unsigned char* ldsl = (LAS unsigned char*)lds;
    volatile LAS unsigned* MISC = (volatile LAS unsigned*)(ldsl + MISC_OFF);
    for (int u = tid0; u < (LDS_BYTES - LDSCTL_OFF) / 4; u += NWAVES * 64) ((LAS unsigned*)(ldsl + LDSCTL_OFF))[u] = 0u;
    __syncthreads();
    LAS unsigned long long* ptab = (LAS unsigned long long*)(ldsl + MISC_OFF + 256);
    if (tid0 < 36) ptab[tid0] = (unsigned long long)args.in[tid0];
    __syncthreads();
    gu32* ctl = (gu32*)(args.ws + WS_CTL);
    XcdBarrier bar; bar.bar = (unsigned*)(ctl + CW_BAR); bar.x = 0; bar.st = nullptr;
    if (!MK_SPLIT) bar = xcd_barrier_post((unsigned*)(ctl + CW_BAR), MISC + 8);
    const int lo = args.ph_lo, hi = args.ph_hi;
    const int wave_s = __builtin_amdgcn_readfirstlane(tid0 >> 6);
    for (int it = lo; it < hi; ++it) {
        const int ph = (PROBE_REP < 0 || it <= PROBE_REP) ? it : (it <= PROBE_REP + PROBE_NREP ? PROBE_REP : it - PROBE_NREP);
        const int rep = (PROBE_REP >= 0 && it > PROBE_REP && it <= PROBE_REP + PROBE_NREP) ? it - PROBE_REP : 0;
        unsigned ones = ~0u; asm volatile("" : "+s"(ones));
        int tid = wave_s * 64 + (int)__builtin_amdgcn_mbcnt_hi(ones, __builtin_amdgcn_mbcnt_lo(ones, 0u)); asm volatile("" : "+v"(tid));
        Ctx a; a.ws = args.ws; a.out = args.out; a.tbl = ptab; a.bid = blockIdx.x; asm volatile("" : "+s"(a.ws)); asm volatile("" : "+s"(a.out)); asm volatile("" : "+s"(a.bid));
        int G = G0; asm volatile("" : "+s"(G));
        const float* modb = (const float*)(a.ws + WS_MOD);
        if (ph == 0) { if (ENB(0)) p0_prologue(a, lds, G, tid); }
        else {
            const int l = (ph - 1) / 10, q = (ph - 1) % 10;
            switch (q) {
            case 0: if (ENB(1)) norm_phase(a, l, 0, G, tid); break;
            case 1: if (ENB(2)) { gates_phase(a, l, G, tid);
                pg8::Gemm g{(const pg8::bf16_t*)(a.ws + WS_H), (const pg8::bf16_t*)(a.ws + WS_WIN) + (size_t)l * 2048 * 1024, MTOK, 2048, 1024, 1024, 0};
                pg8::StaticOrder S; S.init(MTOK, 2048, G, a.bid);
                EpiG1 E{l, a.ws, a.out, inp(a, I_QG) + l * 64, inp(a, I_KG) + l * 64};
                pg8::gemm_phase<EpiG1, pg8::StaticOrder, true, true>(tid, ldsl, g, S, E); } break;
            case 2: if (ENB(3)) mix_phase(a, l, rep, lds, MISC, tid); break;
            case 3: if (ENB(4)) fin_phase(a, l, G, tid); break;
            case 4: if (ENB(5)) { pg8::Gemm g{(const pg8::bf16_t*)(a.ws + WS_SU), (const pg8::bf16_t*)(a.ws + WS_GLUT) + (size_t)l * 256 * 256, MTOK, 256, 256, 256, 0};
                pg8::StaticOrder S; S.init(MTOK, 256, G, a.bid);
                EpiGlu E{(const bf16*)(a.ws + WS_SU), (bf16*)(a.ws + WS_MIX), inp(a, I_GLUB) + l * 256};
                pg8::gemm_phase<EpiGlu, pg8::StaticOrder, true, true>(tid, ldsl, g, S, E); } break;
            case 5: if (ENB(6)) { pg8::Gemm g{(const pg8::bf16_t*)(a.ws + WS_MIX), (const pg8::bf16_t*)(a.ws + WS_WOUT) + (size_t)l * 1024 * 1024, MTOK, 1024, 1024, 1024, 0};
                pg8::StaticOrder S; S.init(MTOK, 1024, G, a.bid);
                EpiResid E{l == 0 ? inp(a, I_XP) : a.out + OUT_Y, l == 0 ? inp(a, I_XS) : a.out + OUT_Y + (size_t)NPROMPT * DM, a.out + OUT_Y, (rep && l == 1) ? (const float*)(a.ws + 131072) : modb + (size_t)l * 9 * 6144 + 2 * 1024};
                pg8::gemm_phase<EpiResid, pg8::StaticOrder, true, true>(tid, ldsl, g, S, E); } break;
            case 6: if (ENB(7)) norm_phase(a, l, 1, G, tid); break;
            case 7: if (ENB(8)) { pg8::Gemm g{(const pg8::bf16_t*)(a.ws + WS_H), (const pg8::bf16_t*)(a.ws + WS_WGU) + (size_t)l * NGU * 1024, MTOK, NGU, 1024, 1024, 0};
                StripOrder S{G, a.bid};
                EpiG3 E{(bf16*)(a.ws + WS_BIG), inp(a, I_CW) + (size_t)l * 3 * DFF, inp(a, I_CB) + (size_t)l * DFF, (LAS float*)(ldsl + XR_OFF)};
                pg8::gemm_phase<EpiG3, StripOrder, true, true>(tid, ldsl, g, S, E); } break;
            case 8: break;
            case 9: if (ENB(10)) { pg8::Gemm g{(const pg8::bf16_t*)(a.ws + WS_BIG), (const pg8::bf16_t*)(a.ws + WS_WDN) + (size_t)l * 1024 * DFF, MTOK, 1024, DFF, DFF, 0};
                pg8::StaticOrder S; S.init(MTOK, 1024, G, a.bid);
                EpiResid E{a.out + OUT_Y, a.out + OUT_Y + (size_t)NPROMPT * DM, a.out + OUT_Y, rep ? (const float*)(a.ws + 131072) : modb + (size_t)l * 9 * 6144 + 5 * 1024};
                pg8::gemm_phase<EpiResid, pg8::StaticOrder, true, true>(tid, ldsl, g, S, E); } break;
            }
        }
        if (it + 1 < hi) xcd_barrier(bar);
        if (PROBE_XBAR && it + 1 < hi) { for (int xb = 0; xb < PROBE_XBAR; ++xb) xcd_barrier(bar); }
    }
}

extern "C" void kernel_launch(void* const* d_in, const int* in_sizes, int n_in, void* d_out, int out_size, void* d_ws, size_t ws_size, hipStream_t stream) {
    static int grid = 0;
    if (grid == 0) {
        if (n_in != 36 || ws_size < WS_END) { fprintf(stderr, "kernel_launch: unexpected inputs (n_in %d, ws %zu)\n", n_in, ws_size); grid = -1; return; }
        int dev = 0, cus = 0, per_cu = 0;
        if (hipGetDevice(&dev) != hipSuccess || hipDeviceGetAttribute(&cus, hipDeviceAttributeMultiprocessorCount, dev) != hipSuccess) { grid = -1; return; }
        if (hipFuncSetAttribute((const void*)hyb_fwd, hipFuncAttributeMaxDynamicSharedMemorySize, LDS_BYTES) != hipSuccess) { fprintf(stderr, "kernel_launch: hipFuncSetAttribute failed\n"); grid = -1; return; }
        if (hipOccupancyMaxActiveBlocksPerMultiprocessor(&per_cu, (const void*)hyb_fwd, NWAVES * 64, LDS_BYTES) != hipSuccess || per_cu < 1) { fprintf(stderr, "kernel_launch: occupancy query says %d\n", per_cu); }
        (void)hipGetLastError();
        grid = cus;
    }
    if (grid < 0) return;
    (void)hipMemsetAsync((char*)d_ws + WS_CTL, 0, CTL_ZERO_BYTES, stream);
    Args a{};
    for (int i = 0; i < 36; ++i) a.in[i] = (const float*)d_in[i];
    a.out = (float*)d_out; a.ws = (unsigned char*)d_ws;
#if MK_SPLIT
    for (int ph = 0; ph < N_PHASES; ++ph) { a.ph_lo = ph; a.ph_hi = ph + 1; hipLaunchKernelGGL(hyb_fwd, dim3(grid), dim3(NWAVES * 64), LDS_BYTES, stream, a); }
#else
    a.ph_lo = 0; a.ph_hi = N_PHASES + (PROBE_REP >= 0 ? PROBE_NREP : 0);
    hipLaunchKernelGGL(hyb_fwd, dim3(grid), dim3(NWAVES * 64), LDS_BYTES, stream, a);
#endif
}
```

```cpp
#include <hip/hip_runtime.h>
#include <hip/hip_bf16.h>
#include <cstdio>
#include <cstdint>
#include <cmath>
namespace pg8 {
#define PG8_LAS __attribute__((address_space(3)))
typedef unsigned short bf16_t;
typedef short bf16x8 __attribute__((ext_vector_type(8)));
typedef float f32x4 __attribute__((ext_vector_type(4)));
typedef unsigned u32x4 __attribute__((ext_vector_type(4)));
constexpr int BM = 256, BK = 64, HALF = 128, HTB = HALF * BK * 2  , STAGE_BYTES = 8 * HTB, NXCD = 8, WGM = 8;

__host__ __device__ __forceinline__ int lds_byte(int r, int c) { const int st = (r >> 4) * 2 + (c >> 5), rr = r & 15, cc = c & 31, ob = rr * 64 + cc * 2; return st * 1024 + (ob ^ (((ob >> 9) & 1) << 5)); }
__host__ __device__ __forceinline__ void stage_rc(int b, int& R, int& C) { const int st = b / 1024, sb = b % 1024, swz = sb ^ (((sb >> 9) & 1) << 5); R = (st >> 1) * 16 + swz / 64; C = (st & 1) * 32 + (swz % 64) / 2; }
__host__ __device__ __forceinline__ int perm32(int rho) { const int n = rho >> 4, i = rho & 15; return 8 * (i >> 2) + 4 * n + (i & 3); }

struct Unit { int pm, pn; };
struct Gemm { const bf16_t* A; const bf16_t* Bt; int M, N, K; int lda; int amode; };

struct StaticOrder {
    int nM, nN, nwg, G, c;
    __host__ __device__ void init(int M, int N, int G_, int c_) { nM = M / BM; nN = N / BM; nwg = nM * nN; G = G_; c = c_; }
    __host__ __device__ bool next(int i, Unit& u) const {
        const long L = (long)i * G + c; if (L >= nwg) return false;
        int wgid = (int)L; { const int q = nwg / NXCD, r = nwg % NXCD, xcd = wgid % NXCD, off = wgid / NXCD; wgid = (xcd < r ? xcd * (q + 1) : r * (q + 1) + (xcd - r) * q) + off; }
        const int nig = WGM * nN, gid = wgid / nig, fm = gid * WGM, gsz = (nM - fm) < WGM ? (nM - fm) : WGM;
        u.pm = fm + ((wgid % nig) % gsz); u.pn = (wgid % nig) / gsz; return true;
    }
    __device__ __forceinline__ void a_ready(const Unit&) const {}
    __device__ __forceinline__ void done(const Unit&) const {}
};

__device__ __forceinline__ unsigned cvt_pk_bf16(float lo, float hi) { unsigned r; asm volatile("v_cvt_pk_bf16_f32 %0, %1, %2" : "=v"(r) : "v"(lo), "v"(hi)); return r; }
typedef float f32x2 __attribute__((ext_vector_type(2)));
__device__ __forceinline__ f32x2 gelu_pk(f32x2 v) {
    const f32x2 av = __builtin_elementwise_abs(v), d = av * 0.2316418882f + 1.0f;
    f32x2 t; t.x = __builtin_amdgcn_rcpf(d.x); t.y = __builtin_amdgcn_rcpf(d.y);
    f32x2 q = t * 0.5307027145f + (-0.7265760135f); q = q * t + 0.7107068705f; q = q * t + (-0.142248368f); q = q * t + 0.127414796f; q = q * t;
    const f32x2 s = (v * v) * (-0.72134752044f);
    f32x2 e; e.x = __builtin_amdgcn_exp2f(s.x); e.y = __builtin_amdgcn_exp2f(s.y);
    const f32x2 m = v * (q * e), r = v - m;
    f32x2 o; o.x = v.x < 0.f ? m.x : r.x; o.y = v.y < 0.f ? m.y : r.y; return o;
}

template <int ACT  > struct EpiBf16 {
    static constexpr bool PERM = true, AFTER_DRAIN = false; static_assert(ACT == 0 || ACT == 1, "EpiBf16: ACT is 0 (none) or 1 (gelu_pk)");
    bf16_t* O; int ldc; const float* bias; int split_cols; size_t split_stride; float scale0;
    __device__ __forceinline__ void operator()(const f32x4 (&acc)[2][2][4][2], const Unit& u, int wr, int wc, int fr, int fq) const {
        const int row0 = u.pm * BM + wr * 64 + fr; int colt = u.pn * BM; bf16_t* base = O;
        float sc = 1.f; if (split_cols) { const int t = colt / split_cols; base += (size_t)t * split_stride; colt -= t * split_cols; if (t == 0) sc = scale0; }
        const int col0 = colt + wc * 32 + 8 * fq, bcol0 = u.pn * BM + wc * 32 + 8 * fq;
        f32x4 bv[2][2];
#pragma unroll
        for (int bj = 0; bj < 2; ++bj)
#pragma unroll
            for (int n = 0; n < 2; ++n) bv[bj][n] = bias ? *(const f32x4*)(bias + bcol0 + bj * HALF + 4 * n) : (f32x4){0.f, 0.f, 0.f, 0.f};
#pragma unroll
        for (int ai = 0; ai < 2; ++ai)
#pragma unroll
            for (int m = 0; m < 4; ++m) { bf16_t* rowp = base + (size_t)(row0 + ai * HALF + m * 16) * ldc + col0;
#pragma unroll
                for (int bj = 0; bj < 2; ++bj) { f32x4 v0 = acc[ai][bj][m][0] + bv[bj][0], v1 = acc[ai][bj][m][1] + bv[bj][1];
                    if (ACT == 1) { f32x2 a = gelu_pk((f32x2){v0[0], v0[1]}), b = gelu_pk((f32x2){v0[2], v0[3]}), c = gelu_pk((f32x2){v1[0], v1[1]}), d = gelu_pk((f32x2){v1[2], v1[3]});
                        v0 = (f32x4){a.x, a.y, b.x, b.y}; v1 = (f32x4){c.x, c.y, d.x, d.y}; }
                    v0 = v0 * sc; v1 = v1 * sc; u32x4 w; w.x = cvt_pk_bf16(v0[0], v0[1]); w.y = cvt_pk_bf16(v0[2], v0[3]); w.z = cvt_pk_bf16(v1[0], v1[1]); w.w = cvt_pk_bf16(v1[2], v1[3]);
                    *(u32x4*)(rowp + bj * HALF) = w; } }
    }
};


template <class Epi, class Sched, bool ALIGN_EPI = false, bool SP2 = false>
__device__ __forceinline__ void gemm_phase(const int tid, PG8_LAS unsigned char* lds, const Gemm g, const Sched& S, const Epi& E) {
    const int wid = __builtin_amdgcn_readfirstlane(tid >> 6), lane = tid & 63, wr = wid >> 2, wc = wid & 3, fr = lane & 15, fq = lane >> 4;
    const int K = g.K, nt = K / BK;
    unsigned voffA[2], voffB[2];
#pragma unroll
    for (int i = 0; i < 2; ++i) { int R, C; stage_rc(tid * 16 + i * 8192, R, C); const int Rb = Epi::PERM ? ((R & ~31) + perm32(R & 31)) : R;
        voffA[i] = (unsigned)(R * g.lda + C) * 2u; voffB[i] = (unsigned)(Rb * K + C) * 2u; }
    const size_t kstep = (size_t)(BK * 2);
    const size_t hstepA = (size_t)HALF * g.lda * 2, hstepB = (size_t)HALF * K * 2;
    const size_t tstepA = 2 * hstepA, tstepB = 2 * hstepB;
    const int amode = g.amode;
#define PG8_AK(t) ((size_t)(amode ? (((t) >> 1) * 512 + ((t) & 1) * 128) : ((t) * 128)))
    const unsigned ldsw = (unsigned)wid * 1024u;
    const int aoff = lds_byte(wr * 64 + fr, fq * 8), boff = lds_byte(wc * 32 + fr, fq * 8);
#define PG8_SA(b, h) (((b) * 2 + (h)) * HTB)
#define PG8_SB(b, h) ((4 + (b) * 2 + (h)) * HTB)
#define PG8_STAGE(bufoff, gbase, voff) do { _Pragma("unroll") for (int _i = 0; _i < 2; ++_i) \
        __builtin_amdgcn_global_load_lds((const unsigned*)((const char*)(gbase) + (voff)[_i]), (PG8_LAS unsigned*)(lds + (bufoff) + ldsw + _i * 8192), 16, 0, 0); } while (0)
#define PG8_LDA(dst, b, h) do { _Pragma("unroll") for (int m = 0; m < 4; ++m) _Pragma("unroll") for (int k = 0; k < 2; ++k) dst[m][k] = *(const PG8_LAS bf16x8*)(lds + PG8_SA(b, h) + aoff + m * 2048 + k * 1024); } while (0)
#define PG8_LDB(dst, b, h) do { _Pragma("unroll") for (int n = 0; n < 2; ++n) _Pragma("unroll") for (int k = 0; k < 2; ++k) dst[n][k] = *(const PG8_LAS bf16x8*)(lds + PG8_SB(b, h) + boff + n * 2048 + k * 1024); } while (0)
#define PG8_MMA(ai, bj, At, Bt) do { __builtin_amdgcn_s_setprio(1); _Pragma("unroll") for (int m = 0; m < 4; ++m) _Pragma("unroll") for (int n = 0; n < 2; ++n) _Pragma("unroll") for (int k = 0; k < 2; ++k) \
        acc[ai][bj][m][n] = __builtin_amdgcn_mfma_f32_16x16x32_bf16(Bt[n][k], At[m][k], acc[ai][bj][m][n], 0, 0, 0); __builtin_amdgcn_s_setprio(0); } while (0)
#define PG8_WAIT_V(n) asm volatile("s_waitcnt vmcnt(" #n ")" ::: "memory")
#define PG8_WAIT_L(n) asm volatile("s_waitcnt lgkmcnt(" #n ")" ::: "memory")
#define PG8_BAR __builtin_amdgcn_s_barrier()
#define PG8_SCHED __builtin_amdgcn_sched_barrier(0)
    Unit cur, nxt; int ui = 0;
    if (!S.next(0, cur)) return;
    f32x4 acc[2][2][4][2];
#pragma unroll
    for (int a = 0; a < 2; ++a)
#pragma unroll
        for (int b = 0; b < 2; ++b)
#pragma unroll
            for (int m = 0; m < 4; ++m)
#pragma unroll
                for (int n = 0; n < 2; ++n) acc[a][b][m][n] = (f32x4){0.f, 0.f, 0.f, 0.f};
    bf16x8 At[4][2], B0[2][2], B1[2][2];
    const char* cA = (const char*)g.A + (size_t)cur.pm * tstepA; const char* cB = (const char*)g.Bt + (size_t)cur.pn * tstepB;
    S.a_ready(cur);
    if constexpr (SP2) {
        PG8_STAGE(PG8_SB(0, 0), cB, voffB); PG8_STAGE(PG8_SB(0, 1), cB + hstepB, voffB); PG8_STAGE(PG8_SA(0, 0), cA, voffA); PG8_STAGE(PG8_SA(0, 1), cA + hstepA, voffA);
        if (wr == 1) PG8_BAR;
        PG8_WAIT_V(2); PG8_BAR;
        PG8_STAGE(PG8_SB(1, 0), cB + kstep, voffB); PG8_STAGE(PG8_SA(1, 0), cA + kstep, voffA); PG8_STAGE(PG8_SB(1, 1), cB + hstepB + kstep, voffB);
        PG8_WAIT_V(6); PG8_BAR;
    } else {
        PG8_STAGE(PG8_SB(0, 0), cB, voffB); PG8_STAGE(PG8_SA(0, 0), cA, voffA); PG8_STAGE(PG8_SB(0, 1), cB + hstepB, voffB); PG8_STAGE(PG8_SA(0, 1), cA + hstepA, voffA);
        if (wr == 1) PG8_BAR;
        PG8_WAIT_V(4); PG8_BAR;
        PG8_STAGE(PG8_SB(1, 0), cB + kstep, voffB); PG8_STAGE(PG8_SA(1, 0), cA + kstep, voffA); PG8_STAGE(PG8_SB(1, 1), cB + hstepB + kstep, voffB);
        PG8_WAIT_V(6); PG8_BAR;
    }
    for (;;) {
        const bool has_next = S.next(ui + 1, nxt);
        const char* nA = has_next ? (const char*)g.A + (size_t)nxt.pm * tstepA : cA; const char* nB = has_next ? (const char*)g.Bt + (size_t)nxt.pn * tstepB : cB;
        for (int t = 0; t < nt; t += 2) {
            const bool last = (t == nt - 2);
            const char* a1 = cA + PG8_AK(t + 1);
            const char* a2 = last ? nA : cA + PG8_AK(t + 2); const char* b2 = last ? nB : cB + (size_t)(t + 2) * kstep;
            const char* a3 = a2 + kstep; const char* b3 = b2 + kstep;
            if (last && has_next) S.a_ready(nxt);
            if constexpr (SP2) {
            PG8_LDB(B0, 0, 0); PG8_LDB(B1, 0, 1); PG8_SCHED; PG8_LDA(At, 0, 0); PG8_STAGE(PG8_SA(1, 1), a1 + hstepA, voffA);
            PG8_WAIT_V(8); PG8_WAIT_L(0); PG8_BAR; PG8_MMA(0, 0, At, B0); PG8_MMA(0, 1, At, B1); PG8_BAR; PG8_SCHED;
            PG8_LDA(At, 0, 1); PG8_STAGE(PG8_SB(0, 0), b2, voffB); PG8_STAGE(PG8_SB(0, 1), b2 + hstepB, voffB); PG8_STAGE(PG8_SA(0, 0), a2, voffA);
            PG8_WAIT_V(8); PG8_WAIT_L(0); PG8_BAR; PG8_MMA(1, 0, At, B0); PG8_MMA(1, 1, At, B1); PG8_BAR; PG8_SCHED;
            PG8_LDB(B0, 1, 0); PG8_LDB(B1, 1, 1); PG8_SCHED; PG8_LDA(At, 1, 0); PG8_STAGE(PG8_SA(0, 1), a2 + hstepA, voffA);
            PG8_WAIT_V(8); PG8_WAIT_L(0); PG8_BAR; PG8_MMA(0, 0, At, B0); PG8_MMA(0, 1, At, B1); PG8_BAR; PG8_SCHED;
            PG8_LDA(At, 1, 1); PG8_STAGE(PG8_SB(1, 0), b3, voffB); PG8_STAGE(PG8_SB(1, 1), b3 + hstepB, voffB); PG8_STAGE(PG8_SA(1, 0), a3, voffA);
            PG8_WAIT_V(8); PG8_WAIT_L(0); PG8_BAR; PG8_MMA(1, 0, At, B0); PG8_MMA(1, 1, At, B1); PG8_BAR; PG8_SCHED;
            } else {
            PG8_LDB(B0, 0, 0); PG8_SCHED; PG8_LDA(At, 0, 0); PG8_STAGE(PG8_SA(1, 1), a1 + hstepA, voffA);
            PG8_WAIT_L(8); PG8_BAR; PG8_WAIT_L(0); PG8_MMA(0, 0, At, B0); PG8_BAR; PG8_SCHED;
            PG8_LDB(B1, 0, 1); PG8_STAGE(PG8_SB(0, 0), b2, voffB);
            PG8_BAR; PG8_WAIT_L(0); PG8_MMA(0, 1, At, B1); PG8_BAR;
            PG8_LDA(At, 0, 1); PG8_STAGE(PG8_SA(0, 0), a2, voffA);
            PG8_BAR; PG8_WAIT_L(0); PG8_MMA(1, 0, At, B0); PG8_BAR; PG8_SCHED;
            PG8_STAGE(PG8_SB(0, 1), b2 + hstepB, voffB);
            PG8_WAIT_V(6); PG8_BAR; PG8_MMA(1, 1, At, B1); PG8_BAR;
            PG8_LDB(B0, 1, 0); PG8_SCHED; PG8_LDA(At, 1, 0); PG8_STAGE(PG8_SA(0, 1), a2 + hstepA, voffA);
            PG8_WAIT_L(8); PG8_BAR; PG8_WAIT_L(0); PG8_MMA(0, 0, At, B0); PG8_BAR; PG8_SCHED;
            PG8_LDB(B1, 1, 1); PG8_STAGE(PG8_SB(1, 0), b3, voffB);
            PG8_BAR; PG8_WAIT_L(0); PG8_MMA(0, 1, At, B1); PG8_BAR;
            PG8_LDA(At, 1, 1); PG8_STAGE(PG8_SA(1, 0), a3, voffA);
            PG8_BAR; PG8_WAIT_L(0); PG8_MMA(1, 0, At, B0); PG8_BAR; PG8_SCHED;
            PG8_STAGE(PG8_SB(1, 1), b3 + hstepB, voffB);
            PG8_WAIT_V(6); PG8_BAR; PG8_MMA(1, 1, At, B1); PG8_BAR;
            }
        }
        if constexpr (ALIGN_EPI) { if (wr == 0) PG8_BAR; }
        if constexpr (!Epi::AFTER_DRAIN) { int fr_ = fr, fq_ = fq; asm volatile("" : "+v"(fr_), "+v"(fq_));
            E(acc, cur, wr, wc, fr_, fq_); S.done(cur); }
        if (!has_next) break;
#pragma unroll
        for (int a = 0; a < 2; ++a)
#pragma unroll
            for (int b = 0; b < 2; ++b)
#pragma unroll
                for (int m = 0; m < 4; ++m)
#pragma unroll
                    for (int n = 0; n < 2; ++n) acc[a][b][m][n] = (f32x4){0.f, 0.f, 0.f, 0.f};
        cur = nxt; cA = nA; cB = nB; ++ui;
        if constexpr (ALIGN_EPI) { if (wr == 1) PG8_BAR; }
    }
    PG8_WAIT_V(0);
    if constexpr (!ALIGN_EPI) { if (wr == 0) PG8_BAR; }
    PG8_BAR;
    if constexpr (Epi::AFTER_DRAIN) { E.fused(acc, cur, wr, wc, fr, fq, lds, wid, lane); S.done(cur); }
#undef PG8_AK
#undef PG8_SA
#undef PG8_SB
#undef PG8_STAGE
#undef PG8_LDA
#undef PG8_LDB
#undef PG8_MMA
#undef PG8_WAIT_V
#undef PG8_WAIT_L
#undef PG8_BAR
#undef PG8_SCHED
}
}

#include <hip/hip_bf16.h>
#include <cmath>
namespace attn_body {
using bf16=__hip_bfloat16;
using bf16x8=__attribute__((ext_vector_type(8)))short;
using s16x4=__attribute__((ext_vector_type(4)))short;
using f32x16=__attribute__((ext_vector_type(16)))float;
using u32x4=__attribute__((ext_vector_type(4)))unsigned;
constexpr int D=64;
constexpr int NW=8,QBLK=32,QB=QBLK*NW,KVBLK=64;
constexpr int ATTN_UNIT_ROWS=QB;
__device__ __forceinline__ int crow(int r,int hi){return (r&3)+8*(r>>2)+4*hi;}
#define SBAR() __builtin_amdgcn_sched_barrier(0)
__device__ __forceinline__ void cmask(f32x16&p0,f32x16&p1,int jb,int qrel,int hi){
  const float NEG=-INFINITY; int kb=64*jb+4*hi;
  #pragma unroll
  for(int r=0;r<16;++r){int kv=kb+(r&3)+8*(r>>2); if(kv>qrel)p0[r]=NEG; if(kv+32>qrel)p1[r]=NEG;}
}

constexpr int NSLOT=3, SLOTB=8192;
constexpr int LDS_K=0, LDS_V=NSLOT*SLOTB, LDS_WS=2*NSLOT*SLOTB, LDS_OST=LDS_WS+NW*64*4, LDS_BYTES=LDS_OST+NW*4096;
constexpr float C2=0.125f*1.4426950408889634f;
__device__ __forceinline__ void glds16(const void*gsrc,unsigned lds_dst){unsigned keep;
  asm volatile("s_mov_b32 %0, m0\n\ts_mov_b32 m0, %2\n\ts_nop 0\n\tglobal_load_lds_dwordx4 %1, off\n\ts_mov_b32 m0, %0":"=&s"(keep):"v"(gsrc),"s"(lds_dst):"memory");}
__device__ __forceinline__ float max3f(float a,float b,float c){float r;asm("v_max3_f32 %0, %1, %2, %3":"=v"(r):"v"(a),"v"(b),"v"(c));return r;}
__device__ __forceinline__ float max2f(float a,float b){float r;asm("v_max_f32_e32 %0, %1, %2":"=v"(r):"v"(a),"v"(b));return r;}
__device__ __forceinline__ float fadd_s(float a,float b){float r;asm("v_add_f32_e32 %0, %1, %2":"=v"(r):"v"(a),"v"(b));return r;}
__device__ __forceinline__ float fsub_s(float a,float b){float r;asm("v_sub_f32_e32 %0, %1, %2":"=v"(r):"v"(a),"v"(b));return r;}
typedef float f32x2_t __attribute__((ext_vector_type(2))); typedef __bf16 bf16x2_t __attribute__((ext_vector_type(2)));
__device__ __forceinline__ unsigned cvtpk_s(float lo,float hi){f32x2_t v={lo,hi};bf16x2_t b=__builtin_convertvector(v,bf16x2_t);return __builtin_bit_cast(unsigned,b);}
#define WAIT_BAR(N) asm volatile("s_waitcnt vmcnt(" #N ") lgkmcnt(0)\n\ts_barrier":::"memory")

__device__ __forceinline__ void qkt(f32x16&p0,f32x16&p1,const char*Kslot,const bf16x8*qr,const f32x16&negm,int r32,int hi){
  const char*kb=Kslot+hi*1024+r32*16;
  #pragma unroll
  for(int d0=0;d0<4;++d0){
    const bf16x8 b0=*reinterpret_cast<const bf16x8*>(kb+d0*2048);
    const bf16x8 b1=*reinterpret_cast<const bf16x8*>(kb+d0*2048+512);
    if(d0==0){p0=__builtin_amdgcn_mfma_f32_32x32x16_bf16(b0,qr[0],negm,0,0,0);p1=__builtin_amdgcn_mfma_f32_32x32x16_bf16(b1,qr[0],negm,0,0,0);}
    else{p0=__builtin_amdgcn_mfma_f32_32x32x16_bf16(b0,qr[d0],p0,0,0,0);p1=__builtin_amdgcn_mfma_f32_32x32x16_bf16(b1,qr[d0],p1,0,0,0);}}
}
typedef __attribute__((address_space(3))) const char* lds_cptr;
typedef short v4i16_t __attribute__((ext_vector_type(4)));
__device__ __forceinline__ void kload8(bf16x8*kf,lds_cptr kp){
  kf[0]=*(const __attribute__((address_space(3))) bf16x8*)(kp);      kf[1]=*(const __attribute__((address_space(3))) bf16x8*)(kp+512);
  kf[2]=*(const __attribute__((address_space(3))) bf16x8*)(kp+2048); kf[3]=*(const __attribute__((address_space(3))) bf16x8*)(kp+2560);
  kf[4]=*(const __attribute__((address_space(3))) bf16x8*)(kp+4096); kf[5]=*(const __attribute__((address_space(3))) bf16x8*)(kp+4608);
  kf[6]=*(const __attribute__((address_space(3))) bf16x8*)(kp+6144); kf[7]=*(const __attribute__((address_space(3))) bf16x8*)(kp+6656);
}
__device__ __forceinline__ void kload2(bf16x8*kf,lds_cptr kp,int j){ kf[2*j]=*(const __attribute__((address_space(3))) bf16x8*)(kp+j*2048); kf[2*j+1]=*(const __attribute__((address_space(3))) bf16x8*)(kp+j*2048+512); }
__device__ __forceinline__ s16x4 vtr(lds_cptr p){ return __builtin_bit_cast(s16x4,__builtin_amdgcn_ds_read_tr16_b64_v4i16((__attribute__((address_space(3))) v4i16_t*)p)); }
__device__ __forceinline__ float rowmax(const f32x16&p0,const f32x16&p1){
  float a=max3f(p0[0],p0[1],p1[0]),b=max3f(p0[2],p0[3],p1[1]);a=max3f(a,p1[2],p1[3]);
  #pragma unroll
  for(int r=4;r<16;r+=4){a=max3f(a,p0[r],p0[r+1]);b=max3f(b,p0[r+2],p0[r+3]);a=max3f(a,p1[r],p1[r+1]);b=max3f(b,p1[r+2],p1[r+3]);}
  const float m=max2f(a,b);
  auto rr=__builtin_amdgcn_permlane32_swap(__float_as_uint(m),__float_as_uint(m),false,false);
  return max2f(__uint_as_float(rr[0]),__uint_as_float(rr[1]));
}
__device__ __forceinline__ void pv(f32x16*o,int vb,bf16x8 pa0,bf16x8 pa1,bf16x8 pa2,bf16x8 pa3){
  #pragma unroll
  for(int d0=0;d0<2;++d0){s16x4 lo[4],hi[4];
    #pragma unroll
    for(int ks=0;ks<4;++ks){
      asm volatile("ds_read_b64_tr_b16 %0,%1 offset:%c2":"=&v"(lo[ks]):"v"(vb),"i"(d0*4096+ks*1024):"memory");
      asm volatile("ds_read_b64_tr_b16 %0,%1 offset:%c2":"=&v"(hi[ks]):"v"(vb),"i"(d0*4096+ks*1024+512):"memory");}
    asm volatile("s_waitcnt lgkmcnt(0)":::"memory");SBAR();
    #define PK(k) (bf16x8){lo[k][0],lo[k][1],lo[k][2],lo[k][3],hi[k][0],hi[k][1],hi[k][2],hi[k][3]}
    o[d0]=__builtin_amdgcn_mfma_f32_32x32x16_bf16(pa0,PK(0),o[d0],0,0,0);
    o[d0]=__builtin_amdgcn_mfma_f32_32x32x16_bf16(pa1,PK(1),o[d0],0,0,0);
    o[d0]=__builtin_amdgcn_mfma_f32_32x32x16_bf16(pa2,PK(2),o[d0],0,0,0);
    o[d0]=__builtin_amdgcn_mfma_f32_32x32x16_bf16(pa3,PK(3),o[d0],0,0,0);
    #undef PK
  }
}

#ifndef ATTN_STORE16
#define ATTN_STORE16(p,v) (*(u32x4*)(p)=(v))
#endif
template<int THRL> __device__ __forceinline__ void attn_unit(const bf16*Q0,const int QP,const bf16*__restrict__ Kh,const bf16*__restrict__ Vh,const int KP,bf16*O0,const int OP,const int NT,char*shm,const int tid){
  const int lane=tid&63,r32=lane&31,hi=lane>>5; const int wid=__builtin_amdgcn_readfirstlane(tid>>6);
  const bf16*Qw=Q0+(long)(wid*QBLK)*QP;
  const unsigned lds0=(unsigned)(uintptr_t)shm;
  float*wsf=(float*)(shm+LDS_WS)+wid*64;
  const bf16*ksrc=Kh+(long)lane*KP+wid*8;
  const bf16*vsrc=Vh+(long)(16*(wid&3)+(lane>>2))*KP+(wid>>2)*32+(lane&3)*8;
  const unsigned kdst=lds0+LDS_K+wid*1024, vdst=lds0+LDS_V+wid*1024;
  #define DMA_K(t,slot) glds16(ksrc+(long)(t)*KVBLK*KP,(unsigned)__builtin_amdgcn_readfirstlane(kdst+(slot)))
  #define DMA_V(t,slot) glds16(vsrc+(long)(t)*KVBLK*KP,(unsigned)__builtin_amdgcn_readfirstlane(vdst+(slot)))
  const int vb0=(int)(lds0+LDS_V)+((lane>>4)&1)*32+(lane&3)*8+(4*hi+((lane&15)>>2))*64;
  const char*Kbase=shm+LDS_K; bf16x8 kf[8];
  const lds_cptr shm3=(lds_cptr)shm; const lds_cptr kp0=shm3+LDS_K+hi*1024+r32*16; const lds_cptr vp0=shm3+LDS_V+((lane>>4)&1)*32+(lane&3)*8+(4*hi+((lane&15)>>2))*64;
  DMA_K(0,0);DMA_V(0,0);DMA_K(1,SLOTB);
  bf16x8 qr[4];
  #pragma unroll
  for(int d0=0;d0<4;++d0)qr[d0]=*reinterpret_cast<const bf16x8*>(&Qw[(long)r32*QP+d0*16+hi*8]);
  float mhat=0.f,l_reg=0.f;f32x16 o[2];o[0]=f32x16{};o[1]=f32x16{};f32x16 negm=f32x16{};asm volatile("":"+v"(negm));
  #define CMASK(P0,P1,t) do{}while(0)
  bool resc=false;
  #define START(P0,P1) do{ const float rm=rowmax(P0,P1); resc=false; \
    { const float dl=rm; mhat=fadd_s(mhat,dl); \
      _Pragma("unroll") for(int r=0;r<16;++r){P0[r]=fsub_s(P0[r],dl);P1[r]=fsub_s(P1[r],dl);} \
      _Pragma("unroll") for(int r=0;r<16;++r)negm[r]=-mhat; asm volatile("":"+v"(negm)); } \
    _Pragma("unroll") for(int r=0;r<16;++r)P0[r]=__builtin_amdgcn_exp2f(P0[r]); }while(0)
  #define RESC() do{ if(resc){ asm volatile("s_waitcnt lgkmcnt(0)":::"memory"); \
      _Pragma("unroll") for(int d_=0;d_<2;++d_) _Pragma("unroll") for(int r=0;r<16;++r)o[d_][r]*=wsf[crow(r,hi)]; } }while(0)
  f32x16 pA0,pA1,pB0,pB1;
  int sl_prev=0,sl_cur=0,sl_next=SLOTB;
  #define ROT() do{sl_prev=sl_cur;sl_cur=sl_next;sl_next=(sl_next==(NSLOT-1)*SLOTB)?0:sl_next+SLOTB;}while(0)
  DMA_K(2,2*SLOTB);
  WAIT_BAR(3);
  qkt(pA0,pA1,Kbase,qr,negm,r32,hi);asm volatile("s_nop 15\n\ts_nop 7":"+v"(pA0),"+v"(pA1));CMASK(pA0,pA1,0);
  START(pA0,pA1);
  _Pragma("unroll") for(int r=0;r<16;++r)pA1[r]=__builtin_amdgcn_exp2f(pA1[r]);
  WAIT_BAR(0);
  DMA_K(3,0);DMA_V(1,SLOTB);
  ROT();
  kload8(kf,kp0+sl_cur);
  WAIT_BAR(2);
  s16x4 vlo[8],vhi[8]; u32x4 pw0,pw1,pw2,pw3;
  #define PKW(P,B) cvtpk_s(P[B],P[B+1])
  #define PAF(k) __builtin_bit_cast(bf16x8,pw##k)
  #define VFR(i) (bf16x8){vlo[i][0],vlo[i][1],vlo[i][2],vlo[i][3],vhi[i][0],vhi[i][1],vhi[i][2],vhi[i][3]}
  #define PIN(x) asm volatile("":"+v"(x))
  #define MX3(a,b,c) __builtin_fmaxf(__builtin_fmaxf((a),(b)),(c))
  #define GAPA(MF,A0,A1,A2,A3,W0,W1,PW) do{ MF; sacc+=A0; sacc+=A1; sacc+=A2; sacc+=A3; PIN(sacc); W0; W1; PIN(PW); SBAR(); }while(0)
  #define EX(v) __builtin_amdgcn_exp2f(v)
  #define GAPB(MF,X,B) do{ MF; X[B]=EX(X[B]); X[B+1]=EX(X[B+1]); X[B+2]=EX(X[B+2]); X[B+3]=EX(X[B+3]); PIN(X); SBAR(); }while(0)
  #define VRD(i) do{ vlo[i]=vtr(vp_+(((i)>>2)*4096+((i)&3)*1024)); vhi[i]=vtr(vp_+(((i)>>2)*4096+((i)&3)*1024+512)); }while(0)
  #define KRD(G,j) do{ if(G){ kload2(kf,kp0+sl_next,j); SBAR(); } }while(0)
  #define STEP(C0,C1,P0,P1,t,GK,GV,GL) do{ SBAR(); \
    const lds_cptr vp_=vp0+sl_prev; \
    VRD(0); SBAR(); float sacc=(P0[0]+P0[1]); \
    GAPA(C0=__builtin_amdgcn_mfma_f32_32x32x16_bf16(kf[0],qr[0],negm,0,0,0), P0[2],P0[3],P0[4],P0[5],     pw0[0]=PKW(P0,0), pw0[1]=PKW(P0,2), pw0); \
    VRD(4); SBAR(); GAPA(C1=__builtin_amdgcn_mfma_f32_32x32x16_bf16(kf[1],qr[0],negm,0,0,0), P0[6],P0[7],P0[8],P0[9],     pw0[2]=PKW(P0,4), pw0[3]=PKW(P0,6), pw0); \
    VRD(1); SBAR(); GAPA(C0=__builtin_amdgcn_mfma_f32_32x32x16_bf16(kf[2],qr[1],C0,0,0,0),   P0[10],P0[11],P0[12],P0[13], pw1[0]=PKW(P0,8), pw1[1]=PKW(P0,10), pw1); \
    VRD(5); SBAR(); GAPA(C1=__builtin_amdgcn_mfma_f32_32x32x16_bf16(kf[3],qr[1],C1,0,0,0),   P0[14],P0[15],P1[0],P1[1],   pw1[2]=PKW(P0,12),pw1[3]=PKW(P0,14), pw1); \
    VRD(2); SBAR(); GAPA(C0=__builtin_amdgcn_mfma_f32_32x32x16_bf16(kf[4],qr[2],C0,0,0,0),   P1[2],P1[3],P1[4],P1[5],     pw2[0]=PKW(P1,0), pw2[1]=PKW(P1,2), pw2); \
    VRD(6); SBAR(); GAPA(C1=__builtin_amdgcn_mfma_f32_32x32x16_bf16(kf[5],qr[2],C1,0,0,0),   P1[6],P1[7],P1[8],P1[9],     pw2[2]=PKW(P1,4), pw2[3]=PKW(P1,6), pw2); \
    VRD(3); SBAR(); GAPA(C0=__builtin_amdgcn_mfma_f32_32x32x16_bf16(kf[6],qr[3],C0,0,0,0),   P1[10],P1[11],P1[12],P1[13], pw3[0]=PKW(P1,8), pw3[1]=PKW(P1,10), pw3); \
    VRD(7); SBAR(); GAPA(C1=__builtin_amdgcn_mfma_f32_32x32x16_bf16(kf[7],qr[3],C1,0,0,0),   P1[14],P1[15],0.f,0.f,       pw3[2]=PKW(P1,12),pw3[3]=PKW(P1,14), pw3); \
    l_reg+=sacc; \
    if(GK){DMA_K((t)+3,sl_cur);} if(GV){DMA_V((t)+1,sl_next);} \
    CMASK(C0,C1,t); \
    { float a=MX3(C0[0],C0[1],C1[0]),b=MX3(C0[2],C0[3],C1[1]); a=MX3(a,C1[2],C1[3]); \
      _Pragma("unroll") for(int r=4;r<16;r+=4){a=MX3(a,C0[r],C0[r+1]);b=MX3(b,C0[r+2],C0[r+3]);a=MX3(a,C1[r],C1[r+1]);b=MX3(b,C1[r+2],C1[r+3]);} \
      float rm=__builtin_fmaxf(a,b); { auto rr=__builtin_amdgcn_permlane32_swap(__float_as_uint(rm),__float_as_uint(rm),false,false); rm=__builtin_fmaxf(__uint_as_float(rr[0]),__uint_as_float(rr[1])); } \
      resc=false; \
      if(__builtin_expect(__any(rm>(float)THRL),0)){ const float dl=__builtin_fmaxf(rm,0.f); mhat+=dl; \
        _Pragma("unroll") for(int r=0;r<16;++r){C0[r]-=dl;C1[r]-=dl;} \
        _Pragma("unroll") for(int r=0;r<16;++r)negm[r]=-mhat; asm volatile("":"+v"(negm)); \
        const float f=__builtin_amdgcn_exp2f(-dl); l_reg*=f; if(hi==0)wsf[r32]=f; resc=true; } } \
    SBAR(); \
    GAPB(o[0]=__builtin_amdgcn_mfma_f32_32x32x16_bf16(PAF(0),VFR(0),o[0],0,0,0), C0,0); \
    GAPB(o[1]=__builtin_amdgcn_mfma_f32_32x32x16_bf16(PAF(0),VFR(4),o[1],0,0,0), C0,4); \
    KRD(GL,0); GAPB(o[0]=__builtin_amdgcn_mfma_f32_32x32x16_bf16(PAF(1),VFR(1),o[0],0,0,0), C0,8); \
    KRD(GL,1); GAPB(o[1]=__builtin_amdgcn_mfma_f32_32x32x16_bf16(PAF(1),VFR(5),o[1],0,0,0), C0,12); \
    KRD(GL,2); GAPB(o[0]=__builtin_amdgcn_mfma_f32_32x32x16_bf16(PAF(2),VFR(2),o[0],0,0,0), C1,0); \
    KRD(GL,3); GAPB(o[1]=__builtin_amdgcn_mfma_f32_32x32x16_bf16(PAF(2),VFR(6),o[1],0,0,0), C1,4); \
    GAPB(o[0]=__builtin_amdgcn_mfma_f32_32x32x16_bf16(PAF(3),VFR(3),o[0],0,0,0), C1,8); \
    GAPB(o[1]=__builtin_amdgcn_mfma_f32_32x32x16_bf16(PAF(3),VFR(7),o[1],0,0,0), C1,12); \
    }while(0)
  int t=1;
  #undef CMASK
  #define CMASK(P0,P1,t) do{}while(0)
  for(;t+5<NT;t+=2){
    STEP(pB0,pB1,pA0,pA1,t,true,true,true);     WAIT_BAR(2); RESC(); ROT();
    STEP(pA0,pA1,pB0,pB1,t+1,true,true,true);   WAIT_BAR(2); RESC(); ROT();
  }
  #undef CMASK
  #define CMASK(P0,P1,t) do{}while(0)
  #define ENDW(tt) do{ if((tt)+3<NT){WAIT_BAR(2);} else if((tt)+2<NT){WAIT_BAR(1);} else {WAIT_BAR(0);} }while(0)
  for(;t+1<NT;t+=2){
    STEP(pB0,pB1,pA0,pA1,t,(t+3<NT),(t+1<NT),(t+1<NT));       ENDW(t);   RESC(); ROT();
    STEP(pA0,pA1,pB0,pB1,t+1,(t+4<NT),(t+2<NT),(t+2<NT));     ENDW(t+1); RESC(); ROT();
  }
  STEP(pB0,pB1,pA0,pA1,NT-1,false,false,false); RESC();
  { float sacc=pB0[0]+pB0[1]; _Pragma("unroll") for(int r=2;r<16;++r)sacc+=pB0[r]; _Pragma("unroll") for(int r=0;r<16;++r)sacc+=pB1[r]; l_reg+=sacc;
    pw0=(u32x4){PKW(pB0,0),PKW(pB0,2),PKW(pB0,4),PKW(pB0,6)};pw1=(u32x4){PKW(pB0,8),PKW(pB0,10),PKW(pB0,12),PKW(pB0,14)};pw2=(u32x4){PKW(pB1,0),PKW(pB1,2),PKW(pB1,4),PKW(pB1,6)};pw3=(u32x4){PKW(pB1,8),PKW(pB1,10),PKW(pB1,12),PKW(pB1,14)};
    SBAR(); pv(o,vb0+sl_cur,PAF(0),PAF(1),PAF(2),PAF(3)); }
  #undef PKW
  #undef PAF
  #undef VFR
  #undef PIN
  #undef MX3
  #undef GAPA
  #undef GAPB
  #undef EX
  #undef VRD
  #undef KRD
  #undef STEP
  #undef ENDW
  {auto rr=__builtin_amdgcn_permlane32_swap(__float_as_uint(l_reg),__float_as_uint(l_reg),false,false);l_reg=__uint_as_float(rr[0])+__uint_as_float(rr[1]);}
  if(hi==0)wsf[32+r32]=l_reg;asm volatile("s_waitcnt lgkmcnt(0)":::"memory");
  float rli[16];
  #pragma unroll
  for(int r=0;r<16;++r)rli[r]=__builtin_amdgcn_rcpf(wsf[32+crow(r,hi)]);
  bf16*Ow=O0+(long)(wid*QBLK)*OP;
  { bf16*stg=(bf16*)(shm+LDS_OST)+wid*2048;
    #pragma unroll
    for(int r=0;r<16;++r){const int orow=crow(r,hi);
      #pragma unroll
      for(int d0=0;d0<2;++d0)stg[orow*64+d0*32+r32]=__float2bfloat16(o[d0][r]*rli[r]);}
    asm volatile("s_waitcnt lgkmcnt(0)":::"memory");
    #pragma unroll
    for(int i=0;i<4;++i){const int row=i*8+(lane>>3),ch=lane&7; const u32x4 v=*(const u32x4*)(stg+row*64+ch*8); ATTN_STORE16(Ow+(long)row*OP+ch*8,v);} }
  asm volatile("s_waitcnt lgkmcnt(0)\n\ts_barrier":::"memory");
  #undef DMA_K
  #undef DMA_V
  #undef CMASK
  #undef START
  #undef RESC
  #undef ROT
}
constexpr int ATTN_LDS_BYTES=LDS_BYTES;
#undef SBAR
#undef WAIT_BAR
}

#define GAS __attribute__((address_space(1)))
#define LAS __attribute__((address_space(3)))
typedef unsigned short bf16;
typedef unsigned v4u __attribute__((ext_vector_type(4)));
typedef float f32x4 __attribute__((ext_vector_type(4)));
typedef short bf16x8 __attribute__((ext_vector_type(8)));
typedef GAS unsigned gu32;
typedef GAS unsigned long long gu64;
#define RLX_AGENT __ATOMIC_RELAXED, __HIP_MEMORY_SCOPE_AGENT
#define LDS_WAIT() asm volatile("s_waitcnt lgkmcnt(0)" ::: "memory")
#define VM_WAIT() asm volatile("s_waitcnt vmcnt(0)" ::: "memory")
__device__ __forceinline__ unsigned long long rt() { return __builtin_amdgcn_s_memrealtime(); }
__device__ __forceinline__ unsigned f2bf(float f) { unsigned u = __builtin_bit_cast(unsigned, f); return (u + 0x7fffu + ((u >> 16) & 1u)) >> 16; }
__device__ __forceinline__ unsigned pk2(float lo, float hi) { return f2bf(lo) | (f2bf(hi) << 16); }

#define XB_TMO      128
#define XB_XCNT(j)  (256  + 64 * (j))
#define XB_XSUB(j)  (1280 + 64 * (j))
#define XB_XGEN(j)  (2304 + 64 * (j))
#define XB_TOP      3328
#define XB_TOPGEN   3392
#define XCD_BAR_WORDS 3456
#define XB_SPIN_CAP (1u << 18)

__device__ __forceinline__ unsigned xb_ld(unsigned* p)              { return __hip_atomic_load(p, __ATOMIC_RELAXED, __HIP_MEMORY_SCOPE_AGENT); }
__device__ __forceinline__ unsigned xb_add(unsigned* p, unsigned v) { return __hip_atomic_fetch_add(p, v, __ATOMIC_RELAXED, __HIP_MEMORY_SCOPE_AGENT); }
__device__ __forceinline__ unsigned xb_xcc_id() { return (unsigned)__builtin_amdgcn_s_getreg((3 << 11) | 20) & 0xFu; }
#define XB_SPIN(cond, bar) do { unsigned _sp = 0; while (cond) { __builtin_amdgcn_s_sleep(1); \
    if ((++_sp & 255u) == 0u) { if (xb_ld(&(bar)[XB_TMO])) break; if (_sp > XB_SPIN_CAP) { atomicAdd(&(bar)[XB_TMO], 1u); break; } } } } while (0)

struct XcdBarrier {
    unsigned* bar; unsigned x;
    volatile LAS unsigned* st;
};

__device__ __forceinline__ XcdBarrier xcd_barrier_post(unsigned* bar, volatile LAS unsigned* st) {
    XcdBarrier b; b.bar = bar; b.x = xb_xcc_id(); b.st = st;
    if (threadIdx.x == 0) (void)xb_add(&bar[XB_XCNT(b.x)], 1u);
    return b;
}
__device__ __forceinline__ void xcd_barrier_complete(unsigned* bar, unsigned x, unsigned& nloc, unsigned& nx) {
    const unsigned G = gridDim.x * gridDim.y * gridDim.z;
    unsigned sum, cnt, mine, sp = 0u;
    for (;;) {
        sum = 0u; cnt = 0u; mine = 0u;
#pragma unroll
        for (unsigned j = 0; j < 16; ++j) { const unsigned c = xb_ld(&bar[XB_XCNT(j)]); sum += c; cnt += (c > 0u) ? 1u : 0u; mine = (j == x) ? c : mine; }
        if (sum == G) break;
        __builtin_amdgcn_s_sleep(1);
        if ((++sp & 255u) == 0u) { if (xb_ld(&bar[XB_TMO])) break; if (sp > XB_SPIN_CAP) { atomicAdd(&bar[XB_TMO], 1u); break; } }
    }
    nloc = mine > 0u ? mine : 1u; nx = cnt > 0u ? cnt : 1u;
}

__device__ __forceinline__ void xcd_barrier(const XcdBarrier& b) {
    asm volatile("s_waitcnt vmcnt(0)" ::: "memory");
    __syncthreads();
    if (threadIdx.x == 0) {
        unsigned* bar = b.bar;
        __builtin_amdgcn_s_waitcnt(0);
        unsigned nloc = b.st[0], nx = b.st[1];
        if (nloc == 0u) { xcd_barrier_complete(bar, b.x, nloc, nx); b.st[0] = nloc; b.st[1] = nx; }
        const unsigned old = xb_add(&bar[XB_XSUB(b.x)], 1u);
        const unsigned gen = old / nloc;
        if (old + 1u == (gen + 1u) * nloc) {
            __builtin_amdgcn_fence(__ATOMIC_RELEASE, "agent");
            asm volatile("s_waitcnt vmcnt(0)" ::: "memory");
            const unsigned og = xb_add(&bar[XB_TOP], 1u);
            const unsigned tg = og / nx;
            if (og + 1u == (tg + 1u) * nx) xb_add(&bar[XB_TOPGEN], 1u);
            else XB_SPIN(xb_ld(&bar[XB_TOPGEN]) == tg, bar);
            __builtin_amdgcn_fence(__ATOMIC_ACQUIRE, "agent");
            xb_add(&bar[XB_XGEN(b.x)], 1u);
            asm volatile("s_waitcnt vmcnt(0)" ::: "memory");
        } else {
            XB_SPIN(xb_ld(&bar[XB_XGEN(b.x)]) == gen, bar);
            __builtin_amdgcn_fence(__ATOMIC_ACQUIRE, "agent");
            asm volatile("s_waitcnt vmcnt(0)" ::: "memory");
        }
    }
    __syncthreads();
}

constexpr int NWAVES = 8;
#ifndef EN
#define EN 0xFFFF
#endif
#define ENB(b) ((EN >> (b)) & 1)
#ifndef PROBE_REP
#define PROBE_REP (-1)
#endif
#ifndef PROBE_NREP
#define PROBE_NREP 1
#endif
#ifndef PROBE_XBAR
#define PROBE_XBAR 0
#endif
#ifndef PROBE_MIXSEL
#define PROBE_MIXSEL 7
#endif
constexpr int DM = 1024, NPROMPT = 4096, NSAMPLE = 8192, MTOK = 12288, DFF = 2816, NGU = 5632;
constexpr float EPS = 1e-6f;
constexpr float QSCALE = 0.125f * 1.4426950408889634f;
typedef unsigned u32x2 __attribute__((ext_vector_type(2)));

constexpr size_t OUT_Y = 0;
constexpr size_t OUT_K = 12582912, OUT_V = 13631488, OUT_S5RE = 14680064, OUT_S5IM = 14745600, OUT_MC = 14811136, OUT_MN = 15859712, OUT_MM = 15876096;

constexpr size_t MiB = 1u << 20;
constexpr size_t WS_CTL = 0, CTL_ZERO_BYTES = 1 * MiB;
constexpr size_t WS_MOD = 1 * MiB;
constexpr size_t WS_ROPE = 1 * MiB + 512 * 1024;
constexpr size_t WS_S5W1 = 2 * MiB;
constexpr size_t WS_S5W2 = 10 * MiB;
constexpr size_t WS_S5A16 = 14 * MiB;
constexpr size_t WS_GLUT = 15 * MiB;
constexpr size_t WS_WGT = 15 * MiB + 512 * 1024;
constexpr size_t WS_WIN = 16 * MiB;
constexpr size_t WS_WOUT = 24 * MiB;
constexpr size_t WS_WGU = 28 * MiB;
constexpr size_t WS_WDN = 50 * MiB;
constexpr size_t WS_GATES = 61 * MiB;
constexpr size_t WS_H = 62 * MiB;
constexpr size_t WS_BIG = 86 * MiB;
constexpr size_t WS_Q = 86 * MiB;
constexpr size_t WS_KP = 98 * MiB, WS_KS = 99 * MiB, WS_VP = 102 * MiB, WS_VS = 103 * MiB;
constexpr size_t WS_SU = 106 * MiB, WS_MQ = 112 * MiB, WS_MK = 118 * MiB, WS_MV = 124 * MiB, WS_MO = 130 * MiB;
constexpr size_t WS_MIX = 136 * MiB;
constexpr size_t WS_Y5 = 160 * MiB;
constexpr size_t WS_HF = 172 * MiB, WS_HB = 184 * MiB;
constexpr size_t WS_END = 256 * MiB;
static_assert(WS_BIG + (size_t)MTOK * NGU * 2 <= WS_END && WS_HB + (size_t)MTOK * 256 * 4 <= WS_BIG + (size_t)MTOK * NGU * 2, "d_ws map");

constexpr int CW_BAR = 4096;
constexpr int CW_QUEUE = 16384;

constexpr int RING_BYTES = 131072, LDSCTL_OFF = RING_BYTES, MISC_OFF = LDSCTL_OFF + 320, LDS_BYTES = 147456;

struct Args { const float* in[36]; float* out; unsigned char* ws; int ph_lo, ph_hi; };
struct Ctx { float* out; unsigned char* ws; const LAS unsigned long long* tbl; int bid; };
__device__ __forceinline__ const float* inp(const Ctx& a, int i) { const unsigned long long v = a.tbl[i];
    const unsigned lo = __builtin_amdgcn_readfirstlane((unsigned)v), hi = __builtin_amdgcn_readfirstlane((unsigned)(v >> 32)); return (const float*)(((unsigned long long)hi << 32) | lo); }
enum { I_XP = 0, I_XS, I_C, I_CK, I_CV, I_S5RE, I_S5IM, I_MC, I_MN, I_MM, I_CCTX, I_ADAW, I_ADAB, I_N1G, I_N2G, I_WIN, I_QG, I_KG,
       I_ARE, I_AIM, I_LDT, I_BRE, I_BIM, I_CRE, I_CIM, I_S5D, I_GLUW, I_GLUB, I_MGB, I_MNG, I_WOUT, I_WG, I_WU, I_CW, I_CB, I_WD };

__device__ __forceinline__ float bf2f(unsigned short x) { return __uint_as_float(((unsigned)x) << 16); }
__device__ __forceinline__ float wave_sum(float v) {
#pragma unroll
    for (int o = 1; o < 64; o <<= 1) v += __shfl_xor(v, o);
    return v;
}
__device__ __forceinline__ float sigmoidf_(float x) { return 1.0f / (1.0f + __expf(-x)); }
__device__ __forceinline__ int bc_of_row(int r) { return r < NPROMPT ? 0 : 1 + ((r - NPROMPT) >> 10); }

__device__ __forceinline__ void p0_transpose_item(const float* W, int K, int ldn, int k0, int n0, bf16* WT, int drow0, LAS float* scr, int lane) {
    float tv[32];
#pragma unroll
    for (int i = 0; i < 32; ++i) tv[i] = W[(size_t)(k0 + 2 * i + (lane >> 5)) * ldn + n0 + (lane & 31)];
#pragma unroll
    for (int i = 0; i < 32; ++i) scr[(2 * i + (lane >> 5)) * 33 + (lane & 31)] = tv[i];
    LDS_WAIT(); asm volatile("" ::: "memory");
    const int c = lane & 7;
#pragma unroll
    for (int j = 0; j < 4; ++j) { const int n = (lane >> 3) + 8 * j; const LAS float* s = scr + (8 * c) * 33 + n;
        v4u o; o.x = pk2(s[0 * 33], s[1 * 33]); o.y = pk2(s[2 * 33], s[3 * 33]); o.z = pk2(s[4 * 33], s[5 * 33]); o.w = pk2(s[6 * 33], s[7 * 33]);
        *(GAS v4u*)(WT + (size_t)(drow0 + n) * K + k0 + 8 * c) = o; }
    LDS_WAIT(); asm volatile("" ::: "memory");
}

__device__ __forceinline__ void p0_adaln_unit(const Ctx& a, int u, unsigned char* ldsg, int tid, int lane, int wave) {
    const int l = u / 96, n0 = (u % 96) * 64;
    float* sil = (float*)ldsg;
    float* red = sil + 9 * 1024;
    for (int i = tid; i < 9 * 1024; i += 512) { const int bc = i >> 10, k = i & 1023; const float c = (bc == 0) ? inp(a, I_CCTX)[k] : inp(a, I_C)[(bc - 1) * 1024 + k]; sil[i] = c * sigmoidf_(c); }
    __syncthreads();
    const float* W = inp(a, I_ADAW) + (size_t)l * 1024 * 6144 + n0 + lane;
    float acc[9];
#pragma unroll
    for (int bc = 0; bc < 9; ++bc) acc[bc] = 0.f;
    const int k0 = wave * 128;
#pragma unroll 8
    for (int k = k0; k < k0 + 128; ++k) { const float w = W[(size_t)k * 6144];
#pragma unroll
        for (int bc = 0; bc < 9; ++bc) acc[bc] += sil[bc * 1024 + k] * w; }
#pragma unroll
    for (int bc = 0; bc < 9; ++bc) red[(wave * 9 + bc) * 64 + lane] = acc[bc];
    __syncthreads();
    for (int i = tid; i < 9 * 64; i += 512) { const int bc = i >> 6, ln = i & 63; float s = inp(a, I_ADAB)[l * 6144 + n0 + ln];
#pragma unroll
        for (int w = 0; w < 8; ++w) s += red[(w * 9 + bc) * 64 + ln];
        ((float*)(a.ws + WS_MOD))[(size_t)(l * 9 + bc) * 6144 + n0 + ln] = s; }
    __syncthreads();
}

__device__ __forceinline__ void p0_s5_unit(const Ctx& a, int u, unsigned char* ldsg, int tid) {
    const int l = u >> 4, g = u & 15;
    float2* Pw = (float2*)ldsg;
    float2* Bb = Pw + 2 * 17 * 64;
    float2* Cc = Bb + 2 * 64 * 16;
    float* Kt = (float*)(Cc + 2 * 16 * 64);
    if (tid < 128) {
        const int d = tid >> 6, p = tid & 63; const int gi = (l * 2 + d) * 16 + g, idx = gi * 64 + p;
        const float are = inp(a, I_ARE)[idx], aim = inp(a, I_AIM)[idx], dt = expf(inp(a, I_LDT)[gi]);
        for (int t = 0; t <= 16; ++t) { const float mag = expf((float)t * dt * are), ang = (float)t * dt * aim; float sn, cs; sincosf(ang, &sn, &cs); Pw[(d * 17 + t) * 64 + p] = make_float2(mag * cs, mag * sn); }
        const float2 ab = Pw[(d * 17 + 1) * 64 + p], a16 = Pw[(d * 17 + 16) * 64 + p];
        ((float2*)(a.ws + WS_S5A16))[idx] = a16;
        const float nr = ab.x - 1.0f, ni = ab.y, den = are * are + aim * aim;
        const float fre = (nr * are + ni * aim) / den, fim = (ni * are - nr * aim) / den;
        for (int c = 0; c < 16; ++c) { const float bre = inp(a, I_BRE)[(size_t)idx * 16 + c], bim = inp(a, I_BIM)[(size_t)idx * 16 + c];
            Bb[(d * 64 + p) * 16 + c] = make_float2(fre * bre - fim * bim, fre * bim + fim * bre); }
    }
    for (int i = tid; i < 2048; i += 512) { const int d = i >> 10, c = (i >> 6) & 15, p = i & 63; const size_t s = ((size_t)((l * 2 + d) * 16 + g) * 16 + c) * 64 + p;
        Cc[i] = make_float2(inp(a, I_CRE)[s], inp(a, I_CIM)[s]); }
    __syncthreads();
    {
        const int d = tid >> 8, tau = (tid >> 4) & 15, c = tid & 15;
        float acc[16];
#pragma unroll
        for (int j = 0; j < 16; ++j) acc[j] = 0.f;
        for (int p = 0; p < 64; ++p) { const float2 cc = Cc[(d * 16 + c) * 64 + p], pw = Pw[(d * 17 + tau) * 64 + p];
            const float xr = cc.x * pw.x - cc.y * pw.y, xi = cc.x * pw.y + cc.y * pw.x;
#pragma unroll
            for (int j = 0; j < 16; ++j) { const float2 bb = Bb[(d * 64 + p) * 16 + j]; acc[j] += xr * bb.x - xi * bb.y; } }
#pragma unroll
        for (int j = 0; j < 16; ++j) Kt[((d * 16 + tau) * 16 + c) * 16 + j] = acc[j];
    }
    __syncthreads();
    bf16* W1 = (bf16*)(a.ws + WS_S5W1) + (size_t)u * 512 * 256;
    bf16* W2 = (bf16*)(a.ws + WS_S5W2) + (size_t)u * 256 * 256;
    const float* dsk = inp(a, I_S5D) + l * 256 + g * 16;
    for (int e = tid; e < 8192; e += 512) {
        const int row = e >> 5, col0 = (e & 31) * 8, i = row >> 4, c = row & 15, j = col0 >> 4, c2 = col0 & 15;
        float v[8];
#pragma unroll
        for (int x = 0; x < 8; ++x) { float t = 0.f;
            if (i >= j) t += Kt[((0 * 16 + (i - j)) * 16 + c) * 16 + c2 + x];
            if (j >= i) t += Kt[((1 * 16 + (j - i)) * 16 + c) * 16 + c2 + x];
            if (row == col0 + x) t += dsk[c];
            v[x] = t; }
        v4u o; o.x = pk2(v[0], v[1]); o.y = pk2(v[2], v[3]); o.z = pk2(v[4], v[5]); o.w = pk2(v[6], v[7]);
        *(v4u*)(W1 + (size_t)row * 256 + col0) = o;
    }
    for (int e = tid; e < 8192; e += 512) {
        const int rr = e >> 5, col0 = (e & 31) * 8, d = rr >> 7, im = (rr >> 6) & 1, p = rr & 63, j = col0 >> 4, c2 = col0 & 15;
        const int ex = d == 0 ? 15 - j : j;
        const float2 pw = Pw[(d * 17 + ex) * 64 + p];
        float v[8];
#pragma unroll
        for (int x = 0; x < 8; ++x) { const float2 bb = Bb[(d * 64 + p) * 16 + c2 + x]; v[x] = im ? (pw.x * bb.y + pw.y * bb.x) : (pw.x * bb.x - pw.y * bb.y); }
        v4u o; o.x = pk2(v[0], v[1]); o.y = pk2(v[2], v[3]); o.z = pk2(v[4], v[5]); o.w = pk2(v[6], v[7]);
        *(v4u*)(W1 + 65536 + (size_t)rr * 256 + col0) = o;
    }
    for (int e = tid; e < 8192; e += 512) {
        const int row = e >> 5, col0 = (e & 31) * 8, i = row >> 4, c = row & 15, d = col0 >> 7, im = (col0 >> 6) & 1, p0 = col0 & 63;
        const int n = d == 0 ? i + 1 : 16 - i;
        float v[8];
#pragma unroll
        for (int x = 0; x < 8; ++x) { const float2 cc = Cc[(d * 16 + c) * 64 + p0 + x], pw = Pw[(d * 17 + n) * 64 + p0 + x]; v[x] = im ? -(cc.x * pw.y + cc.y * pw.x) : (cc.x * pw.x - cc.y * pw.y); }
        v4u o; o.x = pk2(v[0], v[1]); o.y = pk2(v[2], v[3]); o.z = pk2(v[4], v[5]); o.w = pk2(v[6], v[7]);
        *(v4u*)(W2 + (size_t)row * 256 + col0) = o;
    }
    __syncthreads();
}

__device__ __forceinline__ void p0_prologue(const Ctx& a, unsigned char* ldsg, int G, int rep, volatile LAS unsigned* MISC, const int tid0) {
    constexpr int IT_IN = 16 * 64, IT_OUT = 16 * 32, IT_G = 16 * 88, IT_D = 44 * 32, IT_GLU = 4 * 8, IT_L = IT_IN + IT_OUT + 2 * IT_G + IT_D + IT_GLU;
    constexpr int U_S5 = 32, U_ADA = 192, U_MISC = 9, U_TR = 2 * IT_L / 8, U_ALL = U_S5 + U_ADA + U_MISC + U_TR;
    gu32* head = (gu32*)(a.ws + WS_CTL) + CW_QUEUE + 64 * (8 + rep);
    for (;;) {
        if (tid0 == 0) MISC[16] = __hip_atomic_fetch_add(head, 1u, RLX_AGENT);
        __syncthreads();
        const int u = (int)MISC[16];
        __syncthreads();
        if (u >= U_ALL) break;
        int tid = tid0; asm volatile("" : "+v"(tid));
        const int lane = tid & 63, wave = __builtin_amdgcn_readfirstlane(tid >> 6);
        if (u < U_S5) { p0_s5_unit(a, u, ldsg, tid); continue; }
        if (u < U_S5 + U_ADA) { p0_adaln_unit(a, u - U_S5, ldsg, tid, lane, wave); continue; }
        if (u < U_S5 + U_ADA + U_MISC) { const int v = u - U_S5 - U_ADA;
            if (v == 0) { float* rp = (float*)(a.ws + WS_ROPE);
                for (int i = tid; i < 1024; i += 512) { const int pos = i >> 4, j = i & 15; const float inv = exp2f(-(float)j * (13.287712379549449f / 16.0f));   float sn, cs; sincosf((float)pos * inv, &sn, &cs); rp[i] = cs; rp[1024 + i] = sn; } }
            else {
                for (int i = (v - 1) * 4096 + tid; i < v * 4096; i += 512) { const int l = i >> 14, j = (i >> 10) & 15, k = i & 1023;
                    ((bf16*)(a.ws + WS_WGT))[i] = (bf16)f2bf(inp(a, I_WIN)[((size_t)l * 1024 + k) * 2064 + 2048 + j]); } }
            continue; }
        {
            LAS float* scr = (LAS float*)((LAS unsigned char*)ldsg + wave * 16384);
            const int it = (u - U_S5 - U_ADA - U_MISC) * 8 + wave;
            const int l = it / IT_L; int r = it % IT_L;
            if (r < IT_IN) { const int kb = r / 64, nb = r % 64, tile = nb >> 3, cb = nb & 7;
                p0_transpose_item(inp(a, I_WIN) + (size_t)l * 1024 * 2064, 1024, 2064, 64 * kb, 32 * nb, (bf16*)(a.ws + WS_WIN) + (size_t)l * 2048 * 1024, 256 * tile + 128 * (cb & 1) + 32 * (cb >> 1), scr, lane); }
            else if ((r -= IT_IN) < IT_OUT) { const int kb = r / 32, nb = r % 32;
                p0_transpose_item(inp(a, I_WOUT) + (size_t)l * 1024 * 1024, 1024, 1024, 64 * kb, 32 * nb, (bf16*)(a.ws + WS_WOUT) + (size_t)l * 1024 * 1024, 32 * nb, scr, lane); }
            else if ((r -= IT_OUT) < IT_G) { const int kb = r / 88, nb = r % 88;
                p0_transpose_item(inp(a, I_WG) + (size_t)l * 1024 * DFF, 1024, DFF, 64 * kb, 32 * nb, (bf16*)(a.ws + WS_WGU) + (size_t)l * NGU * 1024, 256 * (nb >> 2) + 32 * (nb & 3), scr, lane); }
            else if ((r -= IT_G) < IT_G) { const int kb = r / 88, nb = r % 88;
                p0_transpose_item(inp(a, I_WU) + (size_t)l * 1024 * DFF, 1024, DFF, 64 * kb, 32 * nb, (bf16*)(a.ws + WS_WGU) + (size_t)l * NGU * 1024, 256 * (nb >> 2) + 128 + 32 * (nb & 3), scr, lane); }
            else if ((r -= IT_G) < IT_D) { const int kb = r / 32, nb = r % 32;
                p0_transpose_item(inp(a, I_WD) + (size_t)l * DFF * 1024, DFF, 1024, 64 * kb, 32 * nb, (bf16*)(a.ws + WS_WDN) + (size_t)l * 1024 * DFF, 32 * nb, scr, lane); }
            else { r -= IT_D; const int kb = r / 8, nb = r % 8;
                p0_transpose_item(inp(a, I_GLUW) + (size_t)l * 256 * 256, 256, 256, 64 * kb, 32 * nb, (bf16*)(a.ws + WS_GLUT) + (size_t)l * 256 * 256, 32 * nb, scr, lane); }
        }
    }
}

__device__ __forceinline__ void norm_phase(const Ctx& a, int l, int which  , int G, const int tid) {
    const int lane = tid & 63, wave = __builtin_amdgcn_readfirstlane(tid >> 6);
    const int gw = a.bid * NWAVES + wave, NGW = G * NWAVES;
    const float* gvec = inp(a, which ? I_N2G : I_N1G) + l * 1024;
    const float* mod = (const float*)(a.ws + WS_MOD) + (size_t)l * 9 * 6144;
    bf16* H = (bf16*)(a.ws + WS_H);
    f32x4 gv[4];
#pragma unroll
    for (int j = 0; j < 4; ++j) gv[j] = *(const f32x4*)(gvec + 4 * lane + 256 * j);
    for (int m = gw; m < MTOK; m += NGW) {
        const float* xrow = (l == 0 && which == 0) ? (m < NPROMPT ? inp(a, I_XP) + (size_t)m * DM : inp(a, I_XS) + (size_t)(m - NPROMPT) * DM) : a.out + OUT_Y + (size_t)m * DM;
        const float* mb = mod + (size_t)bc_of_row(m) * 6144 + (which ? 3 * 1024 : 0);
        f32x4 v[4]; float s = 0.f;
#pragma unroll
        for (int j = 0; j < 4; ++j) { v[j] = *(const f32x4*)(xrow + 4 * lane + 256 * j); s += (v[j].x * v[j].x + v[j].y * v[j].y) + (v[j].z * v[j].z + v[j].w * v[j].w); }
        const float r = rsqrtf(wave_sum(s) * (1.0f / DM) + EPS);
#pragma unroll
        for (int j = 0; j < 4; ++j) { const f32x4 sh = *(const f32x4*)(mb + 4 * lane + 256 * j), sc = *(const f32x4*)(mb + 1024 + 4 * lane + 256 * j);
            const f32x4 o = v[j] * r * gv[j] * (sc + 1.0f) + sh;
            u32x2 w; w.x = pk2(o.x, o.y); w.y = pk2(o.z, o.w);
            *(u32x2*)(H + (size_t)m * DM + 4 * lane + 256 * j) = w; }
    }
    if (which == 0) {
        bf16* KS = (bf16*)(a.ws + WS_KS); bf16* VS = (bf16*)(a.ws + WS_VS);
        for (int i = a.bid * 512 + tid; i < 2 * 8 * 8192; i += G * 512) {
            const int kv = i >> 16, b = (i >> 13) & 7, e = (i & 8191) * 8;
            const float* src = inp(a, kv ? I_CV : I_CK) + ((size_t)(b * 2 + l) * 512) * 128 + e;
            const f32x4 x0 = *(const f32x4*)src, x1 = *(const f32x4*)(src + 4);
            v4u o; o.x = pk2(x0.x, x0.y); o.y = pk2(x0.z, x0.w); o.z = pk2(x1.x, x1.y); o.w = pk2(x1.z, x1.w);
            *(v4u*)((kv ? VS : KS) + (size_t)b * 1536 * 128 + e) = o;
        }
    }
}

struct EpiG1 {
    static constexpr bool PERM = false, AFTER_DRAIN = false;
    int l; unsigned char* ws; float* out; const float* qg; const float* kg;
    __device__ __forceinline__ void operator()(const pg8::f32x4 (&acc)[2][2][4][2], const pg8::Unit& u, int wr, int wc, int fr, int fq) const {
        const int pn = u.pn; const bool samp = u.pm >= 16;
        const int kind = (pn <= 1) ? 0 : (pn == 2 ? (wc < 2 ? 1 : 2) : 3);
        const float* rope = (const float*)(ws + WS_ROPE);
#pragma unroll
        for (int ai = 0; ai < 2; ++ai)
#pragma unroll
            for (int m = 0; m < 4; ++m) {
                const int r = u.pm * 256 + ai * 128 + wr * 64 + m * 16 + fr;
                f32x4 v[2][2];
#pragma unroll
                for (int bj = 0; bj < 2; ++bj)
#pragma unroll
                    for (int n = 0; n < 2; ++n) v[bj][n] = acc[ai][bj][m][n];
                if (kind <= 1) {
                    float ss = 0.f;
#pragma unroll
                    for (int bj = 0; bj < 2; ++bj)
#pragma unroll
                        for (int n = 0; n < 2; ++n) ss += (v[bj][n].x * v[bj][n].x + v[bj][n].y * v[bj][n].y) + (v[bj][n].z * v[bj][n].z + v[bj][n].w * v[bj][n].w);
                    ss += __shfl_xor(ss, 16); ss += __shfl_xor(ss, 32);
                    const float rinv = rsqrtf(ss * (1.0f / 64.0f) + EPS);
#pragma unroll
                    for (int bj = 0; bj < 2; ++bj)
#pragma unroll
                        for (int n = 0; n < 2; ++n) v[bj][n] = v[bj][n] * rinv * *(const f32x4*)((kind == 0 ? qg : kg) + 32 * bj + 16 * n + 4 * fq);
                }
                if (!samp && (kind == 1 || kind == 2)) {
                    const int b = r >> 8, t = r & 255, kvh = wc & 1;
                    float* dst = out + (kind == 1 ? OUT_K : OUT_V) + ((((size_t)b * 2 + l) * 256 + t) * 2 + kvh) * 64 + 4 * fq;
#pragma unroll
                    for (int bj = 0; bj < 2; ++bj)
#pragma unroll
                        for (int n = 0; n < 2; ++n) *(f32x4*)(dst + 32 * bj + 16 * n) = v[bj][n];
                }
                if (samp && kind <= 1) {
                    const int t = (r - NPROMPT) & 1023;
#pragma unroll
                    for (int bj = 0; bj < 2; ++bj) { const int pos = bj == 0 ? (t >> 6) : (t & 63);
                        const f32x4 cs = *(const f32x4*)(rope + pos * 16 + 4 * fq), sn = *(const f32x4*)(rope + 1024 + pos * 16 + 4 * fq);
                        const f32x4 x1 = v[bj][0], x2 = v[bj][1];
                        v[bj][0] = x1 * cs - x2 * sn; v[bj][1] = x2 * cs + x1 * sn; }
                }
                bf16* dst; float scl = 1.0f;
                if (kind == 0) { dst = (bf16*)(ws + WS_Q) + (size_t)r * 512 + (4 * pn + wc) * 64; scl = QSCALE; }
                else if (kind == 3) { dst = (bf16*)(ws + WS_SU + (size_t)(pn - 3) * (6 * MiB)) + (size_t)r * 256 + wc * 64; if (pn == 5) scl = 0.125f; }
                else { const int kvh = wc & 1;
                    if (!samp) dst = (bf16*)(ws + (kind == 1 ? WS_KP : WS_VP)) + (size_t)r * 128 + kvh * 64;
                    else { const int b = (r - NPROMPT) >> 10, t = (r - NPROMPT) & 1023; dst = (bf16*)(ws + (kind == 1 ? WS_KS : WS_VS)) + ((size_t)b * 1536 + 512 + t) * 128 + kvh * 64; } }
#pragma unroll
                for (int bj = 0; bj < 2; ++bj)
#pragma unroll
                    for (int n = 0; n < 2; ++n) { const f32x4 o = v[bj][n] * scl; u32x2 w; w.x = pk2(o.x, o.y); w.y = pk2(o.z, o.w);
                        *(u32x2*)(dst + 32 * bj + 16 * n + 4 * fq) = w; }
                asm volatile("" ::: "memory");
            }
    }
};
struct EpiGlu {
    static constexpr bool PERM = false, AFTER_DRAIN = false;
    const bf16* Z; bf16* MIX; const float* bias;
    __device__ __forceinline__ void operator()(const pg8::f32x4 (&acc)[2][2][4][2], const pg8::Unit& u, int wr, int wc, int fr, int fq) const {
#pragma unroll
        for (int ai = 0; ai < 2; ++ai)
#pragma unroll
            for (int m = 0; m < 4; ++m) { const int r = u.pm * 256 + ai * 128 + wr * 64 + m * 16 + fr;
#pragma unroll
                for (int bj = 0; bj < 2; ++bj)
#pragma unroll
                    for (int n = 0; n < 2; ++n) { const int c = 128 * bj + 32 * wc + 16 * n + 4 * fq;
                        const f32x4 bv = *(const f32x4*)(bias + c); const u32x2 zz = *(const u32x2*)(Z + (size_t)r * 256 + c);
                        const f32x4 s = acc[ai][bj][m][n] + bv;
                        const float z0 = __uint_as_float(zz.x << 16), z1 = __uint_as_float(zz.x & 0xffff0000u), z2 = __uint_as_float(zz.y << 16), z3 = __uint_as_float(zz.y & 0xffff0000u);
                        u32x2 w; w.x = pk2(z0 * sigmoidf_(s.x), z1 * sigmoidf_(s.y)); w.y = pk2(z2 * sigmoidf_(s.z), z3 * sigmoidf_(s.w));
                        *(u32x2*)(MIX + (size_t)r * 1024 + 512 + c) = w; }
                asm volatile("" ::: "memory"); }
    }
};
struct EpiResid {
    static constexpr bool PERM = false, AFTER_DRAIN = false;
    const float* xp; const float* xs; float* xout; const float* gate;
    __device__ __forceinline__ void operator()(const pg8::f32x4 (&acc)[2][2][4][2], const pg8::Unit& u, int wr, int wc, int fr, int fq) const {
        const int bc = u.pm < 16 ? 0 : 1 + ((u.pm - 16) >> 2);
        const float* gp = gate + (size_t)bc * 6144 + u.pn * 256 + wc * 32 + 4 * fq;
        f32x4 gv[2][2];
#pragma unroll
        for (int bj = 0; bj < 2; ++bj)
#pragma unroll
            for (int n = 0; n < 2; ++n) gv[bj][n] = *(const f32x4*)(gp + bj * 128 + n * 16);
#pragma unroll
        for (int ai = 0; ai < 2; ++ai)
#pragma unroll
            for (int m = 0; m < 4; ++m) { const int r = u.pm * 256 + ai * 128 + wr * 64 + m * 16 + fr;
                const float* xi = (r < NPROMPT ? xp + (size_t)r * DM : xs + (size_t)(r - NPROMPT) * DM) + u.pn * 256 + wc * 32 + 4 * fq;
                float* xo = xout + (size_t)r * DM + u.pn * 256 + wc * 32 + 4 * fq;
#pragma unroll
                for (int bj = 0; bj < 2; ++bj)
#pragma unroll
                    for (int n = 0; n < 2; ++n) { const f32x4 b = *(const f32x4*)(xi + bj * 128 + n * 16); *(f32x4*)(xo + bj * 128 + n * 16) = b + gv[bj][n] * acc[ai][bj][m][n]; }
                if (m & 1) asm volatile("" ::: "memory"); }
    }
};


__device__ __forceinline__ float dpp_ror1(float x) { return __builtin_bit_cast(float, __builtin_amdgcn_update_dpp(0, __builtin_bit_cast(int, x), 0x121, 0xf, 0xf, false)); }
__device__ __forceinline__ float dpp_ror15(float x) { return __builtin_bit_cast(float, __builtin_amdgcn_update_dpp(0, __builtin_bit_cast(int, x), 0x12f, 0xf, 0xf, false)); }
__device__ __forceinline__ f32x4 ror1v(f32x4 v) { return (f32x4){dpp_ror1(v.x), dpp_ror1(v.y), dpp_ror1(v.z), dpp_ror1(v.w)}; }
__device__ __forceinline__ f32x4 ror15v(f32x4 v) { return (f32x4){dpp_ror15(v.x), dpp_ror15(v.y), dpp_ror15(v.z), dpp_ror15(v.w)}; }
__device__ __forceinline__ f32x4 siluv(f32x4 c) { return (f32x4){c.x * sigmoidf_(c.x), c.y * sigmoidf_(c.y), c.z * sigmoidf_(c.z), c.w * sigmoidf_(c.w)}; }
constexpr int XR_OFF = 133120;
struct StripOrder {
    int G, c;
    __device__ __forceinline__ bool next(int i, pg8::Unit& u) const {
        if (G == 256) {
            if (c < 176) { if (i < 4) { u.pm = 16 + 4 * (c / 22) + i; u.pn = c % 22; return true; } if (i == 4) { u.pm = c / 22; u.pn = c % 22; return true; } return false; }
            const int s = 176 + (c - 176) + 80 * i; if (i < 3 && s < 352) { u.pm = s / 22; u.pn = s % 22; return true; } return false;
        }
        int rem = i;
        for (int j = c; j < 528; j += G) { const int cnt = j < 176 ? 4 : 1;
            if (rem < cnt) { if (j < 176) { u.pm = 16 + 4 * (j / 22) + rem; u.pn = j % 22; } else { u.pm = (j - 176) / 22; u.pn = (j - 176) % 22; } return true; }
            rem -= cnt; }
        return false;
    }
    __device__ __forceinline__ void a_ready(const pg8::Unit&) const {}
    __device__ __forceinline__ void done(const pg8::Unit&) const {}
};
struct EpiG3 {
    static constexpr bool PERM = true, AFTER_DRAIN = false;
    bf16* HID; const float* cw; const float* cb; LAS float* XR;
    __device__ __forceinline__ void operator()(const pg8::f32x4 (&acc)[2][2][4][2], const pg8::Unit& u, int wr, int wc, int fr, int fq) const {
        const int pm = u.pm, pn = u.pn; const bool samp = pm >= 16; const int qtr = samp ? ((pm - 16) & 3) : 0;
        const bool first = !samp || qtr == 0, last = !samp || qtr == 3;
        LAS float* XF = XR; LAS float* XL = XR + 512; LAS float* CY = XR + 1024 + (qtr & 1) * 384; LAS float* CP = XR + 1024 + ((qtr & 1) ^ 1) * 384;
        const int fl = 32 * wc + 8 * fq;
#pragma unroll
        for (int ai = 0; ai < 2; ++ai) { const int q = 2 * ai + wr;
            if (fr == 0) {
#pragma unroll
                for (int n = 0; n < 2; ++n) *(LAS f32x4*)(XF + q * 128 + fl + 4 * n) = acc[ai][0][0][n]; }
            if (fr == 15) {
#pragma unroll
                for (int n = 0; n < 2; ++n) *(LAS f32x4*)(XL + q * 128 + fl + 4 * n) = acc[ai][0][3][n]; } }
        asm volatile("s_waitcnt lgkmcnt(0)" ::: "memory"); __builtin_amdgcn_s_barrier(); asm volatile("" ::: "memory");
        f32x4 w0[2], w1[2], w2[2], bb[2];
#pragma unroll
        for (int n = 0; n < 2; ++n) { const int f = 128 * pn + fl + 4 * n; w0[n] = *(const f32x4*)(cw + f); w1[n] = *(const f32x4*)(cw + DFF + f); w2[n] = *(const f32x4*)(cw + 2 * DFF + f); bb[n] = *(const f32x4*)(cb + f); }
        const f32x4 zero4 = {0.f, 0.f, 0.f, 0.f};
#pragma unroll
        for (int ai = 0; ai < 2; ++ai) { const int q = 2 * ai + wr;
#pragma unroll
            for (int m = 0; m < 4; ++m) {
                const int r = pm * 256 + ai * 128 + wr * 64 + m * 16 + fr;
                f32x4 hv[2]; bool defer = false;
#pragma unroll
                for (int n = 0; n < 2; ++n) {
                    const f32x4 cur = acc[ai][0][m][n];
                    f32x4 up = ror1v(cur), dn = ror15v(cur);
                    if (m > 0) { const f32x4 t = ror1v(acc[ai][0][m > 0 ? m - 1 : 0][n]); if (fr == 0) up = t; }
                    else if (fr == 0) { up = (q > 0) ? *(const LAS f32x4*)(XL + (q - 1) * 128 + fl + 4 * n) : (first ? zero4 : *(const LAS f32x4*)(CP + fl + 4 * n)); }
                    if (m < 3) { const f32x4 t = ror15v(acc[ai][0][m < 3 ? m + 1 : 3][n]); if (fr == 15) dn = t; }
                    else if (fr == 15) { dn = (q < 3) ? *(const LAS f32x4*)(XF + (q + 1) * 128 + fl + 4 * n) : zero4; }
                    const f32x4 cpart = w0[n] * up + w1[n] * cur + bb[n];
                    const f32x4 uu = acc[ai][1][m][n];
                    hv[n] = siluv(cpart + w2[n] * dn) * uu;
                    if (m == 3 && q == 3 && !last && fr == 15) { defer = true;
                        *(LAS f32x4*)(CY + fl + 4 * n) = cur; *(LAS f32x4*)(CY + 128 + fl + 4 * n) = cpart; *(LAS f32x4*)(CY + 256 + fl + 4 * n) = uu; }
                    if (m == 0 && q == 0 && !first && fr == 0) {
                        const f32x4 pc = *(const LAS f32x4*)(CP + 128 + fl + 4 * n), pu = *(const LAS f32x4*)(CP + 256 + fl + 4 * n);
                        const f32x4 ph = siluv(pc + w2[n] * cur) * pu; u32x2 w; w.x = pk2(ph.x, ph.y); w.y = pk2(ph.z, ph.w);
                        *(u32x2*)(HID + (size_t)(pm * 256 - 1) * DFF + 128 * pn + fl + 4 * n) = w; }
                }
                if (!defer) { v4u w; w.x = pk2(hv[0].x, hv[0].y); w.y = pk2(hv[0].z, hv[0].w); w.z = pk2(hv[1].x, hv[1].y); w.w = pk2(hv[1].z, hv[1].w);
                    *(v4u*)(HID + (size_t)r * DFF + 128 * pn + fl) = w; }
            } }
    }
};
__device__ __forceinline__ void gates_phase(const Ctx& a, int l, int G, const int tid) {
    const int lane = tid & 63, wave = __builtin_amdgcn_readfirstlane(tid >> 6);
    const int gw = a.bid * NWAVES + wave, NGW = G * NWAVES;
    const bf16* H = (const bf16*)(a.ws + WS_H); const bf16* WG = (const bf16*)(a.ws + WS_WGT) + (size_t)l * 16 * 1024;
    float* GT = (float*)(a.ws + WS_GATES);
    const int j = lane & 15; const float bias = inp(a, I_MGB)[l * 16 + j];
    for (int uu = gw; uu < MTOK / 16; uu += NGW) {
        const int r0 = uu * 16;
        const bf16* Ap = H + (size_t)(r0 + (lane & 15)) * DM + 8 * (lane >> 4);
        const bf16* Bp = WG + (size_t)(lane & 15) * DM + 8 * (lane >> 4);
        f32x4 acc = {0.f, 0.f, 0.f, 0.f};
#pragma unroll 8
        for (int ks = 0; ks < 32; ++ks) { const bf16x8 av = *(const bf16x8*)(Ap + ks * 32), bv = *(const bf16x8*)(Bp + ks * 32); acc = __builtin_amdgcn_mfma_f32_16x16x32_bf16(av, bv, acc, 0, 0, 0); }
#pragma unroll
        for (int rg = 0; rg < 4; ++rg) { float v = acc[rg] + bias; if (j >= 8) v = fminf(v, 0.f) - __logf(1.0f + __expf(-fabsf(v)));
            GT[(size_t)(r0 + 4 * (lane >> 4) + rg) * 16 + j] = v; }
    }
}

template <int NCB> __device__ __forceinline__ void s5_unit(const Ctx& a, int l, int s, int g, unsigned char* ldsg, const int tid) {
    constexpr int NCH = 16 * NCB;
    const int lane = tid & 63, wave = __builtin_amdgcn_readfirstlane(tid >> 6);
    const bool samp = s >= 16; const int row0 = samp ? NPROMPT + (s - 16) * 1024 : s * 256;
    const bf16* U = (const bf16*)(a.ws + WS_SU) + (size_t)row0 * 256 + g * 16;
    const bf16* W1 = (const bf16*)(a.ws + WS_S5W1) + (size_t)(l * 16 + g) * 512 * 256;
    const bf16* W2 = (const bf16*)(a.ws + WS_S5W2) + (size_t)(l * 16 + g) * 256 * 256;
    float* dS = (float*)ldsg;
    bf16* Sin = (bf16*)(ldsg + 256 * 65 * 4);
    const int lr = lane & 15, lq = lane >> 4;
    f32x4 accY[2][NCB], accS[2][NCB];
#pragma unroll
    for (int i = 0; i < 2; ++i)
#pragma unroll
        for (int cb = 0; cb < NCB; ++cb) { accY[i][cb] = (f32x4){0.f, 0.f, 0.f, 0.f}; accS[i][cb] = (f32x4){0.f, 0.f, 0.f, 0.f}; }
#pragma unroll 2
    for (int ks = 0; ks < 8; ++ks) {
        bf16x8 bfr[NCB];
#pragma unroll
        for (int cb = 0; cb < NCB; ++cb) bfr[cb] = *(const bf16x8*)(U + (size_t)((cb * 16 + lr) * 16 + 2 * ks + (lq >> 1)) * 256 + 8 * (lq & 1));
#pragma unroll
        for (int i = 0; i < 2; ++i) {
            const bf16x8 ay = *(const bf16x8*)(W1 + (size_t)((2 * wave + i) * 16 + lr) * 256 + ks * 32 + 8 * lq);
            const bf16x8 as = *(const bf16x8*)(W1 + (size_t)((16 + 2 * wave + i) * 16 + lr) * 256 + ks * 32 + 8 * lq);
#pragma unroll
            for (int cb = 0; cb < NCB; ++cb) { accY[i][cb] = __builtin_amdgcn_mfma_f32_16x16x32_bf16(ay, bfr[cb], accY[i][cb], 0, 0, 0);
                                               accS[i][cb] = __builtin_amdgcn_mfma_f32_16x16x32_bf16(as, bfr[cb], accS[i][cb], 0, 0, 0); }
        }
    }
#pragma unroll
    for (int i = 0; i < 2; ++i)
#pragma unroll
        for (int cb = 0; cb < NCB; ++cb)
#pragma unroll
            for (int rg = 0; rg < 4; ++rg) dS[((2 * wave + i) * 16 + 4 * lq + rg) * (NCH + 1) + cb * 16 + lr] = accS[i][cb][rg];
    __syncthreads();
    if (tid < 128) {
        const int d = tid >> 6, p = tid & 63; const int gi = (l * 2 + d) * 16 + g;
        const float2 a16 = ((const float2*)(a.ws + WS_S5A16))[gi * 64 + p];
        float sr = 0.f, si = 0.f;
        if (samp) { const size_t ix = ((size_t)(((s - 16) * 2 + l) * 2 + d) * 16 + g) * 64 + p; sr = inp(a, I_S5RE)[ix]; si = inp(a, I_S5IM)[ix]; }
        for (int kk = 0; kk < NCH; ++kk) { const int k = d == 0 ? kk : NCH - 1 - kk;
            Sin[k * 264 + 128 * d + p] = (bf16)f2bf(sr); Sin[k * 264 + 128 * d + 64 + p] = (bf16)f2bf(si);
            const float xr = dS[(128 * d + p) * (NCH + 1) + k], xi = dS[(128 * d + 64 + p) * (NCH + 1) + k];
            const float nr = a16.x * sr - a16.y * si + xr, ni = a16.x * si + a16.y * sr + xi; sr = nr; si = ni; }
        if (!samp) { const size_t ox = ((size_t)((s * 2 + l) * 2 + d) * 16 + g) * 64 + p; a.out[OUT_S5RE + ox] = sr; a.out[OUT_S5IM + ox] = si; }
    }
    __syncthreads();
#pragma unroll 2
    for (int ks = 0; ks < 8; ++ks) {
        bf16x8 bfr[NCB];
#pragma unroll
        for (int cb = 0; cb < NCB; ++cb) bfr[cb] = *(const bf16x8*)(Sin + (cb * 16 + lr) * 264 + ks * 32 + 8 * lq);
#pragma unroll
        for (int i = 0; i < 2; ++i) { const bf16x8 ay = *(const bf16x8*)(W2 + (size_t)((2 * wave + i) * 16 + lr) * 256 + ks * 32 + 8 * lq);
#pragma unroll
            for (int cb = 0; cb < NCB; ++cb) accY[i][cb] = __builtin_amdgcn_mfma_f32_16x16x32_bf16(ay, bfr[cb], accY[i][cb], 0, 0, 0); }
    }
    float* Y5 = (float*)(a.ws + WS_Y5);
#pragma unroll
    for (int i = 0; i < 2; ++i)
#pragma unroll
        for (int cb = 0; cb < NCB; ++cb) { const int tok = (cb * 16 + lr) * 16 + (2 * wave + i);
            *(f32x4*)(Y5 + (size_t)(row0 + tok) * 256 + g * 16 + 4 * lq) = accY[i][cb]; }
    __syncthreads();
}

__device__ __forceinline__ void mlstm_unit(const Ctx& a, int l, int s, int h, int dir, unsigned char* ldsg, const int tid) {
    const int lane = tid & 63, wave = __builtin_amdgcn_readfirstlane(tid >> 6);
    const bool samp = s >= 16; const int L = samp ? 1024 : 256, nck = L / 64; const int row0 = samp ? NPROMPT + (s - 16) * 1024 : s * 256;
    constexpr int P = 72;
    bf16* Qs = (bf16*)ldsg;
    bf16* Ks = Qs + 64 * P;
    bf16* KT = Ks + 64 * P;
    bf16* VT = KT + 64 * P;
    bf16* SC = VT + 80 * P;
    bf16* Cb = SC + 64 * P;
    float* fl = (float*)(Cb + 80 * P);
    float* av = fl, *Mv = fl + 64, *sint = fl + 128, *wkv = fl + 192, *emn = fl + 256, *denv = fl + 320, *misc = fl + 384;
    const bf16* MQ = (const bf16*)(a.ws + WS_MQ), *MKb = (const bf16*)(a.ws + WS_MK), *MVb = (const bf16*)(a.ws + WS_MV);
    const float* GT = (const float*)(a.ws + WS_GATES);
    float* HO = (float*)(a.ws + (dir ? WS_HB : WS_HF));
    const int lr = lane & 15, lq = lane >> 4;
    f32x4 accC[3];
    float mrun = 0.f;
#pragma unroll
    for (int i = 0; i < 3; ++i) { accC[i] = (f32x4){0.f, 0.f, 0.f, 0.f};
        const int j = wave + 8 * i;
        if (samp && j < 20) { const int db = j >> 2, eb = j & 3; const size_t sb = (size_t)((((s - 16) * 2 + l) * 2 + dir) * 4 + h);
            if (db < 4) {
#pragma unroll
                for (int rg = 0; rg < 4; ++rg) accC[i][rg] = inp(a, I_MC)[(sb * 64 + db * 16 + 4 * lq + rg) * 64 + eb * 16 + lr];
            } else if (lq == 0) accC[i][0] = inp(a, I_MN)[sb * 64 + eb * 16 + lr]; }
    }
    if (samp) mrun = inp(a, I_MM)[(((s - 16) * 2 + l) * 2 + dir) * 4 + h];
    for (int i = tid; i < 16 * 64; i += 512) { const int d = 64 + (i >> 6), sidx = i & 63; VT[d * P + sidx] = (d == 64) ? (bf16)0x3f80 : (bf16)0; }
#pragma unroll
    for (int i = 0; i < 3; ++i) { const int j = wave + 8 * i; if (j < 20) { const int db = j >> 2, eb = j & 3;
#pragma unroll
        for (int rg = 0; rg < 4; ++rg) Cb[(db * 16 + 4 * lq + rg) * P + eb * 16 + lr] = (bf16)f2bf(accC[i][rg]); } }
    __syncthreads();
    for (int ck = 0; ck < nck; ++ck) {
        {
            const int pos = tid >> 3, seg = tid & 7; const int tok = dir ? L - 1 - (64 * ck + pos) : 64 * ck + pos;
            const size_t go = (size_t)(row0 + tok) * 256 + h * 64 + seg * 8;
            const v4u qv = *(const v4u*)(MQ + go), kv = *(const v4u*)(MKb + go), vv = *(const v4u*)(MVb + go);
            *(v4u*)(Qs + pos * P + seg * 8) = qv; *(v4u*)(Ks + pos * P + seg * 8) = kv;
            const unsigned vw[4] = {vv.x, vv.y, vv.z, vv.w};
#pragma unroll
            for (int e = 0; e < 4; ++e) { VT[(seg * 8 + 2 * e) * P + pos] = (bf16)(vw[e] & 0xffffu); VT[(seg * 8 + 2 * e + 1) * P + pos] = (bf16)(vw[e] >> 16); }
        }
        if (wave == 0) {
            const int tok = dir ? L - 1 - (64 * ck + lane) : 64 * ck + lane;
            const float li = GT[(size_t)(row0 + tok) * 16 + dir * 4 + h], lf = GT[(size_t)(row0 + tok) * 16 + 8 + dir * 4 + h];
            float b = lf;
#pragma unroll
            for (int o = 1; o < 64; o <<= 1) { const float t = __shfl_up(b, o); if (lane >= o) b += t; }
            const float aa = li - b;
            float cm = aa;
#pragma unroll
            for (int o = 1; o < 64; o <<= 1) { const float t = __shfl_up(cm, o); if (lane >= o) cm = fmaxf(cm, t); }
            const float Mt = fmaxf(mrun, cm);
            const float blast = __shfl(b, 63), amax = __shfl(cm, 63);
            const float Mn = fmaxf(mrun, amax);
            av[lane] = aa; Mv[lane] = Mt; sint[lane] = __expf(mrun - Mt); wkv[lane] = __expf(aa - Mn); emn[lane] = __expf(-(b + Mt));
            if (lane == 0) { misc[0] = __expf(mrun - Mn); misc[1] = blast + Mn; }
        }
        __syncthreads();
        const float decay = misc[0]; const float mnew = misc[1];
        {
            const int pos = tid >> 3, seg = tid & 7; const float wk = wkv[pos];
            const v4u kv = *(const v4u*)(Ks + pos * P + seg * 8); const unsigned kw[4] = {kv.x, kv.y, kv.z, kv.w};
#pragma unroll
            for (int e = 0; e < 4; ++e) { KT[(seg * 8 + 2 * e) * P + pos] = (bf16)f2bf(wk * __uint_as_float(kw[e] << 16)); KT[(seg * 8 + 2 * e + 1) * P + pos] = (bf16)f2bf(wk * __uint_as_float(kw[e] & 0xffff0000u)); }
        }
        {
            const int tb = wave >> 1;
#pragma unroll
            for (int i = 0; i < 2; ++i) { const int sb = 2 * (wave & 1) + i; f32x4 sacc = {0.f, 0.f, 0.f, 0.f};
#pragma unroll
                for (int ks = 0; ks < 2; ++ks) { const bf16x8 qa = *(const bf16x8*)(Qs + (tb * 16 + lr) * P + ks * 32 + 8 * lq), kb = *(const bf16x8*)(Ks + (sb * 16 + lr) * P + ks * 32 + 8 * lq);
                    sacc = __builtin_amdgcn_mfma_f32_16x16x32_bf16(qa, kb, sacc, 0, 0, 0); }
                const int sidx = sb * 16 + lr; const float as = av[sidx];
#pragma unroll
                for (int rg = 0; rg < 4; ++rg) { const int t = tb * 16 + 4 * lq + rg; const float w = (sidx <= t) ? __expf(as - Mv[t]) : 0.f; SC[t * P + sidx] = (bf16)f2bf(sacc[rg] * w); } }
        }
        __syncthreads();
        f32x4 nacc[3];
#pragma unroll
        for (int i = 0; i < 3; ++i) { nacc[i] = (f32x4){0.f, 0.f, 0.f, 0.f}; const int j = wave + 8 * i;
            if (j < 20) { const int tb = j / 5, db = j % 5;
#pragma unroll
                for (int ks = 0; ks < 2; ++ks) { const bf16x8 qa = *(const bf16x8*)(Qs + (tb * 16 + lr) * P + ks * 32 + 8 * lq), cbv = *(const bf16x8*)(Cb + (db * 16 + lr) * P + ks * 32 + 8 * lq);
                    nacc[i] = __builtin_amdgcn_mfma_f32_16x16x32_bf16(qa, cbv, nacc[i], 0, 0, 0); }
#pragma unroll
                for (int rg = 0; rg < 4; ++rg) nacc[i][rg] *= sint[tb * 16 + 4 * lq + rg];
#pragma unroll
                for (int ks = 0; ks < 2; ++ks) { const bf16x8 sa = *(const bf16x8*)(SC + (tb * 16 + lr) * P + ks * 32 + 8 * lq), vb = *(const bf16x8*)(VT + (db * 16 + lr) * P + ks * 32 + 8 * lq);
                    nacc[i] = __builtin_amdgcn_mfma_f32_16x16x32_bf16(sa, vb, nacc[i], 0, 0, 0); }
                if (db == 4 && lr == 0) {
#pragma unroll
                    for (int rg = 0; rg < 4; ++rg) denv[tb * 16 + 4 * lq + rg] = nacc[i][rg]; } } }
#pragma unroll
        for (int i = 0; i < 3; ++i) { const int j = wave + 8 * i;
            if (j < 20) { const int db = j >> 2, eb = j & 3;
#pragma unroll
                for (int rg = 0; rg < 4; ++rg) accC[i][rg] *= decay;
#pragma unroll
                for (int ks = 0; ks < 2; ++ks) { const bf16x8 va = *(const bf16x8*)(VT + (db * 16 + lr) * P + ks * 32 + 8 * lq), kb = *(const bf16x8*)(KT + (eb * 16 + lr) * P + ks * 32 + 8 * lq);
                    accC[i] = __builtin_amdgcn_mfma_f32_16x16x32_bf16(va, kb, accC[i], 0, 0, 0); } } }
        __syncthreads();
#pragma unroll
        for (int i = 0; i < 3; ++i) { const int j = wave + 8 * i;
            if (j < 20) { const int tb = j / 5, db = j % 5;
                if (db < 4) {
#pragma unroll
                    for (int rg = 0; rg < 4; ++rg) { const int t = tb * 16 + 4 * lq + rg; const int tok = dir ? L - 1 - (64 * ck + t) : 64 * ck + t;
                        HO[(size_t)(row0 + tok) * 256 + h * 64 + db * 16 + lr] = nacc[i][rg] / fmaxf(fabsf(denv[t]), emn[t]); } }
                const int db2 = j >> 2, eb2 = j & 3;
#pragma unroll
                for (int rg = 0; rg < 4; ++rg) Cb[(db2 * 16 + 4 * lq + rg) * P + eb2 * 16 + lr] = (bf16)f2bf(accC[i][rg]); } }
        mrun = mnew;
        __syncthreads();
    }
    if (!samp) {
        const size_t sb = (size_t)(((s * 2 + l) * 2 + dir) * 4 + h);
#pragma unroll
        for (int i = 0; i < 3; ++i) { const int j = wave + 8 * i;
            if (j < 20) { const int db = j >> 2, eb = j & 3;
                if (db < 4) {
#pragma unroll
                    for (int rg = 0; rg < 4; ++rg) a.out[OUT_MC + (sb * 64 + db * 16 + 4 * lq + rg) * 64 + eb * 16 + lr] = accC[i][rg];
                } else if (lq == 0) a.out[OUT_MN + sb * 64 + eb * 16 + lr] = accC[i][0]; } }
        if (tid == 0) a.out[OUT_MM + sb] = mrun;
    }
    __syncthreads();
}

__device__ __forceinline__ void mix_phase(const Ctx& a, int l, int rep, unsigned char* ldsg, volatile LAS unsigned* MISC, const int tid0) {
    gu32* head = (gu32*)(a.ws + WS_CTL) + CW_QUEUE + 64 * (l + 2 * rep);
    const bf16* Q = (const bf16*)(a.ws + WS_Q); bf16* MIX = (bf16*)(a.ws + WS_MIX);
    for (;;) {
        if (tid0 == 0) MISC[16] = __hip_atomic_fetch_add(head, 1u, RLX_AGENT);
        __syncthreads();
        const int u = (int)MISC[16];
        __syncthreads();
        if (u >= 960) break;
        int tid = tid0; asm volatile("" : "+v"(tid));
        const int sel = rep ? PROBE_MIXSEL : 7;
        if (!((sel >> (u < 64 || (u >= 448 && u < 576) ? 0 : ((u >= 64 && u < 320) || (u >= 576 && u < 704)) ? 1 : 2)) & 1)) continue;
        if (u < 64) { if (ENB(11)) mlstm_unit(a, l, 16 + (u >> 3), (u >> 1) & 3, u & 1, ldsg, tid); }
        else if (u < 320) { if (ENB(12)) { const int v = u - 64, b = v >> 5, hq = (v >> 2) & 7, qb = v & 3; const int r0 = NPROMPT + b * 1024 + qb * 256;
            attn_body::attn_unit<8>((const attn_body::bf16*)(Q + (size_t)r0 * 512 + hq * 64), 512, (const attn_body::bf16*)((const bf16*)(a.ws + WS_KS) + (size_t)b * 1536 * 128 + (hq >> 2) * 64),
                                    (const attn_body::bf16*)((const bf16*)(a.ws + WS_VS) + (size_t)b * 1536 * 128 + (hq >> 2) * 64), 128, (attn_body::bf16*)(MIX + (size_t)r0 * 1024 + hq * 64), 1024, 24, (char*)ldsg, tid); } }
        else if (u < 448) { const int v = u - 320; if (ENB(13)) s5_unit<4>(a, l, 16 + (v >> 4), v & 15, ldsg, tid); }
        else if (u < 576) { const int v = u - 448; if (ENB(11)) mlstm_unit(a, l, v >> 3, (v >> 1) & 3, v & 1, ldsg, tid); }
        else if (u < 704) { if (ENB(12)) { const int v = u - 576, b = v >> 3, hq = v & 7; const int r0 = b * 256;
            attn_body::attn_unit<8>((const attn_body::bf16*)(Q + (size_t)r0 * 512 + hq * 64), 512, (const attn_body::bf16*)((const bf16*)(a.ws + WS_KP) + (size_t)r0 * 128 + (hq >> 2) * 64),
                                    (const attn_body::bf16*)((const bf16*)(a.ws + WS_VP) + (size_t)r0 * 128 + (hq >> 2) * 64), 128, (attn_body::bf16*)(MIX + (size_t)r0 * 1024 + hq * 64), 1024, 4, (char*)ldsg, tid); } }
        else { const int v = u - 704; if (ENB(13)) s5_unit<1>(a, l, v >> 4, v & 15, ldsg, tid); }
    }
}

__device__ __forceinline__ float gelu_tanh(float x) { const float t = 0.7978845608028654f * (x + 0.044715f * x * x * x); return x * sigmoidf_(2.0f * t); }
__device__ __forceinline__ void fin_phase(const Ctx& a, int l, int G, const int tid) {
    const int lane = tid & 63, wave = __builtin_amdgcn_readfirstlane(tid >> 6);
    const int gw = a.bid * NWAVES + wave, NGW = G * NWAVES;
    const float* Y5 = (const float*)(a.ws + WS_Y5); const float* HF = (const float*)(a.ws + WS_HF); const float* HB = (const float*)(a.ws + WS_HB);
    const bf16* MO = (const bf16*)(a.ws + WS_MO); bf16* Z = (bf16*)(a.ws + WS_SU); bf16* MIX = (bf16*)(a.ws + WS_MIX);
    const f32x4 ng = *(const f32x4*)(inp(a, I_MNG) + l * 64 + 4 * (lane & 15));
    for (int m = gw; m < MTOK; m += NGW) {
        const f32x4 y = *(const f32x4*)(Y5 + (size_t)m * 256 + 4 * lane);
        u32x2 zw; zw.x = pk2(gelu_tanh(y.x), gelu_tanh(y.y)); zw.y = pk2(gelu_tanh(y.z), gelu_tanh(y.w));
        *(u32x2*)(Z + (size_t)m * 256 + 4 * lane) = zw;
        const f32x4 hv = *(const f32x4*)(HF + (size_t)m * 256 + 4 * lane) + *(const f32x4*)(HB + (size_t)m * 256 + 4 * lane);
        float ss = (hv.x * hv.x + hv.y * hv.y) + (hv.z * hv.z + hv.w * hv.w);
        ss += __shfl_xor(ss, 1); ss += __shfl_xor(ss, 2); ss += __shfl_xor(ss, 4); ss += __shfl_xor(ss, 8);
        const float r = rsqrtf(ss * (1.0f / 64.0f) + EPS);
        const u32x2 mo = *(const u32x2*)(MO + (size_t)m * 256 + 4 * lane);
        const float o0 = __uint_as_float(mo.x << 16), o1 = __uint_as_float(mo.x & 0xffff0000u), o2 = __uint_as_float(mo.y << 16), o3 = __uint_as_float(mo.y & 0xffff0000u);
        u32x2 w; w.x = pk2(hv.x * r * ng.x * sigmoidf_(o0), hv.y * r * ng.y * sigmoidf_(o1)); w.y = pk2(hv.z * r * ng.z * sigmoidf_(o2), hv.w * r * ng.w * sigmoidf_(o3));
        *(u32x2*)(MIX + (size_t)m * 1024 + 768 + 4 * lane) = w;
    }
}

__device__ __forceinline__ void conv_phase(const Ctx& a, int l, int G, const int tid) {
    bf16* AU = (bf16*)(a.ws + WS_BIG);
    const float* cw = inp(a, I_CW) + (size_t)l * 3 * DFF; const float* cb = inp(a, I_CB) + (size_t)l * DFF;
    const int NIT = MTOK * (DFF / 8);
    for (int it = a.bid * 512 + tid; it < NIT; it += G * 512) {
        const int m = it / (DFF / 8), f0 = (it % (DFF / 8)) * 8;
        const int t = m < NPROMPT ? (m & 255) : ((m - NPROMPT) & 1023); const int Ls = m < NPROMPT ? 256 : 1024;
        bf16* pa = AU + (size_t)m * NGU + (f0 >> 7) * 256 + (f0 & 127);
        const v4u ac = *(const v4u*)pa, uu = *(const v4u*)(pa + 128);
        v4u ap = {0u, 0u, 0u, 0u}, an = {0u, 0u, 0u, 0u};
        if (t > 0) ap = *(const v4u*)(pa - NGU);
        if (t < Ls - 1) an = *(const v4u*)(pa + NGU);
        const unsigned acw[4] = {ac.x, ac.y, ac.z, ac.w}, apw[4] = {ap.x, ap.y, ap.z, ap.w}, anw[4] = {an.x, an.y, an.z, an.w}, uw[4] = {uu.x, uu.y, uu.z, uu.w};
        float w0[8], w1[8], w2[8], bb[8];
        *(f32x4*)&w0[0] = *(const f32x4*)(cw + f0); *(f32x4*)&w0[4] = *(const f32x4*)(cw + f0 + 4);
        *(f32x4*)&w1[0] = *(const f32x4*)(cw + DFF + f0); *(f32x4*)&w1[4] = *(const f32x4*)(cw + DFF + f0 + 4);
        *(f32x4*)&w2[0] = *(const f32x4*)(cw + 2 * DFF + f0); *(f32x4*)&w2[4] = *(const f32x4*)(cw + 2 * DFF + f0 + 4);
        *(f32x4*)&bb[0] = *(const f32x4*)(cb + f0); *(f32x4*)&bb[4] = *(const f32x4*)(cb + f0 + 4);
        unsigned ow[4];
#pragma unroll
        for (int e = 0; e < 4; ++e) {
            const float c0 = w0[2 * e] * __uint_as_float(apw[e] << 16) + w1[2 * e] * __uint_as_float(acw[e] << 16) + w2[2 * e] * __uint_as_float(anw[e] << 16) + bb[2 * e];
            const float c1 = w0[2 * e + 1] * __uint_as_float(apw[e] & 0xffff0000u) + w1[2 * e + 1] * __uint_as_float(acw[e] & 0xffff0000u) + w2[2 * e + 1] * __uint_as_float(anw[e] & 0xffff0000u) + bb[2 * e + 1];
            ow[e] = pk2(c0 * sigmoidf_(c0) * __uint_as_float(uw[e] << 16), c1 * sigmoidf_(c1) * __uint_as_float(uw[e] & 0xffff0000u));
        }
        v4u o; o.x = ow[0]; o.y = ow[1]; o.z = ow[2]; o.w = ow[3];
        *(v4u*)(pa + 128) = o;
    }
}

constexpr int N_PHASES = 21;
#ifndef MK_SPLIT
#define MK_SPLIT 0
#endif

__global__ void __launch_bounds__(NWAVES * 64, 2) hyb_fwd(Args args) {
    extern __shared__ __attribute__((aligned(16))) unsigned char lds[];
    const int tid0 = threadIdx.x; const int G0 = gridDim.x;
    LAS unsigned char* ldsl = (LAS unsigned char*)lds;
    volatile LAS unsigned* MISC = (volatile LAS unsigned*)(ldsl + MISC_OFF);
    for (int u = tid0; u < (LDS_BYTES - LDSCTL_OFF) / 4; u += NWAVES * 64) ((LAS unsigned*)(ldsl + LDSCTL_OFF))[u] = 0u;
    __syncthreads();
    LAS unsigned long long* ptab = (LAS unsigned long long*)(ldsl + MISC_OFF + 256);
    if (tid0 < 36) ptab[tid0] = (unsigned long long)args.in[tid0];
    __syncthreads();
    gu32* ctl = (gu32*)(args.ws + WS_CTL);
    XcdBarrier bar; bar.bar = (unsigned*)(ctl + CW_BAR); bar.x = 0; bar.st = nullptr;
    if (!MK_SPLIT) bar = xcd_barrier_post((unsigned*)(ctl + CW_BAR), MISC + 8);
    const int lo = args.ph_lo, hi = args.ph_hi;
    const int wave_s = __builtin_amdgcn_readfirstlane(tid0 >> 6);
    for (int it = lo; it < hi; ++it) {
        const int ph = (PROBE_REP < 0 || it <= PROBE_REP) ? it : (it <= PROBE_REP + PROBE_NREP ? PROBE_REP : it - PROBE_NREP);
        const int rep = (PROBE_REP >= 0 && it > PROBE_REP && it <= PROBE_REP + PROBE_NREP) ? it - PROBE_REP : 0;
        unsigned ones = ~0u; asm volatile("" : "+s"(ones));
        int tid = wave_s * 64 + (int)__builtin_amdgcn_mbcnt_hi(ones, __builtin_amdgcn_mbcnt_lo(ones, 0u)); asm volatile("" : "+v"(tid));
        Ctx a; a.ws = args.ws; a.out = args.out; a.tbl = ptab; a.bid = blockIdx.x; asm volatile("" : "+s"(a.ws)); asm volatile("" : "+s"(a.out)); asm volatile("" : "+s"(a.bid));
        int G = G0; asm volatile("" : "+s"(G));
        const float* modb = (const float*)(a.ws + WS_MOD);
        if (ph == 0) { if (ENB(0)) p0_prologue(a, lds, G, rep, MISC, tid); }
        else {
            const int l = (ph - 1) / 10, q = (ph - 1) % 10;
            switch (q) {
            case 0: if (ENB(1)) norm_phase(a, l, 0, G, tid); break;
            case 1: if (ENB(2)) { gates_phase(a, l, G, tid);
                pg8::Gemm g{(const pg8::bf16_t*)(a.ws + WS_H), (const pg8::bf16_t*)(a.ws + WS_WIN) + (size_t)l * 2048 * 1024, MTOK, 2048, 1024, 1024, 0};
                pg8::StaticOrder S; S.init(MTOK, 2048, G, a.bid);
                EpiG1 E{l, a.ws, a.out, inp(a, I_QG) + l * 64, inp(a, I_KG) + l * 64};
                pg8::gemm_phase<EpiG1, pg8::StaticOrder, true, true>(tid, ldsl, g, S, E); } break;
            case 2: if (ENB(3)) mix_phase(a, l, rep, lds, MISC, tid); break;
            case 3: if (ENB(4)) fin_phase(a, l, G, tid); break;
            case 4: if (ENB(5)) { pg8::Gemm g{(const pg8::bf16_t*)(a.ws + WS_SU), (const pg8::bf16_t*)(a.ws + WS_GLUT) + (size_t)l * 256 * 256, MTOK, 256, 256, 256, 0};
                pg8::StaticOrder S; S.init(MTOK, 256, G, a.bid);
                EpiGlu E{(const bf16*)(a.ws + WS_SU), (bf16*)(a.ws + WS_MIX), inp(a, I_GLUB) + l * 256};
                pg8::gemm_phase<EpiGlu, pg8::StaticOrder, true, true>(tid, ldsl, g, S, E); } break;
            case 5: if (ENB(6)) { pg8::Gemm g{(const pg8::bf16_t*)(a.ws + WS_MIX), (const pg8::bf16_t*)(a.ws + WS_WOUT) + (size_t)l * 1024 * 1024, MTOK, 1024, 1024, 1024, 0};
                pg8::StaticOrder S; S.init(MTOK, 1024, G, a.bid);
                EpiResid E{l == 0 ? inp(a, I_XP) : a.out + OUT_Y, l == 0 ? inp(a, I_XS) : a.out + OUT_Y + (size_t)NPROMPT * DM, a.out + OUT_Y, (rep && l == 1) ? (const float*)(a.ws + 131072) : modb + (size_t)l * 9 * 6144 + 2 * 1024};
                pg8::gemm_phase<EpiResid, pg8::StaticOrder, true, true>(tid, ldsl, g, S, E); } break;
            case 6: if (ENB(7)) norm_phase(a, l, 1, G, tid); break;
            case 7: if (ENB(8)) { pg8::Gemm g{(const pg8::bf16_t*)(a.ws + WS_H), (const pg8::bf16_t*)(a.ws + WS_WGU) + (size_t)l * NGU * 1024, MTOK, NGU, 1024, 1024, 0};
                StripOrder S{G, a.bid};
                EpiG3 E{(bf16*)(a.ws + WS_BIG), inp(a, I_CW) + (size_t)l * 3 * DFF, inp(a, I_CB) + (size_t)l * DFF, (LAS float*)(ldsl + XR_OFF)};
                pg8::gemm_phase<EpiG3, StripOrder, true, true>(tid, ldsl, g, S, E); } break;
            case 8: break;
            case 9: if (ENB(10)) { pg8::Gemm g{(const pg8::bf16_t*)(a.ws + WS_BIG), (const pg8::bf16_t*)(a.ws + WS_WDN) + (size_t)l * 1024 * DFF, MTOK, 1024, DFF, DFF, 0};
                pg8::StaticOrder S; S.init(MTOK, 1024, G, a.bid);
                EpiResid E{a.out + OUT_Y, a.out + OUT_Y + (size_t)NPROMPT * DM, a.out + OUT_Y, rep ? (const float*)(a.ws + 131072) : modb + (size_t)l * 9 * 6144 + 5 * 1024};
                pg8::gemm_phase<EpiResid, pg8::StaticOrder, true, true>(tid, ldsl, g, S, E); } break;
            }
        }
        if (it + 1 < hi) xcd_barrier(bar);
        if (PROBE_XBAR && it + 1 < hi) { for (int xb = 0; xb < PROBE_XBAR; ++xb) xcd_barrier(bar); }
    }
}

extern "C" void kernel_launch(void* const* d_in, const int* in_sizes, int n_in, void* d_out, int out_size, void* d_ws, size_t ws_size, hipStream_t stream) {
    static int grid = 0;
    if (grid == 0) {
        if (n_in != 36 || ws_size < WS_END) { fprintf(stderr, "kernel_launch: unexpected inputs (n_in %d, ws %zu)\n", n_in, ws_size); grid = -1; return; }
        int dev = 0, cus = 0, per_cu = 0;
        if (hipGetDevice(&dev) != hipSuccess || hipDeviceGetAttribute(&cus, hipDeviceAttributeMultiprocessorCount, dev) != hipSuccess) { grid = -1; return; }
        if (hipFuncSetAttribute((const void*)hyb_fwd, hipFuncAttributeMaxDynamicSharedMemorySize, LDS_BYTES) != hipSuccess) { fprintf(stderr, "kernel_launch: hipFuncSetAttribute failed\n"); grid = -1; return; }
        if (hipOccupancyMaxActiveBlocksPerMultiprocessor(&per_cu, (const void*)hyb_fwd, NWAVES * 64, LDS_BYTES) != hipSuccess || per_cu < 1) { fprintf(stderr, "kernel_launch: occupancy query says %d\n", per_cu); }
        (void)hipGetLastError();
        grid = cus;
    }
    if (grid < 0) return;
    (void)hipMemsetAsync((char*)d_ws + WS_CTL, 0, CTL_ZERO_BYTES, stream);
    Args a{};
    for (int i = 0; i < 36; ++i) a.in[i] = (const float*)d_in[i];
    a.out = (float*)d_out; a.ws = (unsigned char*)d_ws;
#if MK_SPLIT
    for (int ph = 0; ph < N_PHASES; ++ph) { a.ph_lo = ph; a.ph_hi = ph + 1; hipLaunchKernelGGL(hyb_fwd, dim3(grid), dim3(NWAVES * 64), LDS_BYTES, stream, a); }
#else
    a.ph_lo = 0; a.ph_hi = N_PHASES + (PROBE_REP >= 0 ? PROBE_NREP : 0);
    hipLaunchKernelGGL(hyb_fwd, dim3(grid), dim3(NWAVES * 64), LDS_BYTES, stream, a);
#endif
}
```

```cpp
#include <hip/hip_runtime.h>
#include <hip/hip_bf16.h>
#include <cstdio>
#include <cstdint>
#include <cmath>
namespace pg8 {
#define PG8_LAS __attribute__((address_space(3)))
typedef unsigned short bf16_t;
typedef short bf16x8 __attribute__((ext_vector_type(8)));
typedef float f32x4 __attribute__((ext_vector_type(4)));
typedef unsigned u32x4 __attribute__((ext_vector_type(4)));
constexpr int BM = 256, BK = 64, HALF = 128, HTB = HALF * BK * 2  , STAGE_BYTES = 8 * HTB, NXCD = 8, WGM = 8;

__host__ __device__ __forceinline__ int lds_byte(int r, int c) { const int st = (r >> 4) * 2 + (c >> 5), rr = r & 15, cc = c & 31, ob = rr * 64 + cc * 2; return st * 1024 + (ob ^ (((ob >> 9) & 1) << 5)); }
__host__ __device__ __forceinline__ void stage_rc(int b, int& R, int& C) { const int st = b / 1024, sb = b % 1024, swz = sb ^ (((sb >> 9) & 1) << 5); R = (st >> 1) * 16 + swz / 64; C = (st & 1) * 32 + (swz % 64) / 2; }
__host__ __device__ __forceinline__ int perm32(int rho) { const int n = rho >> 4, i = rho & 15; return 8 * (i >> 2) + 4 * n + (i & 3); }

struct Unit { int pm, pn; };
struct Gemm { const bf16_t* A; const bf16_t* Bt; int M, N, K; int lda; int amode; };

struct StaticOrder {
    int nM, nN, nwg, G, c;
    __host__ __device__ void init(int M, int N, int G_, int c_) { nM = M / BM; nN = N / BM; nwg = nM * nN; G = G_; c = c_; }
    __host__ __device__ bool next(int i, Unit& u) const {
        const long L = (long)i * G + c; if (L >= nwg) return false;
        int wgid = (int)L; { const int q = nwg / NXCD, r = nwg % NXCD, xcd = wgid % NXCD, off = wgid / NXCD; wgid = (xcd < r ? xcd * (q + 1) : r * (q + 1) + (xcd - r) * q) + off; }
        const int nig = WGM * nN, gid = wgid / nig, fm = gid * WGM, gsz = (nM - fm) < WGM ? (nM - fm) : WGM;
        u.pm = fm + ((wgid % nig) % gsz); u.pn = (wgid % nig) / gsz; return true;
    }
    __device__ __forceinline__ void a_ready(const Unit&) const {}
    __device__ __forceinline__ void done(const Unit&) const {}
};

__device__ __forceinline__ unsigned cvt_pk_bf16(float lo, float hi) { unsigned r; asm volatile("v_cvt_pk_bf16_f32 %0, %1, %2" : "=v"(r) : "v"(lo), "v"(hi)); return r; }
typedef float f32x2 __attribute__((ext_vector_type(2)));
__device__ __forceinline__ f32x2 gelu_pk(f32x2 v) {
    const f32x2 av = __builtin_elementwise_abs(v), d = av * 0.2316418882f + 1.0f;
    f32x2 t; t.x = __builtin_amdgcn_rcpf(d.x); t.y = __builtin_amdgcn_rcpf(d.y);
    f32x2 q = t * 0.5307027145f + (-0.7265760135f); q = q * t + 0.7107068705f; q = q * t + (-0.142248368f); q = q * t + 0.127414796f; q = q * t;
    const f32x2 s = (v * v) * (-0.72134752044f);
    f32x2 e; e.x = __builtin_amdgcn_exp2f(s.x); e.y = __builtin_amdgcn_exp2f(s.y);
    const f32x2 m = v * (q * e), r = v - m;
    f32x2 o; o.x = v.x < 0.f ? m.x : r.x; o.y = v.y < 0.f ? m.y : r.y; return o;
}

template <int ACT  > struct EpiBf16 {
    static constexpr bool PERM = true, AFTER_DRAIN = false; static_assert(ACT == 0 || ACT == 1, "EpiBf16: ACT is 0 (none) or 1 (gelu_pk)");
    bf16_t* O; int ldc; const float* bias; int split_cols; size_t split_stride; float scale0;
    __device__ __forceinline__ void operator()(const f32x4 (&acc)[2][2][4][2], const Unit& u, int wr, int wc, int fr, int fq) const {
        const int row0 = u.pm * BM + wr * 64 + fr; int colt = u.pn * BM; bf16_t* base = O;
        float sc = 1.f; if (split_cols) { const int t = colt / split_cols; base += (size_t)t * split_stride; colt -= t * split_cols; if (t == 0) sc = scale0; }
        const int col0 = colt + wc * 32 + 8 * fq, bcol0 = u.pn * BM + wc * 32 + 8 * fq;
        f32x4 bv[2][2];
#pragma unroll
        for (int bj = 0; bj < 2; ++bj)
#pragma unroll
            for (int n = 0; n < 2; ++n) bv[bj][n] = bias ? *(const f32x4*)(bias + bcol0 + bj * HALF + 4 * n) : (f32x4){0.f, 0.f, 0.f, 0.f};
#pragma unroll
        for (int ai = 0; ai < 2; ++ai)
#pragma unroll
            for (int m = 0; m < 4; ++m) { bf16_t* rowp = base + (size_t)(row0 + ai * HALF + m * 16) * ldc + col0;
#pragma unroll
                for (int bj = 0; bj < 2; ++bj) { f32x4 v0 = acc[ai][bj][m][0] + bv[bj][0], v1 = acc[ai][bj][m][1] + bv[bj][1];
                    if (ACT == 1) { f32x2 a = gelu_pk((f32x2){v0[0], v0[1]}), b = gelu_pk((f32x2){v0[2], v0[3]}), c = gelu_pk((f32x2){v1[0], v1[1]}), d = gelu_pk((f32x2){v1[2], v1[3]});
                        v0 = (f32x4){a.x, a.y, b.x, b.y}; v1 = (f32x4){c.x, c.y, d.x, d.y}; }
                    v0 = v0 * sc; v1 = v1 * sc; u32x4 w; w.x = cvt_pk_bf16(v0[0], v0[1]); w.y = cvt_pk_bf16(v0[2], v0[3]); w.z = cvt_pk_bf16(v1[0], v1[1]); w.w = cvt_pk_bf16(v1[2], v1[3]);
                    *(u32x4*)(rowp + bj * HALF) = w; } }
    }
};


template <class Epi, class Sched, bool ALIGN_EPI = false, bool SP2 = false>
__device__ __forceinline__ void gemm_phase(const int tid, PG8_LAS unsigned char* lds, const Gemm g, const Sched& S, const Epi& E) {
    const int wid = __builtin_amdgcn_readfirstlane(tid >> 6), lane = tid & 63, wr = wid >> 2, wc = wid & 3, fr = lane & 15, fq = lane >> 4;
    const int K = g.K, nt = K / BK;
    unsigned voffA[2], voffB[2];
#pragma unroll
    for (int i = 0; i < 2; ++i) { int R, C; stage_rc(tid * 16 + i * 8192, R, C); const int Rb = Epi::PERM ? ((R & ~31) + perm32(R & 31)) : R;
        voffA[i] = (unsigned)(R * g.lda + C) * 2u; voffB[i] = (unsigned)(Rb * K + C) * 2u; }
    const size_t kstep = (size_t)(BK * 2);
    const size_t hstepA = (size_t)HALF * g.lda * 2, hstepB = (size_t)HALF * K * 2;
    const size_t tstepA = 2 * hstepA, tstepB = 2 * hstepB;
    const int amode = g.amode;
#define PG8_AK(t) ((size_t)(amode ? (((t) >> 1) * 512 + ((t) & 1) * 128) : ((t) * 128)))
    const unsigned ldsw = (unsigned)wid * 1024u;
    const int aoff = lds_byte(wr * 64 + fr, fq * 8), boff = lds_byte(wc * 32 + fr, fq * 8);
#define PG8_SA(b, h) (((b) * 2 + (h)) * HTB)
#define PG8_SB(b, h) ((4 + (b) * 2 + (h)) * HTB)
#define PG8_STAGE(bufoff, gbase, voff) do { _Pragma("unroll") for (int _i = 0; _i < 2; ++_i) \
        __builtin_amdgcn_global_load_lds((const unsigned*)((const char*)(gbase) + (voff)[_i]), (PG8_LAS unsigned*)(lds + (bufoff) + ldsw + _i * 8192), 16, 0, 0); } while (0)
#define PG8_LDA(dst, b, h) do { _Pragma("unroll") for (int m = 0; m < 4; ++m) _Pragma("unroll") for (int k = 0; k < 2; ++k) dst[m][k] = *(const PG8_LAS bf16x8*)(lds + PG8_SA(b, h) + aoff + m * 2048 + k * 1024); } while (0)
#define PG8_LDB(dst, b, h) do { _Pragma("unroll") for (int n = 0; n < 2; ++n) _Pragma("unroll") for (int k = 0; k < 2; ++k) dst[n][k] = *(const PG8_LAS bf16x8*)(lds + PG8_SB(b, h) + boff + n * 2048 + k * 1024); } while (0)
#define PG8_MMA(ai, bj, At, Bt) do { __builtin_amdgcn_s_setprio(1); _Pragma("unroll") for (int m = 0; m < 4; ++m) _Pragma("unroll") for (int n = 0; n < 2; ++n) _Pragma("unroll") for (int k = 0; k < 2; ++k) \
        acc[ai][bj][m][n] = __builtin_amdgcn_mfma_f32_16x16x32_bf16(Bt[n][k], At[m][k], acc[ai][bj][m][n], 0, 0, 0); __builtin_amdgcn_s_setprio(0); } while (0)
#define PG8_WAIT_V(n) asm volatile("s_waitcnt vmcnt(" #n ")" ::: "memory")
#define PG8_WAIT_L(n) asm volatile("s_waitcnt lgkmcnt(" #n ")" ::: "memory")
#define PG8_BAR __builtin_amdgcn_s_barrier()
#define PG8_SCHED __builtin_amdgcn_sched_barrier(0)
    Unit cur, nxt; int ui = 0;
    if (!S.next(0, cur)) return;
    f32x4 acc[2][2][4][2];
#pragma unroll
    for (int a = 0; a < 2; ++a)
#pragma unroll
        for (int b = 0; b < 2; ++b)
#pragma unroll
            for (int m = 0; m < 4; ++m)
#pragma unroll
                for (int n = 0; n < 2; ++n) acc[a][b][m][n] = (f32x4){0.f, 0.f, 0.f, 0.f};
    bf16x8 At[4][2], B0[2][2], B1[2][2];
    const char* cA = (const char*)g.A + (size_t)cur.pm * tstepA; const char* cB = (const char*)g.Bt + (size_t)cur.pn * tstepB;
    S.a_ready(cur);
    if constexpr (SP2) {
        PG8_STAGE(PG8_SB(0, 0), cB, voffB); PG8_STAGE(PG8_SB(0, 1), cB + hstepB, voffB); PG8_STAGE(PG8_SA(0, 0), cA, voffA); PG8_STAGE(PG8_SA(0, 1), cA + hstepA, voffA);
        if (wr == 1) PG8_BAR;
        PG8_WAIT_V(2); PG8_BAR;
        PG8_STAGE(PG8_SB(1, 0), cB + kstep, voffB); PG8_STAGE(PG8_SA(1, 0), cA + kstep, voffA); PG8_STAGE(PG8_SB(1, 1), cB + hstepB + kstep, voffB);
        PG8_WAIT_V(6); PG8_BAR;
    } else {
        PG8_STAGE(PG8_SB(0, 0), cB, voffB); PG8_STAGE(PG8_SA(0, 0), cA, voffA); PG8_STAGE(PG8_SB(0, 1), cB + hstepB, voffB); PG8_STAGE(PG8_SA(0, 1), cA + hstepA, voffA);
        if (wr == 1) PG8_BAR;
        PG8_WAIT_V(4); PG8_BAR;
        PG8_STAGE(PG8_SB(1, 0), cB + kstep, voffB); PG8_STAGE(PG8_SA(1, 0), cA + kstep, voffA); PG8_STAGE(PG8_SB(1, 1), cB + hstepB + kstep, voffB);
        PG8_WAIT_V(6); PG8_BAR;
    }
    for (;;) {
        const bool has_next = S.next(ui + 1, nxt);
        const char* nA = has_next ? (const char*)g.A + (size_t)nxt.pm * tstepA : cA; const char* nB = has_next ? (const char*)g.Bt + (size_t)nxt.pn * tstepB : cB;
        for (int t = 0; t < nt; t += 2) {
            const bool last = (t == nt - 2);
            const char* a1 = cA + PG8_AK(t + 1);
            const char* a2 = last ? nA : cA + PG8_AK(t + 2); const char* b2 = last ? nB : cB + (size_t)(t + 2) * kstep;
            const char* a3 = a2 + kstep; const char* b3 = b2 + kstep;
            if (last && has_next) S.a_ready(nxt);
            if constexpr (SP2) {
            PG8_LDB(B0, 0, 0); PG8_LDB(B1, 0, 1); PG8_SCHED; PG8_LDA(At, 0, 0); PG8_STAGE(PG8_SA(1, 1), a1 + hstepA, voffA);
            PG8_WAIT_V(8); PG8_WAIT_L(0); PG8_BAR; PG8_MMA(0, 0, At, B0); PG8_MMA(0, 1, At, B1); PG8_BAR; PG8_SCHED;
            PG8_LDA(At, 0, 1); PG8_STAGE(PG8_SB(0, 0), b2, voffB); PG8_STAGE(PG8_SB(0, 1), b2 + hstepB, voffB); PG8_STAGE(PG8_SA(0, 0), a2, voffA);
            PG8_WAIT_V(8); PG8_WAIT_L(0); PG8_BAR; PG8_MMA(1, 0, At, B0); PG8_MMA(1, 1, At, B1); PG8_BAR; PG8_SCHED;
            PG8_LDB(B0, 1, 0); PG8_LDB(B1, 1, 1); PG8_SCHED; PG8_LDA(At, 1, 0); PG8_STAGE(PG8_SA(0, 1), a2 + hstepA, voffA);
            PG8_WAIT_V(8); PG8_WAIT_L(0); PG8_BAR; PG8_MMA(0, 0, At, B0); PG8_MMA(0, 1, At, B1); PG8_BAR; PG8_SCHED;
            PG8_LDA(At, 1, 1); PG8_STAGE(PG8_SB(1, 0), b3, voffB); PG8_STAGE(PG8_SB(1, 1), b3 + hstepB, voffB); PG8_STAGE(PG8_SA(1, 0), a3, voffA);
            PG8_WAIT_V(8); PG8_WAIT_L(0); PG8_BAR; PG8_MMA(1, 0, At, B0); PG8_MMA(1, 1, At, B1); PG8_BAR; PG8_SCHED;
            } else {
            PG8_LDB(B0, 0, 0); PG8_SCHED; PG8_LDA(At, 0, 0); PG8_STAGE(PG8_SA(1, 1), a1 + hstepA, voffA);
            PG8_WAIT_L(8); PG8_BAR; PG8_WAIT_L(0); PG8_MMA(0, 0, At, B0); PG8_BAR; PG8_SCHED;
            PG8_LDB(B1, 0, 1); PG8_STAGE(PG8_SB(0, 0), b2, voffB);
            PG8_BAR; PG8_WAIT_L(0); PG8_MMA(0, 1, At, B1); PG8_BAR;
            PG8_LDA(At, 0, 1); PG8_STAGE(PG8_SA(0, 0), a2, voffA);
            PG8_BAR; PG8_WAIT_L(0); PG8_MMA(1, 0, At, B0); PG8_BAR; PG8_SCHED;
            PG8_STAGE(PG8_SB(0, 1), b2 + hstepB, voffB);
            PG8_WAIT_V(6); PG8_BAR; PG8_MMA(1, 1, At, B1); PG8_BAR;
            PG8_LDB(B0, 1, 0); PG8_SCHED; PG8_LDA(At, 1, 0); PG8_STAGE(PG8_SA(0, 1), a2 + hstepA, voffA);
            PG8_WAIT_L(8); PG8_BAR; PG8_WAIT_L(0); PG8_MMA(0, 0, At, B0); PG8_BAR; PG8_SCHED;
            PG8_LDB(B1, 1, 1); PG8_STAGE(PG8_SB(1, 0), b3, voffB);
            PG8_BAR; PG8_WAIT_L(0); PG8_MMA(0, 1, At, B1); PG8_BAR;
            PG8_LDA(At, 1, 1); PG8_STAGE(PG8_SA(1, 0), a3, voffA);
            PG8_BAR; PG8_WAIT_L(0); PG8_MMA(1, 0, At, B0); PG8_BAR; PG8_SCHED;
            PG8_STAGE(PG8_SB(1, 1), b3 + hstepB, voffB);
            PG8_WAIT_V(6); PG8_BAR; PG8_MMA(1, 1, At, B1); PG8_BAR;
            }
        }
        if constexpr (ALIGN_EPI) { if (wr == 0) PG8_BAR; }
        if constexpr (!Epi::AFTER_DRAIN) { int fr_ = fr, fq_ = fq; asm volatile("" : "+v"(fr_), "+v"(fq_));
            E(acc, cur, wr, wc, fr_, fq_); S.done(cur); }
        if (!has_next) break;
#pragma unroll
        for (int a = 0; a < 2; ++a)
#pragma unroll
            for (int b = 0; b < 2; ++b)
#pragma unroll
                for (int m = 0; m < 4; ++m)
#pragma unroll
                    for (int n = 0; n < 2; ++n) acc[a][b][m][n] = (f32x4){0.f, 0.f, 0.f, 0.f};
        cur = nxt; cA = nA; cB = nB; ++ui;
        if constexpr (ALIGN_EPI) { if (wr == 1) PG8_BAR; }
    }
    PG8_WAIT_V(0);
    if constexpr (!ALIGN_EPI) { if (wr == 0) PG8_BAR; }
    PG8_BAR;
    if constexpr (Epi::AFTER_DRAIN) { E.fused(acc, cur, wr, wc, fr, fq, lds, wid, lane); S.done(cur); }
#undef PG8_AK
#undef PG8_SA
#undef PG8_SB
#undef PG8_STAGE
#undef PG8_LDA
#undef PG8_LDB
#undef PG8_MMA
#undef PG8_WAIT_V
#undef PG8_WAIT_L
#undef PG8_BAR
#undef PG8_SCHED
}
}

#include <hip/hip_bf16.h>
#include <cmath>
namespace attn_body {
using bf16=__hip_bfloat16;
using bf16x8=__attribute__((ext_vector_type(8)))short;
using s16x4=__attribute__((ext_vector_type(4)))short;
using f32x16=__attribute__((ext_vector_type(16)))float;
using u32x4=__attribute__((ext_vector_type(4)))unsigned;
constexpr int D=64;
constexpr int NW=8,QBLK=32,QB=QBLK*NW,KVBLK=64;
constexpr int ATTN_UNIT_ROWS=QB;
__device__ __forceinline__ int crow(int r,int hi){return (r&3)+8*(r>>2)+4*hi;}
#define SBAR() __builtin_amdgcn_sched_barrier(0)
__device__ __forceinline__ void cmask(f32x16&p0,f32x16&p1,int jb,int qrel,int hi){
  const float NEG=-INFINITY; int kb=64*jb+4*hi;
  #pragma unroll
  for(int r=0;r<16;++r){int kv=kb+(r&3)+8*(r>>2); if(kv>qrel)p0[r]=NEG; if(kv+32>qrel)p1[r]=NEG;}
}

constexpr int NSLOT=3, SLOTB=8192;
constexpr int LDS_K=0, LDS_V=NSLOT*SLOTB, LDS_WS=2*NSLOT*SLOTB, LDS_OST=LDS_WS+NW*64*4, LDS_BYTES=LDS_OST+NW*4096;
constexpr float C2=0.125f*1.4426950408889634f;
__device__ __forceinline__ void glds16(const void*gsrc,unsigned lds_dst){unsigned keep;
  asm volatile("s_mov_b32 %0, m0\n\ts_mov_b32 m0, %2\n\ts_nop 0\n\tglobal_load_lds_dwordx4 %1, off\n\ts_mov_b32 m0, %0":"=&s"(keep):"v"(gsrc),"s"(lds_dst):"memory");}
__device__ __forceinline__ float max3f(float a,float b,float c){float r;asm("v_max3_f32 %0, %1, %2, %3":"=v"(r):"v"(a),"v"(b),"v"(c));return r;}
__device__ __forceinline__ float max2f(float a,float b){float r;asm("v_max_f32_e32 %0, %1, %2":"=v"(r):"v"(a),"v"(b));return r;}
__device__ __forceinline__ float fadd_s(float a,float b){float r;asm("v_add_f32_e32 %0, %1, %2":"=v"(r):"v"(a),"v"(b));return r;}
__device__ __forceinline__ float fsub_s(float a,float b){float r;asm("v_sub_f32_e32 %0, %1, %2":"=v"(r):"v"(a),"v"(b));return r;}
typedef float f32x2_t __attribute__((ext_vector_type(2))); typedef __bf16 bf16x2_t __attribute__((ext_vector_type(2)));
__device__ __forceinline__ unsigned cvtpk_s(float lo,float hi){f32x2_t v={lo,hi};bf16x2_t b=__builtin_convertvector(v,bf16x2_t);return __builtin_bit_cast(unsigned,b);}
#define WAIT_BAR(N) asm volatile("s_waitcnt vmcnt(" #N ") lgkmcnt(0)\n\ts_barrier":::"memory")

__device__ __forceinline__ void qkt(f32x16&p0,f32x16&p1,const char*Kslot,const bf16x8*qr,const f32x16&negm,int r32,int hi){
  const char*kb=Kslot+hi*1024+r32*16;
  #pragma unroll
  for(int d0=0;d0<4;++d0){
    const bf16x8 b0=*reinterpret_cast<const bf16x8*>(kb+d0*2048);
    const bf16x8 b1=*reinterpret_cast<const bf16x8*>(kb+d0*2048+512);
    if(d0==0){p0=__builtin_amdgcn_mfma_f32_32x32x16_bf16(b0,qr[0],negm,0,0,0);p1=__builtin_amdgcn_mfma_f32_32x32x16_bf16(b1,qr[0],negm,0,0,0);}
    else{p0=__builtin_amdgcn_mfma_f32_32x32x16_bf16(b0,qr[d0],p0,0,0,0);p1=__builtin_amdgcn_mfma_f32_32x32x16_bf16(b1,qr[d0],p1,0,0,0);}}
}
typedef __attribute__((address_space(3))) const char* lds_cptr;
typedef short v4i16_t __attribute__((ext_vector_type(4)));
__device__ __forceinline__ void kload8(bf16x8*kf,lds_cptr kp){
  kf[0]=*(const __attribute__((address_space(3))) bf16x8*)(kp);      kf[1]=*(const __attribute__((address_space(3))) bf16x8*)(kp+512);
  kf[2]=*(const __attribute__((address_space(3))) bf16x8*)(kp+2048); kf[3]=*(const __attribute__((address_space(3))) bf16x8*)(kp+2560);
  kf[4]=*(const __attribute__((address_space(3))) bf16x8*)(kp+4096); kf[5]=*(const __attribute__((address_space(3))) bf16x8*)(kp+4608);
  kf[6]=*(const __attribute__((address_space(3))) bf16x8*)(kp+6144); kf[7]=*(const __attribute__((address_space(3))) bf16x8*)(kp+6656);
}
__device__ __forceinline__ void kload2(bf16x8*kf,lds_cptr kp,int j){ kf[2*j]=*(const __attribute__((address_space(3))) bf16x8*)(kp+j*2048); kf[2*j+1]=*(const __attribute__((address_space(3))) bf16x8*)(kp+j*2048+512); }
__device__ __forceinline__ s16x4 vtr(lds_cptr p){ return __builtin_bit_cast(s16x4,__builtin_amdgcn_ds_read_tr16_b64_v4i16((__attribute__((address_space(3))) v4i16_t*)p)); }
__device__ __forceinline__ float rowmax(const f32x16&p0,const f32x16&p1){
  float a=max3f(p0[0],p0[1],p1[0]),b=max3f(p0[2],p0[3],p1[1]);a=max3f(a,p1[2],p1[3]);
  #pragma unroll
  for(int r=4;r<16;r+=4){a=max3f(a,p0[r],p0[r+1]);b=max3f(b,p0[r+2],p0[r+3]);a=max3f(a,p1[r],p1[r+1]);b=max3f(b,p1[r+2],p1[r+3]);}
  const float m=max2f(a,b);
  auto rr=__builtin_amdgcn_permlane32_swap(__float_as_uint(m),__float_as_uint(m),false,false);
  return max2f(__uint_as_float(rr[0]),__uint_as_float(rr[1]));
}
__device__ __forceinline__ void pv(f32x16*o,int vb,bf16x8 pa0,bf16x8 pa1,bf16x8 pa2,bf16x8 pa3){
  #pragma unroll
  for(int d0=0;d0<2;++d0){s16x4 lo[4],hi[4];
    #pragma unroll
    for(int ks=0;ks<4;++ks){
      asm volatile("ds_read_b64_tr_b16 %0,%1 offset:%c2":"=&v"(lo[ks]):"v"(vb),"i"(d0*4096+ks*1024):"memory");
      asm volatile("ds_read_b64_tr_b16 %0,%1 offset:%c2":"=&v"(hi[ks]):"v"(vb),"i"(d0*4096+ks*1024+512):"memory");}
    asm volatile("s_waitcnt lgkmcnt(0)":::"memory");SBAR();
    #define PK(k) (bf16x8){lo[k][0],lo[k][1],lo[k][2],lo[k][3],hi[k][0],hi[k][1],hi[k][2],hi[k][3]}
    o[d0]=__builtin_amdgcn_mfma_f32_32x32x16_bf16(pa0,PK(0),o[d0],0,0,0);
    o[d0]=__builtin_amdgcn_mfma_f32_32x32x16_bf16(pa1,PK(1),o[d0],0,0,0);
    o[d0]=__builtin_amdgcn_mfma_f32_32x32x16_bf16(pa2,PK(2),o[d0],0,0,0);
    o[d0]=__builtin_amdgcn_mfma_f32_32x32x16_bf16(pa3,PK(3),o[d0],0,0,0);
    #undef PK
  }
}

#ifndef ATTN_STORE16
#define ATTN_STORE16(p,v) (*(u32x4*)(p)=(v))
#endif
template<int THRL> __device__ __forceinline__ void attn_unit(const bf16*Q0,const int QP,const bf16*__restrict__ Kh,const bf16*__restrict__ Vh,const int KP,bf16*O0,const int OP,const int NT,char*shm,const int tid){
  const int lane=tid&63,r32=lane&31,hi=lane>>5; const int wid=__builtin_amdgcn_readfirstlane(tid>>6);
  const bf16*Qw=Q0+(long)(wid*QBLK)*QP;
  const unsigned lds0=(unsigned)(uintptr_t)shm;
  float*wsf=(float*)(shm+LDS_WS)+wid*64;
  const bf16*ksrc=Kh+(long)lane*KP+wid*8;
  const bf16*vsrc=Vh+(long)(16*(wid&3)+(lane>>2))*KP+(wid>>2)*32+(lane&3)*8;
  const unsigned kdst=lds0+LDS_K+wid*1024, vdst=lds0+LDS_V+wid*1024;
  #define DMA_K(t,slot) glds16(ksrc+(long)(t)*KVBLK*KP,(unsigned)__builtin_amdgcn_readfirstlane(kdst+(slot)))
  #define DMA_V(t,slot) glds16(vsrc+(long)(t)*KVBLK*KP,(unsigned)__builtin_amdgcn_readfirstlane(vdst+(slot)))
  const int vb0=(int)(lds0+LDS_V)+((lane>>4)&1)*32+(lane&3)*8+(4*hi+((lane&15)>>2))*64;
  const char*Kbase=shm+LDS_K; bf16x8 kf[8];
  const lds_cptr shm3=(lds_cptr)shm; const lds_cptr kp0=shm3+LDS_K+hi*1024+r32*16; const lds_cptr vp0=shm3+LDS_V+((lane>>4)&1)*32+(lane&3)*8+(4*hi+((lane&15)>>2))*64;
  DMA_K(0,0);DMA_V(0,0);DMA_K(1,SLOTB);
  bf16x8 qr[4];
  #pragma unroll
  for(int d0=0;d0<4;++d0)qr[d0]=*reinterpret_cast<const bf16x8*>(&Qw[(long)r32*QP+d0*16+hi*8]);
  float mhat=0.f,l_reg=0.f;f32x16 o[2];o[0]=f32x16{};o[1]=f32x16{};f32x16 negm=f32x16{};asm volatile("":"+v"(negm));
  #define CMASK(P0,P1,t) do{}while(0)
  bool resc=false;
  #define START(P0,P1) do{ const float rm=rowmax(P0,P1); resc=false; \
    { const float dl=rm; mhat=fadd_s(mhat,dl); \
      _Pragma("unroll") for(int r=0;r<16;++r){P0[r]=fsub_s(P0[r],dl);P1[r]=fsub_s(P1[r],dl);} \
      _Pragma("unroll") for(int r=0;r<16;++r)negm[r]=-mhat; asm volatile("":"+v"(negm)); } \
    _Pragma("unroll") for(int r=0;r<16;++r)P0[r]=__builtin_amdgcn_exp2f(P0[r]); }while(0)
  #define RESC() do{ if(resc){ asm volatile("s_waitcnt lgkmcnt(0)":::"memory"); \
      _Pragma("unroll") for(int d_=0;d_<2;++d_) _Pragma("unroll") for(int r=0;r<16;++r)o[d_][r]*=wsf[crow(r,hi)]; } }while(0)
  f32x16 pA0,pA1,pB0,pB1;
  int sl_prev=0,sl_cur=0,sl_next=SLOTB;
  #define ROT() do{sl_prev=sl_cur;sl_cur=sl_next;sl_next=(sl_next==(NSLOT-1)*SLOTB)?0:sl_next+SLOTB;}while(0)
  DMA_K(2,2*SLOTB);
  WAIT_BAR(3);
  qkt(pA0,pA1,Kbase,qr,negm,r32,hi);asm volatile("s_nop 15\n\ts_nop 7":"+v"(pA0),"+v"(pA1));CMASK(pA0,pA1,0);
  START(pA0,pA1);
  _Pragma("unroll") for(int r=0;r<16;++r)pA1[r]=__builtin_amdgcn_exp2f(pA1[r]);
  WAIT_BAR(0);
  DMA_K(3,0);DMA_V(1,SLOTB);
  ROT();
  kload8(kf,kp0+sl_cur);
  WAIT_BAR(2);
  s16x4 vlo[8],vhi[8]; u32x4 pw0,pw1,pw2,pw3;
  #define PKW(P,B) cvtpk_s(P[B],P[B+1])
  #define PAF(k) __builtin_bit_cast(bf16x8,pw##k)
  #define VFR(i) (bf16x8){vlo[i][0],vlo[i][1],vlo[i][2],vlo[i][3],vhi[i][0],vhi[i][1],vhi[i][2],vhi[i][3]}
  #define PIN(x) asm volatile("":"+v"(x))
  #define MX3(a,b,c) __builtin_fmaxf(__builtin_fmaxf((a),(b)),(c))
  #define GAPA(MF,A0,A1,A2,A3,W0,W1,PW) do{ MF; sacc+=A0; sacc+=A1; sacc+=A2; sacc+=A3; PIN(sacc); W0; W1; PIN(PW); SBAR(); }while(0)
  #define EX(v) __builtin_amdgcn_exp2f(v)
  #define GAPB(MF,X,B) do{ MF; X[B]=EX(X[B]); X[B+1]=EX(X[B+1]); X[B+2]=EX(X[B+2]); X[B+3]=EX(X[B+3]); PIN(X); SBAR(); }while(0)
  #define VRD(i) do{ vlo[i]=vtr(vp_+(((i)>>2)*4096+((i)&3)*1024)); vhi[i]=vtr(vp_+(((i)>>2)*4096+((i)&3)*1024+512)); }while(0)
  #define KRD(G,j) do{ if(G){ kload2(kf,kp0+sl_next,j); SBAR(); } }while(0)
  #define STEP(C0,C1,P0,P1,t,GK,GV,GL) do{ SBAR(); \
    const lds_cptr vp_=vp0+sl_prev; \
    VRD(0); SBAR(); float sacc=(P0[0]+P0[1]); \
    GAPA(C0=__builtin_amdgcn_mfma_f32_32x32x16_bf16(kf[0],qr[0],negm,0,0,0), P0[2],P0[3],P0[4],P0[5],     pw0[0]=PKW(P0,0), pw0[1]=PKW(P0,2), pw0); \
    VRD(4); SBAR(); GAPA(C1=__builtin_amdgcn_mfma_f32_32x32x16_bf16(kf[1],qr[0],negm,0,0,0), P0[6],P0[7],P0[8],P0[9],     pw0[2]=PKW(P0,4), pw0[3]=PKW(P0,6), pw0); \
    VRD(1); SBAR(); GAPA(C0=__builtin_amdgcn_mfma_f32_32x32x16_bf16(kf[2],qr[1],C0,0,0,0),   P0[10],P0[11],P0[12],P0[13], pw1[0]=PKW(P0,8), pw1[1]=PKW(P0,10), pw1); \
    VRD(5); SBAR(); GAPA(C1=__builtin_amdgcn_mfma_f32_32x32x16_bf16(kf[3],qr[1],C1,0,0,0),   P0[14],P0[15],P1[0],P1[1],   pw1[2]=PKW(P0,12),pw1[3]=PKW(P0,14), pw1); \
    VRD(2); SBAR(); GAPA(C0=__builtin_amdgcn_mfma_f32_32x32x16_bf16(kf[4],qr[2],C0,0,0,0),   P1[2],P1[3],P1[4],P1[5],     pw2[0]=PKW(P1,0), pw2[1]=PKW(P1,2), pw2); \
    VRD(6); SBAR(); GAPA(C1=__builtin_amdgcn_mfma_f32_32x32x16_bf16(kf[5],qr[2],C1,0,0,0),   P1[6],P1[7],P1[8],P1[9],     pw2[2]=PKW(P1,4), pw2[3]=PKW(P1,6), pw2); \
    VRD(3); SBAR(); GAPA(C0=__builtin_amdgcn_mfma_f32_32x32x16_bf16(kf[6],qr[3],C0,0,0,0),   P1[10],P1[11],P1[12],P1[13], pw3[0]=PKW(P1,8), pw3[1]=PKW(P1,10), pw3); \
    VRD(7); SBAR(); GAPA(C1=__builtin_amdgcn_mfma_f32_32x32x16_bf16(kf[7],qr[3],C1,0,0,0),   P1[14],P1[15],0.f,0.f,       pw3[2]=PKW(P1,12),pw3[3]=PKW(P1,14), pw3); \
    l_reg+=sacc; \
    if(GK){DMA_K((t)+3,sl_cur);} if(GV){DMA_V((t)+1,sl_next);} \
    CMASK(C0,C1,t); \
    { float a=MX3(C0[0],C0[1],C1[0]),b=MX3(C0[2],C0[3],C1[1]); a=MX3(a,C1[2],C1[3]); \
      _Pragma("unroll") for(int r=4;r<16;r+=4){a=MX3(a,C0[r],C0[r+1]);b=MX3(b,C0[r+2],C0[r+3]);a=MX3(a,C1[r],C1[r+1]);b=MX3(b,C1[r+2],C1[r+3]);} \
      float rm=__builtin_fmaxf(a,b); { auto rr=__builtin_amdgcn_permlane32_swap(__float_as_uint(rm),__float_as_uint(rm),false,false); rm=__builtin_fmaxf(__uint_as_float(rr[0]),__uint_as_float(rr[1])); } \
      resc=false; \
      if(__builtin_expect(__any(rm>(float)THRL),0)){ const float dl=__builtin_fmaxf(rm,0.f); mhat+=dl; \
        _Pragma("unroll") for(int r=0;r<16;++r){C0[r]-=dl;C1[r]-=dl;} \
        _Pragma("unroll") for(int r=0;r<16;++r)negm[r]=-mhat; asm volatile("":"+v"(negm)); \
        const float f=__builtin_amdgcn_exp2f(-dl); l_reg*=f; if(hi==0)wsf[r32]=f; resc=true; } } \
    SBAR(); \
    GAPB(o[0]=__builtin_amdgcn_mfma_f32_32x32x16_bf16(PAF(0),VFR(0),o[0],0,0,0), C0,0); \
    GAPB(o[1]=__builtin_amdgcn_mfma_f32_32x32x16_bf16(PAF(0),VFR(4),o[1],0,0,0), C0,4); \
    KRD(GL,0); GAPB(o[0]=__builtin_amdgcn_mfma_f32_32x32x16_bf16(PAF(1),VFR(1),o[0],0,0,0), C0,8); \
    KRD(GL,1); GAPB(o[1]=__builtin_amdgcn_mfma_f32_32x32x16_bf16(PAF(1),VFR(5),o[1],0,0,0), C0,12); \
    KRD(GL,2); GAPB(o[0]=__builtin_amdgcn_mfma_f32_32x32x16_bf16(PAF(2),VFR(2),o[0],0,0,0), C1,0); \
    KRD(GL,3); GAPB(o[1]=__builtin_amdgcn_mfma_f32_32x32x16_bf16(PAF(2),VFR(6),o[1],0,0,0), C1,4); \
    GAPB(o[0]=__builtin_amdgcn_mfma_f32_32x32x16_bf16(PAF(3),VFR(3),o[0],0,0,0), C1,8); \
    GAPB(o[1]=__builtin_amdgcn_mfma_f32_32x32x16_bf16(PAF(3),VFR(7),o[1],0,0,0), C1,12); \
    }while(0)
  int t=1;
  #undef CMASK
  #define CMASK(P0,P1,t) do{}while(0)
  for(;t+5<NT;t+=2){
    STEP(pB0,pB1,pA0,pA1,t,true,true,true);     WAIT_BAR(2); RESC(); ROT();
    STEP(pA0,pA1,pB0,pB1,t+1,true,true,true);   WAIT_BAR(2); RESC(); ROT();
  }
  #undef CMASK
  #define CMASK(P0,P1,t) do{}while(0)
  #define ENDW(tt) do{ if((tt)+3<NT){WAIT_BAR(2);} else if((tt)+2<NT){WAIT_BAR(1);} else {WAIT_BAR(0);} }while(0)
  for(;t+1<NT;t+=2){
    STEP(pB0,pB1,pA0,pA1,t,(t+3<NT),(t+1<NT),(t+1<NT));       ENDW(t);   RESC(); ROT();
    STEP(pA0,pA1,pB0,pB1,t+1,(t+4<NT),(t+2<NT),(t+2<NT));     ENDW(t+1); RESC(); ROT();
  }
  STEP(pB0,pB1,pA0,pA1,NT-1,false,false,false); RESC();
  { float sacc=pB0[0]+pB0[1]; _Pragma("unroll") for(int r=2;r<16;++r)sacc+=pB0[r]; _Pragma("unroll") for(int r=0;r<16;++r)sacc+=pB1[r]; l_reg+=sacc;
    pw0=(u32x4){PKW(pB0,0),PKW(pB0,2),PKW(pB0,4),PKW(pB0,6)};pw1=(u32x4){PKW(pB0,8),PKW(pB0,10),PKW(pB0,12),PKW(pB0,14)};pw2=(u32x4){PKW(pB1,0),PKW(pB1,2),PKW(pB1,4),PKW(pB1,6)};pw3=(u32x4){PKW(pB1,8),PKW(pB1,10),PKW(pB1,12),PKW(pB1,14)};
    SBAR(); pv(o,vb0+sl_cur,PAF(0),PAF(1),PAF(2),PAF(3)); }
  #undef PKW
  #undef PAF
  #undef VFR
  #undef PIN
  #undef MX3
  #undef GAPA
  #undef GAPB
  #undef EX
  #undef VRD
  #undef KRD
  #undef STEP
  #undef ENDW
  {auto rr=__builtin_amdgcn_permlane32_swap(__float_as_uint(l_reg),__float_as_uint(l_reg),false,false);l_reg=__uint_as_float(rr[0])+__uint_as_float(rr[1]);}
  if(hi==0)wsf[32+r32]=l_reg;asm volatile("s_waitcnt lgkmcnt(0)":::"memory");
  float rli[16];
  #pragma unroll
  for(int r=0;r<16;++r)rli[r]=__builtin_amdgcn_rcpf(wsf[32+crow(r,hi)]);
  bf16*Ow=O0+(long)(wid*QBLK)*OP;
  { bf16*stg=(bf16*)(shm+LDS_OST)+wid*2048;
    #pragma unroll
    for(int r=0;r<16;++r){const int orow=crow(r,hi);
      #pragma unroll
      for(int d0=0;d0<2;++d0)stg[orow*64+d0*32+r32]=__float2bfloat16(o[d0][r]*rli[r]);}
    asm volatile("s_waitcnt lgkmcnt(0)":::"memory");
    #pragma unroll
    for(int i=0;i<4;++i){const int row=i*8+(lane>>3),ch=lane&7; const u32x4 v=*(const u32x4*)(stg+row*64+ch*8); ATTN_STORE16(Ow+(long)row*OP+ch*8,v);} }
  asm volatile("s_waitcnt lgkmcnt(0)\n\ts_barrier":::"memory");
  #undef DMA_K
  #undef DMA_V
  #undef CMASK
  #undef START
  #undef RESC
  #undef ROT
}
constexpr int ATTN_LDS_BYTES=LDS_BYTES;
#undef SBAR
#undef WAIT_BAR
}

#define GAS __attribute__((address_space(1)))
#define LAS __attribute__((address_space(3)))
typedef unsigned short bf16;
typedef unsigned v4u __attribute__((ext_vector_type(4)));
typedef float f32x4 __attribute__((ext_vector_type(4)));
typedef short bf16x8 __attribute__((ext_vector_type(8)));
typedef GAS unsigned gu32;
typedef GAS unsigned long long gu64;
#define RLX_AGENT __ATOMIC_RELAXED, __HIP_MEMORY_SCOPE_AGENT
#define LDS_WAIT() asm volatile("s_waitcnt lgkmcnt(0)" ::: "memory")
#define VM_WAIT() asm volatile("s_waitcnt vmcnt(0)" ::: "memory")
__device__ __forceinline__ unsigned long long rt() { return __builtin_amdgcn_s_memrealtime(); }
__device__ __forceinline__ unsigned f2bf(float f) { unsigned u = __builtin_bit_cast(unsigned, f); return (u + 0x7fffu + ((u >> 16) & 1u)) >> 16; }
__device__ __forceinline__ unsigned pk2(float lo, float hi) { return f2bf(lo) | (f2bf(hi) << 16); }

#define XB_TMO      128
#define XB_XCNT(j)  (256  + 64 * (j))
#define XB_XSUB(j)  (1280 + 64 * (j))
#define XB_XGEN(j)  (2304 + 64 * (j))
#define XB_TOP      3328
#define XB_TOPGEN   3392
#define XCD_BAR_WORDS 3456
#define XB_SPIN_CAP (1u << 18)

__device__ __forceinline__ unsigned xb_ld(unsigned* p)              { return __hip_atomic_load(p, __ATOMIC_RELAXED, __HIP_MEMORY_SCOPE_AGENT); }
__device__ __forceinline__ unsigned xb_add(unsigned* p, unsigned v) { return __hip_atomic_fetch_add(p, v, __ATOMIC_RELAXED, __HIP_MEMORY_SCOPE_AGENT); }
__device__ __forceinline__ unsigned xb_xcc_id() { return (unsigned)__builtin_amdgcn_s_getreg((3 << 11) | 20) & 0xFu; }
#define XB_SPIN(cond, bar) do { unsigned _sp = 0; while (cond) { __builtin_amdgcn_s_sleep(1); \
    if ((++_sp & 255u) == 0u) { if (xb_ld(&(bar)[XB_TMO])) break; if (_sp > XB_SPIN_CAP) { atomicAdd(&(bar)[XB_TMO], 1u); break; } } } } while (0)

struct XcdBarrier {
    unsigned* bar; unsigned x;
    volatile LAS unsigned* st;
};

__device__ __forceinline__ XcdBarrier xcd_barrier_post(unsigned* bar, volatile LAS unsigned* st) {
    XcdBarrier b; b.bar = bar; b.x = xb_xcc_id(); b.st = st;
    if (threadIdx.x == 0) (void)xb_add(&bar[XB_XCNT(b.x)], 1u);
    return b;
}
__device__ __forceinline__ void xcd_barrier_complete(unsigned* bar, unsigned x, unsigned& nloc, unsigned& nx) {
    const unsigned G = gridDim.x * gridDim.y * gridDim.z;
    unsigned sum, cnt, mine, sp = 0u;
    for (;;) {
        sum = 0u; cnt = 0u; mine = 0u;
#pragma unroll
        for (unsigned j = 0; j < 16; ++j) { const unsigned c = xb_ld(&bar[XB_XCNT(j)]); sum += c; cnt += (c > 0u) ? 1u : 0u; mine = (j == x) ? c : mine; }
        if (sum == G) break;
        __builtin_amdgcn_s_sleep(1);
        if ((++sp & 255u) == 0u) { if (xb_ld(&bar[XB_TMO])) break; if (sp > XB_SPIN_CAP) { atomicAdd(&bar[XB_TMO], 1u); break; } }
    }
    nloc = mine > 0u ? mine : 1u; nx = cnt > 0u ? cnt : 1u;
}

__device__ __forceinline__ void xcd_barrier(const XcdBarrier& b) {
    asm volatile("s_waitcnt vmcnt(0)" ::: "memory");
    __syncthreads();
    if (threadIdx.x == 0) {
        unsigned* bar = b.bar;
        __builtin_amdgcn_s_waitcnt(0);
        unsigned nloc = b.st[0], nx = b.st[1];
        if (nloc == 0u) { xcd_barrier_complete(bar, b.x, nloc, nx); b.st[0] = nloc; b.st[1] = nx; }
        const unsigned old = xb_add(&bar[XB_XSUB(b.x)], 1u);
        const unsigned gen = old / nloc;
        if (old + 1u == (gen + 1u) * nloc) {
            __builtin_amdgcn_fence(__ATOMIC_RELEASE, "agent");
            asm volatile("s_waitcnt vmcnt(0)" ::: "memory");
            const unsigned og = xb_add(&bar[XB_TOP], 1u);
            const unsigned tg = og / nx;
            if (og + 1u == (tg + 1u) * nx) xb_add(&bar[XB_TOPGEN], 1u);
            else XB_SPIN(xb_ld(&bar[XB_TOPGEN]) == tg, bar);
            __builtin_amdgcn_fence(__ATOMIC_ACQUIRE, "agent");
            xb_add(&bar[XB_XGEN(b.x)], 1u);
            asm volatile("s_waitcnt vmcnt(0)" ::: "memory");
        } else {
            XB_SPIN(xb_ld(&bar[XB_XGEN(b.x)]) == gen, bar);
            __builtin_amdgcn_fence(__ATOMIC_ACQUIRE, "agent");
            asm volatile("s_waitcnt vmcnt(0)" ::: "memory");
        }
    }
    __syncthreads();
}

constexpr int NWAVES = 8;
#ifndef EN
#define EN 0xFFFF
#endif
#define ENB(b) ((EN >> (b)) & 1)
#ifndef PROBE_REP
#define PROBE_REP (-1)
#endif
#ifndef PROBE_NREP
#define PROBE_NREP 1
#endif
#ifndef PROBE_XBAR
#define PROBE_XBAR 0
#endif
#ifndef PROBE_MIXSEL
#define PROBE_MIXSEL 7
#endif
#ifndef PROBE_MLCH
#define PROBE_MLCH 64
#endif
constexpr int DM = 1024, NPROMPT = 4096, NSAMPLE = 8192, MTOK = 12288, DFF = 2816, NGU = 5632;
constexpr float EPS = 1e-6f;
constexpr float QSCALE = 0.125f * 1.4426950408889634f;
typedef unsigned u32x2 __attribute__((ext_vector_type(2)));

constexpr size_t OUT_Y = 0;
constexpr size_t OUT_K = 12582912, OUT_V = 13631488, OUT_S5RE = 14680064, OUT_S5IM = 14745600, OUT_MC = 14811136, OUT_MN = 15859712, OUT_MM = 15876096;

constexpr size_t MiB = 1u << 20;
constexpr size_t WS_CTL = 0, CTL_ZERO_BYTES = 1 * MiB;
constexpr size_t WS_MOD = 1 * MiB;
constexpr size_t WS_ROPE = 1 * MiB + 512 * 1024;
constexpr size_t WS_S5W1 = 2 * MiB;
constexpr size_t WS_S5W2 = 10 * MiB;
constexpr size_t WS_S5A16 = 14 * MiB;
constexpr size_t WS_GLUT = 15 * MiB;
constexpr size_t WS_WGT = 15 * MiB + 512 * 1024;
constexpr size_t WS_WIN = 16 * MiB;
constexpr size_t WS_WOUT = 24 * MiB;
constexpr size_t WS_WGU = 28 * MiB;
constexpr size_t WS_WDN = 50 * MiB;
constexpr size_t WS_GATES = 61 * MiB;
constexpr size_t WS_H = 62 * MiB;
constexpr size_t WS_BIG = 86 * MiB;
constexpr size_t WS_Q = 86 * MiB;
constexpr size_t WS_KP = 98 * MiB, WS_KS = 99 * MiB, WS_VP = 102 * MiB, WS_VS = 103 * MiB;
constexpr size_t WS_SU = 106 * MiB, WS_MQ = 112 * MiB, WS_MK = 118 * MiB, WS_MV = 124 * MiB, WS_MO = 130 * MiB;
constexpr size_t WS_MIX = 136 * MiB;
constexpr size_t WS_Y5 = 160 * MiB;
constexpr size_t WS_HF = 172 * MiB, WS_HB = 184 * MiB;
constexpr size_t WS_END = 256 * MiB;
static_assert(WS_BIG + (size_t)MTOK * NGU * 2 <= WS_END && WS_HB + (size_t)MTOK * 256 * 4 <= WS_BIG + (size_t)MTOK * NGU * 2, "d_ws map");

constexpr int CW_BAR = 4096;
constexpr int CW_QUEUE = 16384;

constexpr int RING_BYTES = 131072, LDSCTL_OFF = RING_BYTES, MISC_OFF = LDSCTL_OFF + 320, LDS_BYTES = 147456;

struct Args { const float* in[36]; float* out; unsigned char* ws; int ph_lo, ph_hi; };
#define LBAR() do { asm volatile("s_waitcnt lgkmcnt(0)" ::: "memory"); __builtin_amdgcn_s_barrier(); asm volatile("" ::: "memory"); } while (0)
struct Ctx { float* out; unsigned char* ws; const LAS unsigned long long* tbl; int bid; };
__device__ __forceinline__ const GAS float* inpg(const Ctx& a, int i);
__device__ __forceinline__ const float* inp(const Ctx& a, int i) { const unsigned long long v = a.tbl[i];
    const unsigned lo = __builtin_amdgcn_readfirstlane((unsigned)v), hi = __builtin_amdgcn_readfirstlane((unsigned)(v >> 32)); return (const float*)(((unsigned long long)hi << 32) | lo); }
__device__ __forceinline__ const GAS float* inpg(const Ctx& a, int i) { return (const GAS float*)inp(a, i); }
enum { I_XP = 0, I_XS, I_C, I_CK, I_CV, I_S5RE, I_S5IM, I_MC, I_MN, I_MM, I_CCTX, I_ADAW, I_ADAB, I_N1G, I_N2G, I_WIN, I_QG, I_KG,
       I_ARE, I_AIM, I_LDT, I_BRE, I_BIM, I_CRE, I_CIM, I_S5D, I_GLUW, I_GLUB, I_MGB, I_MNG, I_WOUT, I_WG, I_WU, I_CW, I_CB, I_WD };

__device__ __forceinline__ float bf2f(unsigned short x) { return __uint_as_float(((unsigned)x) << 16); }
__device__ __forceinline__ float wave_sum(float v) {
#pragma unroll
    for (int o = 1; o < 64; o <<= 1) v += __shfl_xor(v, o);
    return v;
}
__device__ __forceinline__ float sigmoidf_(float x) { return 1.0f / (1.0f + __expf(-x)); }
__device__ __forceinline__ int bc_of_row(int r) { return r < NPROMPT ? 0 : 1 + ((r - NPROMPT) >> 10); }

__device__ __forceinline__ void p0_transpose_item(const float* W, int K, int ldn, int k0, int n0, bf16* WT, int drow0, LAS float* scr, int lane) {
    float tv[32];
#pragma unroll
    for (int i = 0; i < 32; ++i) tv[i] = W[(size_t)(k0 + 2 * i + (lane >> 5)) * ldn + n0 + (lane & 31)];
#pragma unroll
    for (int i = 0; i < 32; ++i) scr[(2 * i + (lane >> 5)) * 33 + (lane & 31)] = tv[i];
    LDS_WAIT(); asm volatile("" ::: "memory");
    const int c = lane & 7;
#pragma unroll
    for (int j = 0; j < 4; ++j) { const int n = (lane >> 3) + 8 * j; const LAS float* s = scr + (8 * c) * 33 + n;
        v4u o; o.x = pk2(s[0 * 33], s[1 * 33]); o.y = pk2(s[2 * 33], s[3 * 33]); o.z = pk2(s[4 * 33], s[5 * 33]); o.w = pk2(s[6 * 33], s[7 * 33]);
        *(GAS v4u*)(WT + (size_t)(drow0 + n) * K + k0 + 8 * c) = o; }
    LDS_WAIT(); asm volatile("" ::: "memory");
}

__device__ __forceinline__ void p0_adaln_unit(const Ctx& a, int u, unsigned char* ldsg, int tid, int lane, int wave) {
    const int l = u / 96, n0 = (u % 96) * 64;
    float* sil = (float*)ldsg;
    float* red = sil + 9 * 1024;
    for (int i = tid; i < 9 * 1024; i += 512) { const int bc = i >> 10, k = i & 1023; const float c = (bc == 0) ? inp(a, I_CCTX)[k] : inp(a, I_C)[(bc - 1) * 1024 + k]; sil[i] = c * sigmoidf_(c); }
    __syncthreads();
    const float* W = inp(a, I_ADAW) + (size_t)l * 1024 * 6144 + n0 + lane;
    float acc[9];
#pragma unroll
    for (int bc = 0; bc < 9; ++bc) acc[bc] = 0.f;
    const int k0 = wave * 128;
#pragma unroll 8
    for (int k = k0; k < k0 + 128; ++k) { const float w = W[(size_t)k * 6144];
#pragma unroll
        for (int bc = 0; bc < 9; ++bc) acc[bc] += sil[bc * 1024 + k] * w; }
#pragma unroll
    for (int bc = 0; bc < 9; ++bc) red[(wave * 9 + bc) * 64 + lane] = acc[bc];
    __syncthreads();
    for (int i = tid; i < 9 * 64; i += 512) { const int bc = i >> 6, ln = i & 63; float s = inp(a, I_ADAB)[l * 6144 + n0 + ln];
#pragma unroll
        for (int w = 0; w < 8; ++w) s += red[(w * 9 + bc) * 64 + ln];
        ((float*)(a.ws + WS_MOD))[(size_t)(l * 9 + bc) * 6144 + n0 + ln] = s; }
    __syncthreads();
}

__device__ __forceinline__ void p0_s5_unit(const Ctx& a, int u, unsigned char* ldsg, int tid) {
    const int l = u >> 4, g = u & 15;
    float2* Pw = (float2*)ldsg;
    float2* Bb = Pw + 2 * 17 * 64;
    float2* Cc = Bb + 2 * 64 * 16;
    float* Kt = (float*)(Cc + 2 * 16 * 64);
    if (tid < 128) {
        const int d = tid >> 6, p = tid & 63; const int gi = (l * 2 + d) * 16 + g, idx = gi * 64 + p;
        const float are = inp(a, I_ARE)[idx], aim = inp(a, I_AIM)[idx], dt = expf(inp(a, I_LDT)[gi]);
        for (int t = 0; t <= 16; ++t) { const float mag = expf((float)t * dt * are), ang = (float)t * dt * aim; float sn, cs; sincosf(ang, &sn, &cs); Pw[(d * 17 + t) * 64 + p] = make_float2(mag * cs, mag * sn); }
        const float2 ab = Pw[(d * 17 + 1) * 64 + p], a16 = Pw[(d * 17 + 16) * 64 + p];
        ((float2*)(a.ws + WS_S5A16))[idx] = a16;
        const float nr = ab.x - 1.0f, ni = ab.y, den = are * are + aim * aim;
        const float fre = (nr * are + ni * aim) / den, fim = (ni * are - nr * aim) / den;
        for (int c = 0; c < 16; ++c) { const float bre = inp(a, I_BRE)[(size_t)idx * 16 + c], bim = inp(a, I_BIM)[(size_t)idx * 16 + c];
            Bb[(d * 64 + p) * 16 + c] = make_float2(fre * bre - fim * bim, fre * bim + fim * bre); }
    }
    for (int i = tid; i < 2048; i += 512) { const int d = i >> 10, c = (i >> 6) & 15, p = i & 63; const size_t s = ((size_t)((l * 2 + d) * 16 + g) * 16 + c) * 64 + p;
        Cc[i] = make_float2(inp(a, I_CRE)[s], inp(a, I_CIM)[s]); }
    __syncthreads();
    {
        const int d = tid >> 8, tau = (tid >> 4) & 15, c = tid & 15;
        float acc[16];
#pragma unroll
        for (int j = 0; j < 16; ++j) acc[j] = 0.f;
        for (int p = 0; p < 64; ++p) { const float2 cc = Cc[(d * 16 + c) * 64 + p], pw = Pw[(d * 17 + tau) * 64 + p];
            const float xr = cc.x * pw.x - cc.y * pw.y, xi = cc.x * pw.y + cc.y * pw.x;
#pragma unroll
            for (int j = 0; j < 16; ++j) { const float2 bb = Bb[(d * 64 + p) * 16 + j]; acc[j] += xr * bb.x - xi * bb.y; } }
#pragma unroll
        for (int j = 0; j < 16; ++j) Kt[((d * 16 + tau) * 16 + c) * 16 + j] = acc[j];
    }
    __syncthreads();
    bf16* W1 = (bf16*)(a.ws + WS_S5W1) + (size_t)u * 512 * 256;
    bf16* W2 = (bf16*)(a.ws + WS_S5W2) + (size_t)u * 256 * 256;
    const float* dsk = inp(a, I_S5D) + l * 256 + g * 16;
    for (int e = tid; e < 8192; e += 512) {
        const int row = e >> 5, col0 = (e & 31) * 8, i = row >> 4, c = row & 15, j = col0 >> 4, c2 = col0 & 15;
        float v[8];
#pragma unroll
        for (int x = 0; x < 8; ++x) { float t = 0.f;
            if (i >= j) t += Kt[((0 * 16 + (i - j)) * 16 + c) * 16 + c2 + x];
            if (j >= i) t += Kt[((1 * 16 + (j - i)) * 16 + c) * 16 + c2 + x];
            if (row == col0 + x) t += dsk[c];
            v[x] = t; }
        v4u o; o.x = pk2(v[0], v[1]); o.y = pk2(v[2], v[3]); o.z = pk2(v[4], v[5]); o.w = pk2(v[6], v[7]);
        *(v4u*)(W1 + ((size_t)((row >> 4) * 8 + (col0 >> 5)) * 64 + ((col0 >> 3) & 3) * 16 + (row & 15)) * 8) = o;
    }
    for (int e = tid; e < 8192; e += 512) {
        const int rr = e >> 5, col0 = (e & 31) * 8, d = rr >> 7, im = (rr >> 6) & 1, p = rr & 63, j = col0 >> 4, c2 = col0 & 15;
        const int ex = d == 0 ? 15 - j : j;
        const float2 pw = Pw[(d * 17 + ex) * 64 + p];
        float v[8];
#pragma unroll
        for (int x = 0; x < 8; ++x) { const float2 bb = Bb[(d * 64 + p) * 16 + c2 + x]; v[x] = im ? (pw.x * bb.y + pw.y * bb.x) : (pw.x * bb.x - pw.y * bb.y); }
        v4u o; o.x = pk2(v[0], v[1]); o.y = pk2(v[2], v[3]); o.z = pk2(v[4], v[5]); o.w = pk2(v[6], v[7]);
        *(v4u*)(W1 + ((size_t)(((256 + rr) >> 4) * 8 + (col0 >> 5)) * 64 + ((col0 >> 3) & 3) * 16 + (rr & 15)) * 8) = o;
    }
    for (int e = tid; e < 8192; e += 512) {
        const int row = e >> 5, col0 = (e & 31) * 8, i = row >> 4, c = row & 15, d = col0 >> 7, im = (col0 >> 6) & 1, p0 = col0 & 63;
        const int n = d == 0 ? i + 1 : 16 - i;
        float v[8];
#pragma unroll
        for (int x = 0; x < 8; ++x) { const float2 cc = Cc[(d * 16 + c) * 64 + p0 + x], pw = Pw[(d * 17 + n) * 64 + p0 + x]; v[x] = im ? -(cc.x * pw.y + cc.y * pw.x) : (cc.x * pw.x - cc.y * pw.y); }
        v4u o; o.x = pk2(v[0], v[1]); o.y = pk2(v[2], v[3]); o.z = pk2(v[4], v[5]); o.w = pk2(v[6], v[7]);
        *(v4u*)(W2 + ((size_t)((row >> 4) * 8 + (col0 >> 5)) * 64 + ((col0 >> 3) & 3) * 16 + (row & 15)) * 8) = o;
    }
    __syncthreads();
}

__device__ __forceinline__ void p0_prologue(const Ctx& a, unsigned char* ldsg, int G, int rep, volatile LAS unsigned* MISC, const int tid0) {
    constexpr int IT_IN = 16 * 64, IT_OUT = 16 * 32, IT_G = 16 * 88, IT_D = 44 * 32, IT_GLU = 4 * 8, IT_L = IT_IN + IT_OUT + 2 * IT_G + IT_D + IT_GLU;
    constexpr int U_S5 = 32, U_ADA = 192, U_MISC = 9, U_TR = 2 * IT_L / 8, U_ALL = U_S5 + U_ADA + U_MISC + U_TR;
    gu32* head = (gu32*)(a.ws + WS_CTL) + CW_QUEUE + 64 * (8 + rep);
    for (;;) {
        if (tid0 == 0) MISC[16] = __hip_atomic_fetch_add(head, 1u, RLX_AGENT);
        __syncthreads();
        const int u = (int)MISC[16];
        __syncthreads();
        if (u >= U_ALL) break;
        int tid = tid0; asm volatile("" : "+v"(tid));
        const int lane = tid & 63, wave = __builtin_amdgcn_readfirstlane(tid >> 6);
        if (u < U_S5) { p0_s5_unit(a, u, ldsg, tid); continue; }
        if (u < U_S5 + U_ADA) { p0_adaln_unit(a, u - U_S5, ldsg, tid, lane, wave); continue; }
        if (u < U_S5 + U_ADA + U_MISC) { const int v = u - U_S5 - U_ADA;
            if (v == 0) { float* rp = (float*)(a.ws + WS_ROPE);
                for (int i = tid; i < 1024; i += 512) { const int pos = i >> 4, j = i & 15; const float inv = exp2f(-(float)j * (13.287712379549449f / 16.0f));   float sn, cs; sincosf((float)pos * inv, &sn, &cs); rp[i] = cs; rp[1024 + i] = sn; } }
            else {
                for (int i = (v - 1) * 4096 + tid; i < v * 4096; i += 512) { const int l = i >> 14, j = (i >> 10) & 15, k = i & 1023;
                    ((bf16*)(a.ws + WS_WGT))[i] = (bf16)f2bf(inp(a, I_WIN)[((size_t)l * 1024 + k) * 2064 + 2048 + j]); } }
            continue; }
        {
            LAS float* scr = (LAS float*)((LAS unsigned char*)ldsg + wave * 16384);
            const int it = (u - U_S5 - U_ADA - U_MISC) * 8 + wave;
            const int l = it / IT_L; int r = it % IT_L;
            if (r < IT_IN) { const int kb = r / 64, nb = r % 64, tile = nb >> 3, cb = nb & 7;
                p0_transpose_item(inp(a, I_WIN) + (size_t)l * 1024 * 2064, 1024, 2064, 64 * kb, 32 * nb, (bf16*)(a.ws + WS_WIN) + (size_t)l * 2048 * 1024, 256 * tile + 128 * (cb & 1) + 32 * (cb >> 1), scr, lane); }
            else if ((r -= IT_IN) < IT_OUT) { const int kb = r / 32, nb = r % 32;
                p0_transpose_item(inp(a, I_WOUT) + (size_t)l * 1024 * 1024, 1024, 1024, 64 * kb, 32 * nb, (bf16*)(a.ws + WS_WOUT) + (size_t)l * 1024 * 1024, 32 * nb, scr, lane); }
            else if ((r -= IT_OUT) < IT_G) { const int kb = r / 88, nb = r % 88;
                p0_transpose_item(inp(a, I_WG) + (size_t)l * 1024 * DFF, 1024, DFF, 64 * kb, 32 * nb, (bf16*)(a.ws + WS_WGU) + (size_t)l * NGU * 1024, 256 * (nb >> 2) + 32 * (nb & 3), scr, lane); }
            else if ((r -= IT_G) < IT_G) { const int kb = r / 88, nb = r % 88;
                p0_transpose_item(inp(a, I_WU) + (size_t)l * 1024 * DFF, 1024, DFF, 64 * kb, 32 * nb, (bf16*)(a.ws + WS_WGU) + (size_t)l * NGU * 1024, 256 * (nb >> 2) + 128 + 32 * (nb & 3), scr, lane); }
            else if ((r -= IT_G) < IT_D) { const int kb = r / 32, nb = r % 32;
                p0_transpose_item(inp(a, I_WD) + (size_t)l * DFF * 1024, DFF, 1024, 64 * kb, 32 * nb, (bf16*)(a.ws + WS_WDN) + (size_t)l * 1024 * DFF, 32 * nb, scr, lane); }
            else { r -= IT_D; const int kb = r / 8, nb = r % 8;
                p0_transpose_item(inp(a, I_GLUW) + (size_t)l * 256 * 256, 256, 256, 64 * kb, 32 * nb, (bf16*)(a.ws + WS_GLUT) + (size_t)l * 256 * 256, 32 * nb, scr, lane); }
        }
    }
}

__device__ __forceinline__ void norm_phase(const Ctx& a, int l, int which  , int G, const int tid) {
    const int lane = tid & 63, wave = __builtin_amdgcn_readfirstlane(tid >> 6);
    const int gw = a.bid * NWAVES + wave, NGW = G * NWAVES;
    const float* gvec = inp(a, which ? I_N2G : I_N1G) + l * 1024;
    const float* mod = (const float*)(a.ws + WS_MOD) + (size_t)l * 9 * 6144;
    bf16* H = (bf16*)(a.ws + WS_H);
    f32x4 gv[4];
#pragma unroll
    for (int j = 0; j < 4; ++j) gv[j] = *(const f32x4*)(gvec + 4 * lane + 256 * j);
    for (int m = gw; m < MTOK; m += NGW) {
        const float* xrow = (l == 0 && which == 0) ? (m < NPROMPT ? inp(a, I_XP) + (size_t)m * DM : inp(a, I_XS) + (size_t)(m - NPROMPT) * DM) : a.out + OUT_Y + (size_t)m * DM;
        const float* mb = mod + (size_t)bc_of_row(m) * 6144 + (which ? 3 * 1024 : 0);
        f32x4 v[4]; float s = 0.f;
#pragma unroll
        for (int j = 0; j < 4; ++j) { v[j] = *(const f32x4*)(xrow + 4 * lane + 256 * j); s += (v[j].x * v[j].x + v[j].y * v[j].y) + (v[j].z * v[j].z + v[j].w * v[j].w); }
        const float r = rsqrtf(wave_sum(s) * (1.0f / DM) + EPS);
#pragma unroll
        for (int j = 0; j < 4; ++j) { const f32x4 sh = *(const f32x4*)(mb + 4 * lane + 256 * j), sc = *(const f32x4*)(mb + 1024 + 4 * lane + 256 * j);
            const f32x4 o = v[j] * r * gv[j] * (sc + 1.0f) + sh;
            u32x2 w; w.x = pk2(o.x, o.y); w.y = pk2(o.z, o.w);
            *(u32x2*)(H + (size_t)m * DM + 4 * lane + 256 * j) = w; }
    }
    if (which == 0) {
        bf16* KS = (bf16*)(a.ws + WS_KS); bf16* VS = (bf16*)(a.ws + WS_VS);
        for (int i = a.bid * 512 + tid; i < 2 * 8 * 8192; i += G * 512) {
            const int kv = i >> 16, b = (i >> 13) & 7, e = (i & 8191) * 8;
            const float* src = inp(a, kv ? I_CV : I_CK) + ((size_t)(b * 2 + l) * 512) * 128 + e;
            const f32x4 x0 = *(const f32x4*)src, x1 = *(const f32x4*)(src + 4);
            v4u o; o.x = pk2(x0.x, x0.y); o.y = pk2(x0.z, x0.w); o.z = pk2(x1.x, x1.y); o.w = pk2(x1.z, x1.w);
            *(v4u*)((kv ? VS : KS) + (size_t)b * 1536 * 128 + e) = o;
        }
    }
}

struct EpiG1 {
    static constexpr bool PERM = false, AFTER_DRAIN = false;
    int l; unsigned char* ws; float* out; const float* qg; const float* kg;
    __device__ __forceinline__ void operator()(const pg8::f32x4 (&acc)[2][2][4][2], const pg8::Unit& u, int wr, int wc, int fr, int fq) const {
        const int pn = u.pn; const bool samp = u.pm >= 16;
        const int kind = (pn <= 1) ? 0 : (pn == 2 ? (wc < 2 ? 1 : 2) : 3);
        const float* rope = (const float*)(ws + WS_ROPE);
#pragma unroll
        for (int ai = 0; ai < 2; ++ai)
#pragma unroll
            for (int m = 0; m < 4; ++m) {
                const int r = u.pm * 256 + ai * 128 + wr * 64 + m * 16 + fr;
                f32x4 v[2][2];
#pragma unroll
                for (int bj = 0; bj < 2; ++bj)
#pragma unroll
                    for (int n = 0; n < 2; ++n) v[bj][n] = acc[ai][bj][m][n];
                if (kind <= 1) {
                    float ss = 0.f;
#pragma unroll
                    for (int bj = 0; bj < 2; ++bj)
#pragma unroll
                        for (int n = 0; n < 2; ++n) ss += (v[bj][n].x * v[bj][n].x + v[bj][n].y * v[bj][n].y) + (v[bj][n].z * v[bj][n].z + v[bj][n].w * v[bj][n].w);
                    ss += __shfl_xor(ss, 16); ss += __shfl_xor(ss, 32);
                    const float rinv = rsqrtf(ss * (1.0f / 64.0f) + EPS);
#pragma unroll
                    for (int bj = 0; bj < 2; ++bj)
#pragma unroll
                        for (int n = 0; n < 2; ++n) v[bj][n] = v[bj][n] * rinv * *(const f32x4*)((kind == 0 ? qg : kg) + 32 * bj + 16 * n + 4 * fq);
                }
                if (!samp && (kind == 1 || kind == 2)) {
                    const int b = r >> 8, t = r & 255, kvh = wc & 1;
                    float* dst = out + (kind == 1 ? OUT_K : OUT_V) + ((((size_t)b * 2 + l) * 256 + t) * 2 + kvh) * 64 + 4 * fq;
#pragma unroll
                    for (int bj = 0; bj < 2; ++bj)
#pragma unroll
                        for (int n = 0; n < 2; ++n) *(f32x4*)(dst + 32 * bj + 16 * n) = v[bj][n];
                }
                if (samp && kind <= 1) {
                    const int t = (r - NPROMPT) & 1023;
#pragma unroll
                    for (int bj = 0; bj < 2; ++bj) { const int pos = bj == 0 ? (t >> 6) : (t & 63);
                        const f32x4 cs = *(const f32x4*)(rope + pos * 16 + 4 * fq), sn = *(const f32x4*)(rope + 1024 + pos * 16 + 4 * fq);
                        const f32x4 x1 = v[bj][0], x2 = v[bj][1];
                        v[bj][0] = x1 * cs - x2 * sn; v[bj][1] = x2 * cs + x1 * sn; }
                }
                bf16* dst; float scl = 1.0f;
                const bool sug = (pn == 3);
                if (kind == 0) { dst = (bf16*)(ws + WS_Q) + (size_t)r * 512 + (4 * pn + wc) * 64; scl = QSCALE; }
                else if (kind == 3) { dst = (bf16*)(ws + WS_SU + (size_t)(pn - 3) * (6 * MiB)) + (size_t)r * 256 + wc * 64; if (pn == 5) scl = 0.125f; }
                else { const int kvh = wc & 1;
                    if (!samp) dst = (bf16*)(ws + (kind == 1 ? WS_KP : WS_VP)) + (size_t)r * 128 + kvh * 64;
                    else { const int b = (r - NPROMPT) >> 10, t = (r - NPROMPT) & 1023; dst = (bf16*)(ws + (kind == 1 ? WS_KS : WS_VS)) + ((size_t)b * 1536 + 512 + t) * 128 + kvh * 64; } }
#pragma unroll
                for (int bj = 0; bj < 2; ++bj)
#pragma unroll
                    for (int n = 0; n < 2; ++n) { const f32x4 o = v[bj][n] * scl; u32x2 w; w.x = pk2(o.x, o.y); w.y = pk2(o.z, o.w);
                        bf16* dp = sug ? (bf16*)(ws + WS_SU) + ((size_t)(4 * wc + 2 * bj + n) * MTOK + r) * 16 + 4 * fq : dst + 32 * bj + 16 * n + 4 * fq;
                        *(u32x2*)dp = w; }
                asm volatile("" ::: "memory");
            }
    }
};
struct EpiGlu {
    static constexpr bool PERM = false, AFTER_DRAIN = false;
    const bf16* Z; bf16* MIX; const float* bias;
    __device__ __forceinline__ void operator()(const pg8::f32x4 (&acc)[2][2][4][2], const pg8::Unit& u, int wr, int wc, int fr, int fq) const {
#pragma unroll
        for (int ai = 0; ai < 2; ++ai)
#pragma unroll
            for (int m = 0; m < 4; ++m) { const int r = u.pm * 256 + ai * 128 + wr * 64 + m * 16 + fr;
#pragma unroll
                for (int bj = 0; bj < 2; ++bj)
#pragma unroll
                    for (int n = 0; n < 2; ++n) { const int c = 128 * bj + 32 * wc + 16 * n + 4 * fq;
                        const f32x4 bv = *(const f32x4*)(bias + c); const u32x2 zz = *(const u32x2*)(Z + (size_t)r * 256 + c);
                        const f32x4 s = acc[ai][bj][m][n] + bv;
                        const float z0 = __uint_as_float(zz.x << 16), z1 = __uint_as_float(zz.x & 0xffff0000u), z2 = __uint_as_float(zz.y << 16), z3 = __uint_as_float(zz.y & 0xffff0000u);
                        u32x2 w; w.x = pk2(z0 * sigmoidf_(s.x), z1 * sigmoidf_(s.y)); w.y = pk2(z2 * sigmoidf_(s.z), z3 * sigmoidf_(s.w));
                        *(u32x2*)(MIX + (size_t)r * 1024 + 512 + c) = w; }
                asm volatile("" ::: "memory"); }
    }
};
struct EpiResid {
    static constexpr bool PERM = false, AFTER_DRAIN = false;
    const float* xp; const float* xs; float* xout; const float* gate;
    __device__ __forceinline__ void operator()(const pg8::f32x4 (&acc)[2][2][4][2], const pg8::Unit& u, int wr, int wc, int fr, int fq) const {
        const int bc = u.pm < 16 ? 0 : 1 + ((u.pm - 16) >> 2);
        const float* gp = gate + (size_t)bc * 6144 + u.pn * 256 + wc * 32 + 4 * fq;
        f32x4 gv[2][2];
#pragma unroll
        for (int bj = 0; bj < 2; ++bj)
#pragma unroll
            for (int n = 0; n < 2; ++n) gv[bj][n] = *(const f32x4*)(gp + bj * 128 + n * 16);
#pragma unroll
        for (int ai = 0; ai < 2; ++ai)
#pragma unroll
            for (int m = 0; m < 4; ++m) { const int r = u.pm * 256 + ai * 128 + wr * 64 + m * 16 + fr;
                const float* xi = (r < NPROMPT ? xp + (size_t)r * DM : xs + (size_t)(r - NPROMPT) * DM) + u.pn * 256 + wc * 32 + 4 * fq;
                float* xo = xout + (size_t)r * DM + u.pn * 256 + wc * 32 + 4 * fq;
#pragma unroll
                for (int bj = 0; bj < 2; ++bj)
#pragma unroll
                    for (int n = 0; n < 2; ++n) { const f32x4 b = *(const f32x4*)(xi + bj * 128 + n * 16); *(f32x4*)(xo + bj * 128 + n * 16) = b + gv[bj][n] * acc[ai][bj][m][n]; }
                if (m & 1) asm volatile("" ::: "memory"); }
    }
};


__device__ __forceinline__ float dpp_ror1(float x) { return __builtin_bit_cast(float, __builtin_amdgcn_update_dpp(0, __builtin_bit_cast(int, x), 0x121, 0xf, 0xf, false)); }
__device__ __forceinline__ float dpp_ror15(float x) { return __builtin_bit_cast(float, __builtin_amdgcn_update_dpp(0, __builtin_bit_cast(int, x), 0x12f, 0xf, 0xf, false)); }
__device__ __forceinline__ f32x4 ror1v(f32x4 v) { return (f32x4){dpp_ror1(v.x), dpp_ror1(v.y), dpp_ror1(v.z), dpp_ror1(v.w)}; }
__device__ __forceinline__ f32x4 ror15v(f32x4 v) { return (f32x4){dpp_ror15(v.x), dpp_ror15(v.y), dpp_ror15(v.z), dpp_ror15(v.w)}; }
__device__ __forceinline__ f32x4 siluv(f32x4 c) { return (f32x4){c.x * sigmoidf_(c.x), c.y * sigmoidf_(c.y), c.z * sigmoidf_(c.z), c.w * sigmoidf_(c.w)}; }
constexpr int XR_OFF = 133120;
struct StripOrder {
    int G, c;
    __device__ __forceinline__ bool next(int i, pg8::Unit& u) const {
        if (G == 256) {
            if (c < 176) { if (i < 4) { u.pm = 16 + 4 * (c / 22) + i; u.pn = c % 22; return true; } if (i == 4) { u.pm = c / 22; u.pn = c % 22; return true; } return false; }
            const int s = 176 + (c - 176) + 80 * i; if (i < 3 && s < 352) { u.pm = s / 22; u.pn = s % 22; return true; } return false;
        }
        int rem = i;
        for (int j = c; j < 528; j += G) { const int cnt = j < 176 ? 4 : 1;
            if (rem < cnt) { if (j < 176) { u.pm = 16 + 4 * (j / 22) + rem; u.pn = j % 22; } else { u.pm = (j - 176) / 22; u.pn = (j - 176) % 22; } return true; }
            rem -= cnt; }
        return false;
    }
    __device__ __forceinline__ void a_ready(const pg8::Unit&) const {}
    __device__ __forceinline__ void done(const pg8::Unit&) const {}
};
struct EpiG3 {
    static constexpr bool PERM = true, AFTER_DRAIN = false;
    bf16* HID; const float* cw; const float* cb; LAS float* XR;
    __device__ __forceinline__ void operator()(const pg8::f32x4 (&acc)[2][2][4][2], const pg8::Unit& u, int wr, int wc, int fr, int fq) const {
        const int pm = u.pm, pn = u.pn; const bool samp = pm >= 16; const int qtr = samp ? ((pm - 16) & 3) : 0;
        const bool first = !samp || qtr == 0, last = !samp || qtr == 3;
        LAS float* XF = XR; LAS float* XL = XR + 512; LAS float* CY = XR + 1024 + (qtr & 1) * 384; LAS float* CP = XR + 1024 + ((qtr & 1) ^ 1) * 384;
        const int fl = 32 * wc + 8 * fq;
#pragma unroll
        for (int ai = 0; ai < 2; ++ai) { const int q = 2 * ai + wr;
            if (fr == 0) {
#pragma unroll
                for (int n = 0; n < 2; ++n) *(LAS f32x4*)(XF + q * 128 + fl + 4 * n) = acc[ai][0][0][n]; }
            if (fr == 15) {
#pragma unroll
                for (int n = 0; n < 2; ++n) *(LAS f32x4*)(XL + q * 128 + fl + 4 * n) = acc[ai][0][3][n]; } }
        asm volatile("s_waitcnt lgkmcnt(0)" ::: "memory"); __builtin_amdgcn_s_barrier(); asm volatile("" ::: "memory");
        f32x4 w0[2], w1[2], w2[2], bb[2];
#pragma unroll
        for (int n = 0; n < 2; ++n) { const int f = 128 * pn + fl + 4 * n; w0[n] = *(const f32x4*)(cw + f); w1[n] = *(const f32x4*)(cw + DFF + f); w2[n] = *(const f32x4*)(cw + 2 * DFF + f); bb[n] = *(const f32x4*)(cb + f); }
        const f32x4 zero4 = {0.f, 0.f, 0.f, 0.f};
#pragma unroll
        for (int ai = 0; ai < 2; ++ai) { const int q = 2 * ai + wr;
#pragma unroll
            for (int m = 0; m < 4; ++m) {
                const int r = pm * 256 + ai * 128 + wr * 64 + m * 16 + fr;
                f32x4 hv[2]; bool defer = false;
#pragma unroll
                for (int n = 0; n < 2; ++n) {
                    const f32x4 cur = acc[ai][0][m][n];
                    f32x4 up = ror1v(cur), dn = ror15v(cur);
                    if (m > 0) { const f32x4 t = ror1v(acc[ai][0][m > 0 ? m - 1 : 0][n]); if (fr == 0) up = t; }
                    else if (fr == 0) { up = (q > 0) ? *(const LAS f32x4*)(XL + (q - 1) * 128 + fl + 4 * n) : (first ? zero4 : *(const LAS f32x4*)(CP + fl + 4 * n)); }
                    if (m < 3) { const f32x4 t = ror15v(acc[ai][0][m < 3 ? m + 1 : 3][n]); if (fr == 15) dn = t; }
                    else if (fr == 15) { dn = (q < 3) ? *(const LAS f32x4*)(XF + (q + 1) * 128 + fl + 4 * n) : zero4; }
                    const f32x4 cpart = w0[n] * up + w1[n] * cur + bb[n];
                    const f32x4 uu = acc[ai][1][m][n];
                    hv[n] = siluv(cpart + w2[n] * dn) * uu;
                    if (m == 3 && q == 3 && !last && fr == 15) { defer = true;
                        *(LAS f32x4*)(CY + fl + 4 * n) = cur; *(LAS f32x4*)(CY + 128 + fl + 4 * n) = cpart; *(LAS f32x4*)(CY + 256 + fl + 4 * n) = uu; }
                    if (m == 0 && q == 0 && !first && fr == 0) {
                        const f32x4 pc = *(const LAS f32x4*)(CP + 128 + fl + 4 * n), pu = *(const LAS f32x4*)(CP + 256 + fl + 4 * n);
                        const f32x4 ph = siluv(pc + w2[n] * cur) * pu; u32x2 w; w.x = pk2(ph.x, ph.y); w.y = pk2(ph.z, ph.w);
                        *(u32x2*)(HID + (size_t)(pm * 256 - 1) * DFF + 128 * pn + fl + 4 * n) = w; }
                }
                if (!defer) { v4u w; w.x = pk2(hv[0].x, hv[0].y); w.y = pk2(hv[0].z, hv[0].w); w.z = pk2(hv[1].x, hv[1].y); w.w = pk2(hv[1].z, hv[1].w);
                    *(v4u*)(HID + (size_t)r * DFF + 128 * pn + fl) = w; }
            } }
    }
};
__device__ __forceinline__ void gates_phase(const Ctx& a, int l, int G, const int tid) {
    const int lane = tid & 63, wave = __builtin_amdgcn_readfirstlane(tid >> 6);
    const int gw = a.bid * NWAVES + wave, NGW = G * NWAVES;
    const bf16* H = (const bf16*)(a.ws + WS_H); const bf16* WG = (const bf16*)(a.ws + WS_WGT) + (size_t)l * 16 * 1024;
    float* GT = (float*)(a.ws + WS_GATES);
    const int j = lane & 15; const float bias = inp(a, I_MGB)[l * 16 + j];
    for (int uu = gw; uu < MTOK / 16; uu += NGW) {
        const int r0 = uu * 16;
        const bf16* Ap = H + (size_t)(r0 + (lane & 15)) * DM + 8 * (lane >> 4);
        const bf16* Bp = WG + (size_t)(lane & 15) * DM + 8 * (lane >> 4);
        f32x4 acc = {0.f, 0.f, 0.f, 0.f};
#pragma unroll 8
        for (int ks = 0; ks < 32; ++ks) { const bf16x8 av = *(const bf16x8*)(Ap + ks * 32), bv = *(const bf16x8*)(Bp + ks * 32); acc = __builtin_amdgcn_mfma_f32_16x16x32_bf16(av, bv, acc, 0, 0, 0); }
#pragma unroll
        for (int rg = 0; rg < 4; ++rg) { float v = acc[rg] + bias; if (j >= 8) v = fminf(v, 0.f) - __logf(1.0f + __expf(-fabsf(v)));
            GT[(size_t)(r0 + 4 * (lane >> 4) + rg) * 16 + j] = v; }
    }
}

__device__ __forceinline__ void s5_unit(const Ctx& a, int l, int g, int sq, LAS unsigned char* ldsg, const int tid) {
    const int lane = tid & 63, wave = __builtin_amdgcn_readfirstlane(tid >> 6);
    const bool samp = sq < 8; const int row0 = samp ? NPROMPT + sq * 1024 : (sq - 8) * 1024;
    const GAS bf16* W1 = (const GAS bf16*)(a.ws + WS_S5W1) + (size_t)(l * 16 + g) * 512 * 256;
    const GAS bf16* W2 = (const GAS bf16*)(a.ws + WS_S5W2) + (size_t)(l * 16 + g) * 256 * 256;
    LAS unsigned char* Ul = ldsg;
    LAS bf16* Sin = (LAS bf16*)ldsg;
    LAS float* dS = (LAS float*)(ldsg + 34816);
    const int lr = lane & 15, lq = lane >> 4;
    {
        const GAS v4u* src = (const GAS v4u*)((const GAS bf16*)(a.ws + WS_SU) + ((size_t)g * MTOK + row0) * 16);
#pragma unroll
        for (int j = 0; j < 4; ++j) { const int i = tid + 512 * j, tok = i >> 1; *(LAS v4u*)(Ul + (tok >> 4) * 528 + (tok & 15) * 32 + (i & 1) * 16) = src[i]; }
    }
    bf16x8 af[2][8];
#pragma unroll
    for (int i = 0; i < 2; ++i)
#pragma unroll
        for (int ks = 0; ks < 8; ++ks) af[i][ks] = *(const GAS bf16x8*)(W1 + ((size_t)((16 + 2 * wave + i) * 8 + ks) * 64 + lane) * 8);
    LBAR();
    f32x4 acc[2][4];
#pragma unroll
    for (int i = 0; i < 2; ++i)
#pragma unroll
        for (int cb = 0; cb < 4; ++cb) acc[i][cb] = (f32x4){0.f, 0.f, 0.f, 0.f};
#pragma unroll
    for (int ks = 0; ks < 8; ++ks) {
        bf16x8 bfr[4];
#pragma unroll
        for (int cb = 0; cb < 4; ++cb) bfr[cb] = *(const LAS bf16x8*)(Ul + (cb * 16 + lr) * 528 + (2 * ks + (lq >> 1)) * 32 + (lq & 1) * 16);
#pragma unroll
        for (int i = 0; i < 2; ++i)
#pragma unroll
            for (int cb = 0; cb < 4; ++cb) acc[i][cb] = __builtin_amdgcn_mfma_f32_16x16x32_bf16(af[i][ks], bfr[cb], acc[i][cb], 0, 0, 0);
    }
#pragma unroll
    for (int i = 0; i < 2; ++i)
#pragma unroll
        for (int ks = 0; ks < 8; ++ks) af[i][ks] = *(const GAS bf16x8*)(W1 + ((size_t)((2 * wave + i) * 8 + ks) * 64 + lane) * 8);
#pragma unroll
    for (int i = 0; i < 2; ++i)
#pragma unroll
        for (int cb = 0; cb < 4; ++cb)
#pragma unroll
            for (int rg = 0; rg < 4; ++rg) dS[((2 * wave + i) * 16 + 4 * lq + rg) * 65 + cb * 16 + lr] = acc[i][cb][rg];
#pragma unroll
    for (int i = 0; i < 2; ++i)
#pragma unroll
        for (int cb = 0; cb < 4; ++cb) acc[i][cb] = (f32x4){0.f, 0.f, 0.f, 0.f};
#pragma unroll
    for (int ks = 0; ks < 8; ++ks) {
        bf16x8 bfr[4];
#pragma unroll
        for (int cb = 0; cb < 4; ++cb) bfr[cb] = *(const LAS bf16x8*)(Ul + (cb * 16 + lr) * 528 + (2 * ks + (lq >> 1)) * 32 + (lq & 1) * 16);
#pragma unroll
        for (int i = 0; i < 2; ++i)
#pragma unroll
            for (int cb = 0; cb < 4; ++cb) acc[i][cb] = __builtin_amdgcn_mfma_f32_16x16x32_bf16(af[i][ks], bfr[cb], acc[i][cb], 0, 0, 0);
    }
#pragma unroll
    for (int i = 0; i < 2; ++i)
#pragma unroll
        for (int ks = 0; ks < 8; ++ks) af[i][ks] = *(const GAS bf16x8*)(W2 + ((size_t)((2 * wave + i) * 8 + ks) * 64 + lane) * 8);
    LBAR();
    {
        const int nthr = samp ? 128 : 512, len = samp ? 64 : 16;
        if (tid < nthr) {
            const int sg = tid >> 7, d = (tid >> 6) & 1, p = tid & 63; const int gi = (l * 2 + d) * 16 + g, c0 = sg * len;
            typedef float f32x2e __attribute__((ext_vector_type(2))); const f32x2e a16 = ((const GAS f32x2e*)(a.ws + WS_S5A16))[gi * 64 + p];
            float sr = 0.f, si = 0.f;
            if (samp) { const size_t ix = ((size_t)((sq * 2 + l) * 2 + d) * 16 + g) * 64 + p; sr = inp(a, I_S5RE)[ix]; si = inp(a, I_S5IM)[ix]; }
            const LAS float* dre = dS + (128 * d + p) * 65; const LAS float* dim = dS + (128 * d + 64 + p) * 65;
            for (int k8 = 0; k8 < len; k8 += 8) {
                float xr[8], xi[8];
#pragma unroll
                for (int j = 0; j < 8; ++j) { const int k = c0 + (d == 0 ? k8 + j : len - 1 - k8 - j); xr[j] = dre[k]; xi[j] = dim[k]; }
#pragma unroll
                for (int j = 0; j < 8; ++j) { const int k = c0 + (d == 0 ? k8 + j : len - 1 - k8 - j);
                    Sin[k * 264 + 128 * d + p] = (bf16)f2bf(sr); Sin[k * 264 + 128 * d + 64 + p] = (bf16)f2bf(si);
                    const float nr = a16.x * sr - a16.y * si + xr[j], ni = a16.x * si + a16.y * sr + xi[j]; sr = nr; si = ni; }
            }
            if (!samp) { const size_t ox = ((size_t)(((4 * (sq - 8) + sg) * 2 + l) * 2 + d) * 16 + g) * 64 + p; a.out[OUT_S5RE + ox] = sr; a.out[OUT_S5IM + ox] = si; }
        }
    }
    LBAR();
#pragma unroll
    for (int ks = 0; ks < 8; ++ks) {
        bf16x8 bfr[4];
#pragma unroll
        for (int cb = 0; cb < 4; ++cb) bfr[cb] = *(const LAS bf16x8*)(Sin + (cb * 16 + lr) * 264 + ks * 32 + 8 * lq);
#pragma unroll
        for (int i = 0; i < 2; ++i)
#pragma unroll
            for (int cb = 0; cb < 4; ++cb) acc[i][cb] = __builtin_amdgcn_mfma_f32_16x16x32_bf16(af[i][ks], bfr[cb], acc[i][cb], 0, 0, 0);
    }
    GAS float* Y5 = (GAS float*)(a.ws + WS_Y5);
#pragma unroll
    for (int i = 0; i < 2; ++i)
#pragma unroll
        for (int cb = 0; cb < 4; ++cb) { const int tok = (cb * 16 + lr) * 16 + (2 * wave + i);
            *(GAS f32x4*)(Y5 + (size_t)(row0 + tok) * 256 + g * 16 + 4 * lq) = acc[i][cb]; }
    LBAR();
}

__device__ __forceinline__ void mlstm_unit(const Ctx& a, int l, int s, int h, int dir, LAS unsigned char* ldsg, const int tid, const int rep = 0) {
    const int lane = tid & 63, wave = __builtin_amdgcn_readfirstlane(tid >> 6);
    const bool samp = s >= 16; const int L = samp ? 1024 : 256; int nck = L / 64; const int row0 = samp ? NPROMPT + (s - 16) * 1024 : s * 256;
    if (rep && nck > PROBE_MLCH) nck = PROBE_MLCH;
    constexpr int P = 72;
    constexpr int STG = (64 + 64 + 80) * P;
    LAS bf16* ST = (LAS bf16*)ldsg;
    LAS bf16* KT = ST + 2 * STG;
    LAS bf16* SC = KT + 64 * P;
    LAS bf16* Cb = SC + 64 * P;
    LAS float* GA = (LAS float*)(Cb + 80 * P);
    LAS float* GC = GA + 1024;
    LAS float* GBv = GC + 1024;
    LAS float* GS = GBv + 1024;
    LAS float* denv = GS + 32;
    const GAS bf16* MQ = (const GAS bf16*)(a.ws + WS_MQ), *MKb = (const GAS bf16*)(a.ws + WS_MK), *MVb = (const GAS bf16*)(a.ws + WS_MV);
    const GAS float* GT = (const GAS float*)(a.ws + WS_GATES);
    GAS float* HO = (GAS float*)(a.ws + (rep ? (dir ? 232 * MiB : 220 * MiB) : (dir ? WS_HB : WS_HF)));
    const int lr = lane & 15, lq = lane >> 4;
    const int pos = tid & 63, seg = tid >> 6;
    f32x4 accC[3];
    float mrun = 0.f;
#pragma unroll
    for (int i = 0; i < 3; ++i) { accC[i] = (f32x4){0.f, 0.f, 0.f, 0.f};
        const int j = wave + 8 * i;
        if (samp && j < 20) { const int db = j >> 2, eb = j & 3; const size_t sb = (size_t)((((s - 16) * 2 + l) * 2 + dir) * 4 + h);
            if (db < 4) {
#pragma unroll
                for (int rg = 0; rg < 4; ++rg) accC[i][rg] = inpg(a, I_MC)[(sb * 64 + db * 16 + 4 * lq + rg) * 64 + eb * 16 + lr];
            } else if (lq == 0) accC[i][0] = inpg(a, I_MN)[sb * 64 + eb * 16 + lr]; }
    }
    if (samp) mrun = inpg(a, I_MM)[(((s - 16) * 2 + l) * 2 + dir) * 4 + h];
    for (int i = tid; i < 2 * 16 * 64; i += 512) { const int st = i >> 10, d = 64 + ((i >> 6) & 15), sidx = i & 63; ST[st * STG + (128 + d) * P + sidx] = (d == 64) ? (bf16)0x3f80 : (bf16)0; }
    for (int ck = wave; ck < nck; ck += 8) {
        const int tk = dir ? L - 1 - (64 * ck + lane) : 64 * ck + lane;
        const float li = GT[(size_t)(row0 + tk) * 16 + dir * 4 + h], lf = GT[(size_t)(row0 + tk) * 16 + 8 + dir * 4 + h];
        float b = lf;
#pragma unroll
        for (int o = 1; o < 64; o <<= 1) { const float t = __shfl_up(b, o); if (lane >= o) b += t; }
        const float aa = li - b; float cm = aa;
#pragma unroll
        for (int o = 1; o < 64; o <<= 1) { const float t = __shfl_up(cm, o); if (lane >= o) cm = fmaxf(cm, t); }
        GA[ck * 64 + lane] = aa; GC[ck * 64 + lane] = cm; GBv[ck * 64 + lane] = b;
        if (lane == 63) { GS[2 * ck] = b; GS[2 * ck + 1] = cm; }
    }
    v4u qv, kv, vv;
#define ML_LOAD(ck_) do { const int tok_ = dir ? L - 1 - (64 * (ck_) + pos) : 64 * (ck_) + pos; const size_t go_ = (size_t)(row0 + tok_) * 256 + h * 64 + seg * 8; \
        qv = *(const GAS v4u*)(MQ + go_); kv = *(const GAS v4u*)(MKb + go_); vv = *(const GAS v4u*)(MVb + go_); } while (0)
#define ML_STAGE(st_) do { LAS bf16* Qs_ = ST + (st_) * STG; LAS bf16* Ks_ = Qs_ + 64 * P; LAS bf16* VT_ = Ks_ + 64 * P; \
        *(LAS v4u*)(Qs_ + pos * P + seg * 8) = qv; *(LAS v4u*)(Ks_ + pos * P + seg * 8) = kv; \
        const unsigned vw_[4] = {vv.x, vv.y, vv.z, vv.w}; \
        _Pragma("unroll") for (int e = 0; e < 4; ++e) { VT_[(seg * 8 + 2 * e) * P + pos] = (bf16)(vw_[e] & 0xffffu); VT_[(seg * 8 + 2 * e + 1) * P + pos] = (bf16)(vw_[e] >> 16); } } while (0)
    ML_LOAD(0); ML_STAGE(0);
    if (nck > 1) ML_LOAD(1);
    f32x4 nacc[3];
#pragma unroll
    for (int i = 0; i < 3; ++i) nacc[i] = (f32x4){0.f, 0.f, 0.f, 0.f};
    float mprev = mrun;
    LBAR();
    for (int ck = 0; ck <= nck; ++ck) {
        const int cur = ck & 1;
        LAS bf16* Qs = ST + cur * STG; LAS bf16* Ks = Qs + 64 * P; LAS bf16* VT = Ks + 64 * P;
        if (ck > 0) {
            const LAS float* gc = GC + (ck - 1) * 64; const LAS float* gbv = GBv + (ck - 1) * 64;
#pragma unroll
            for (int i = 0; i < 3; ++i) { const int j = wave + 8 * i;
                if (j < 20) { const int tb = j / 5, db = j % 5;
                    if (db < 4) {
#pragma unroll
                        for (int rg = 0; rg < 4; ++rg) { const int t = tb * 16 + 4 * lq + rg; const int tok = dir ? L - 1 - (64 * (ck - 1) + t) : 64 * (ck - 1) + t;
                            const float emn = __expf(-(gbv[t] + fmaxf(mprev, gc[t])));
                            HO[(size_t)(row0 + tok) * 256 + h * 64 + db * 16 + lr] = nacc[i][rg] * __builtin_amdgcn_rcpf(fmaxf(fabsf(denv[t]), emn)); } } } }
        }
#pragma unroll
        for (int i = 0; i < 3; ++i) { const int j = wave + 8 * i; if (j < 20) { const int db = j >> 2, eb = j & 3;
#pragma unroll
            for (int rg = 0; rg < 4; ++rg) Cb[(db * 16 + 4 * lq + rg) * P + eb * 16 + lr] = (bf16)f2bf(accC[i][rg]); } }
        if (ck == nck) break;
        const LAS float* ga = GA + ck * 64; const LAS float* gcc = GC + ck * 64;
        const float Mn = fmaxf(mrun, GS[2 * ck + 1]);
        {
            const float wk = __expf(ga[pos] - Mn);
            const v4u kk = *(const LAS v4u*)(Ks + pos * P + seg * 8); const unsigned kw[4] = {kk.x, kk.y, kk.z, kk.w};
#pragma unroll
            for (int e = 0; e < 4; ++e) { KT[(seg * 8 + 2 * e) * P + pos] = (bf16)f2bf(wk * __uint_as_float(kw[e] << 16)); KT[(seg * 8 + 2 * e + 1) * P + pos] = (bf16)f2bf(wk * __uint_as_float(kw[e] & 0xffff0000u)); }
        }
        {
            const int tb = wave >> 1;
#pragma unroll
            for (int i = 0; i < 2; ++i) { const int sb = 2 * (wave & 1) + i; f32x4 sacc = {0.f, 0.f, 0.f, 0.f};
#pragma unroll
                for (int ks = 0; ks < 2; ++ks) { const bf16x8 qa = *(const LAS bf16x8*)(Qs + (tb * 16 + lr) * P + ks * 32 + 8 * lq), kb = *(const LAS bf16x8*)(Ks + (sb * 16 + lr) * P + ks * 32 + 8 * lq);
                    sacc = __builtin_amdgcn_mfma_f32_16x16x32_bf16(qa, kb, sacc, 0, 0, 0); }
                const int sidx = sb * 16 + lr; const float as = ga[sidx];
#pragma unroll
                for (int rg = 0; rg < 4; ++rg) { const int t = tb * 16 + 4 * lq + rg; const float w = __expf((sidx <= t) ? as - fmaxf(mrun, gcc[t]) : -1e30f); SC[t * P + sidx] = (bf16)f2bf(sacc[rg] * w); } }
        }
        LBAR();
        const float decay = __expf(mrun - Mn);
#pragma unroll
        for (int i = 0; i < 3; ++i) { nacc[i] = (f32x4){0.f, 0.f, 0.f, 0.f}; const int j = wave + 8 * i;
            if (j < 20) { const int tb = j / 5, db = j % 5;
#pragma unroll
                for (int ks = 0; ks < 2; ++ks) { const bf16x8 qa = *(const LAS bf16x8*)(Qs + (tb * 16 + lr) * P + ks * 32 + 8 * lq), cbv = *(const LAS bf16x8*)(Cb + (db * 16 + lr) * P + ks * 32 + 8 * lq);
                    nacc[i] = __builtin_amdgcn_mfma_f32_16x16x32_bf16(qa, cbv, nacc[i], 0, 0, 0); }
#pragma unroll
                for (int rg = 0; rg < 4; ++rg) nacc[i][rg] *= __expf(mrun - fmaxf(mrun, gcc[tb * 16 + 4 * lq + rg]));
#pragma unroll
                for (int ks = 0; ks < 2; ++ks) { const bf16x8 sa = *(const LAS bf16x8*)(SC + (tb * 16 + lr) * P + ks * 32 + 8 * lq), vb = *(const LAS bf16x8*)(VT + (db * 16 + lr) * P + ks * 32 + 8 * lq);
                    nacc[i] = __builtin_amdgcn_mfma_f32_16x16x32_bf16(sa, vb, nacc[i], 0, 0, 0); }
                if (db == 4 && lr == 0) {
#pragma unroll
                    for (int rg = 0; rg < 4; ++rg) denv[tb * 16 + 4 * lq + rg] = nacc[i][rg]; } } }
#pragma unroll
        for (int i = 0; i < 3; ++i) { const int j = wave + 8 * i;
            if (j < 20) { const int db = j >> 2, eb = j & 3;
#pragma unroll
                for (int rg = 0; rg < 4; ++rg) accC[i][rg] *= decay;
#pragma unroll
                for (int ks = 0; ks < 2; ++ks) { const bf16x8 va = *(const LAS bf16x8*)(VT + (db * 16 + lr) * P + ks * 32 + 8 * lq), kb = *(const LAS bf16x8*)(KT + (eb * 16 + lr) * P + ks * 32 + 8 * lq);
                    accC[i] = __builtin_amdgcn_mfma_f32_16x16x32_bf16(va, kb, accC[i], 0, 0, 0); } } }
        if (ck + 1 < nck) ML_STAGE(cur ^ 1);
        if (ck + 2 < nck) ML_LOAD(ck + 2);
        mprev = mrun; mrun = GS[2 * ck] + Mn;
        LBAR();
    }
#undef ML_LOAD
#undef ML_STAGE
    if (!samp && !rep) {
        const size_t sb = (size_t)(((s * 2 + l) * 2 + dir) * 4 + h);
#pragma unroll
        for (int i = 0; i < 3; ++i) { const int j = wave + 8 * i;
            if (j < 20) { const int db = j >> 2, eb = j & 3;
                if (db < 4) {
#pragma unroll
                    for (int rg = 0; rg < 4; ++rg) a.out[OUT_MC + (sb * 64 + db * 16 + 4 * lq + rg) * 64 + eb * 16 + lr] = accC[i][rg];
                } else if (lq == 0) a.out[OUT_MN + sb * 64 + eb * 16 + lr] = accC[i][0]; } }
        if (tid == 0) a.out[OUT_MM + sb] = mrun;
    }
    LBAR();
}

__device__ __forceinline__ void mix_phase(const Ctx& a, int l, int rep, unsigned char* ldsg, volatile LAS unsigned* MISC, const int tid0) {
    LAS unsigned char* ldsl = (LAS unsigned char*)ldsg;
    gu32* head = (gu32*)(a.ws + WS_CTL) + CW_QUEUE + 64 * (l + 2 * rep);
    const bf16* Q = (const bf16*)(a.ws + WS_Q); bf16* MIX = (bf16*)(a.ws + WS_MIX);
    for (;;) {
        if (tid0 == 0) MISC[16] = __hip_atomic_fetch_add(head, 1u, RLX_AGENT);
        LBAR();
        const int u = (int)MISC[16];
        LBAR();
        if (u >= 768) break;
        int tid = tid0; asm volatile("" : "+v"(tid));
        const int sel = rep ? PROBE_MIXSEL : 7;
        if (!((sel >> (u < 64 || (u >= 448 && u < 576) ? 0 : ((u >= 64 && u < 320) || (u >= 576 && u < 704)) ? 1 : 2)) & 1)) continue;
        if (u < 64) { if (ENB(11)) mlstm_unit(a, l, 16 + (u >> 3), (u >> 1) & 3, u & 1, ldsl, tid, rep); }
        else if (u < 320) { if (ENB(12)) { const int v = u - 64, b = v >> 5, hq = (v >> 2) & 7, qb = v & 3; const int r0 = NPROMPT + b * 1024 + qb * 256;
            attn_body::attn_unit<8>((const attn_body::bf16*)(Q + (size_t)r0 * 512 + hq * 64), 512, (const attn_body::bf16*)((const bf16*)(a.ws + WS_KS) + (size_t)b * 1536 * 128 + (hq >> 2) * 64),
                                    (const attn_body::bf16*)((const bf16*)(a.ws + WS_VS) + (size_t)b * 1536 * 128 + (hq >> 2) * 64), 128, (attn_body::bf16*)(MIX + (size_t)r0 * 1024 + hq * 64), 1024, 24, (char*)ldsg, tid); } }
        else if (u < 448) { const int v = u - 320; if (ENB(13)) s5_unit(a, l, v & 15, v >> 4, ldsl, tid); }
        else if (u < 576) { const int v = u - 448; if (ENB(11)) mlstm_unit(a, l, v >> 3, (v >> 1) & 3, v & 1, ldsl, tid, rep); }
        else if (u < 704) { if (ENB(12)) { const int v = u - 576, b = v >> 3, hq = v & 7; const int r0 = b * 256;
            attn_body::attn_unit<8>((const attn_body::bf16*)(Q + (size_t)r0 * 512 + hq * 64), 512, (const attn_body::bf16*)((const bf16*)(a.ws + WS_KP) + (size_t)r0 * 128 + (hq >> 2) * 64),
                                    (const attn_body::bf16*)((const bf16*)(a.ws + WS_VP) + (size_t)r0 * 128 + (hq >> 2) * 64), 128, (attn_body::bf16*)(MIX + (size_t)r0 * 1024 + hq * 64), 1024, 4, (char*)ldsg, tid); } }
        else { const int v = u - 704; if (ENB(13)) s5_unit(a, l, v & 15, 8 + (v >> 4), ldsl, tid); }
    }
}

__device__ __forceinline__ float gelu_tanh(float x) { const float t = 0.7978845608028654f * (x + 0.044715f * x * x * x); return x * sigmoidf_(2.0f * t); }
__device__ __forceinline__ void fg_phase(const Ctx& a, int l, int G, LAS unsigned char* ldsl, const int tid) {
    const int lane = tid & 63, wave = __builtin_amdgcn_readfirstlane(tid >> 6), lr = lane & 15, lq = lane >> 4;
    const GAS float* Y5 = (const GAS float*)(a.ws + WS_Y5); const GAS float* HF = (const GAS float*)(a.ws + WS_HF); const GAS float* HB = (const GAS float*)(a.ws + WS_HB);
    const GAS bf16* MO = (const GAS bf16*)(a.ws + WS_MO); GAS bf16* MIX = (GAS bf16*)(a.ws + WS_MIX);
    const GAS bf16* GLUT = (const GAS bf16*)(a.ws + WS_GLUT) + (size_t)l * 256 * 256;
    LAS bf16* Zs = (LAS bf16*)ldsl;
    for (int u = a.bid; u < MTOK / 64; u += G) {
        const int r0 = u * 64;
        bf16x8 wf[2][8];
#pragma unroll
        for (int cb = 0; cb < 2; ++cb)
#pragma unroll
            for (int ks = 0; ks < 8; ++ks) wf[cb][ks] = *(const GAS bf16x8*)(GLUT + (size_t)(32 * wave + 16 * cb + lr) * 256 + ks * 32 + 8 * lq);
#pragma unroll
        for (int j = 0; j < 8; ++j) { const int t = wave * 8 + j; const size_t m = (size_t)(r0 + t);
            const f32x4 y = *(const GAS f32x4*)(Y5 + m * 256 + 4 * lane);
            u32x2 zw; zw.x = pk2(gelu_tanh(y.x), gelu_tanh(y.y)); zw.y = pk2(gelu_tanh(y.z), gelu_tanh(y.w));
            *(LAS u32x2*)(Zs + t * 264 + 4 * lane) = zw;
            const f32x4 hv = *(const GAS f32x4*)(HF + m * 256 + 4 * lane) + *(const GAS f32x4*)(HB + m * 256 + 4 * lane);
            float ss = (hv.x * hv.x + hv.y * hv.y) + (hv.z * hv.z + hv.w * hv.w);
            ss += __shfl_xor(ss, 1); ss += __shfl_xor(ss, 2); ss += __shfl_xor(ss, 4); ss += __shfl_xor(ss, 8);
            const float r = rsqrtf(ss * (1.0f / 64.0f) + EPS);
            const f32x4 ng = *(const GAS f32x4*)(inpg(a, I_MNG) + l * 64 + 4 * (lane & 15));
            const u32x2 mo = *(const GAS u32x2*)(MO + m * 256 + 4 * lane);
            const float o0 = __uint_as_float(mo.x << 16), o1 = __uint_as_float(mo.x & 0xffff0000u), o2 = __uint_as_float(mo.y << 16), o3 = __uint_as_float(mo.y & 0xffff0000u);
            u32x2 w; w.x = pk2(hv.x * r * ng.x * sigmoidf_(o0), hv.y * r * ng.y * sigmoidf_(o1)); w.y = pk2(hv.z * r * ng.z * sigmoidf_(o2), hv.w * r * ng.w * sigmoidf_(o3));
            *(GAS u32x2*)(MIX + m * 1024 + 768 + 4 * lane) = w; }
        LBAR();
        f32x4 acc[2][4];
#pragma unroll
        for (int cb = 0; cb < 2; ++cb)
#pragma unroll
            for (int tb = 0; tb < 4; ++tb) acc[cb][tb] = (f32x4){0.f, 0.f, 0.f, 0.f};
#pragma unroll
        for (int ks = 0; ks < 8; ++ks) {
            bf16x8 zf[4];
#pragma unroll
            for (int tb = 0; tb < 4; ++tb) zf[tb] = *(const LAS bf16x8*)(Zs + (16 * tb + lr) * 264 + ks * 32 + 8 * lq);
#pragma unroll
            for (int cb = 0; cb < 2; ++cb)
#pragma unroll
                for (int tb = 0; tb < 4; ++tb) acc[cb][tb] = __builtin_amdgcn_mfma_f32_16x16x32_bf16(wf[cb][ks], zf[tb], acc[cb][tb], 0, 0, 0);
        }
#pragma unroll
        for (int cb = 0; cb < 2; ++cb) { const int n0 = 32 * wave + 16 * cb + 4 * lq;
            const f32x4 bv = *(const GAS f32x4*)(inpg(a, I_GLUB) + l * 256 + n0);
#pragma unroll
            for (int tb = 0; tb < 4; ++tb) { const int t = 16 * tb + lr;
                const u32x2 zz = *(const LAS u32x2*)(Zs + t * 264 + n0);
                const f32x4 sg = acc[cb][tb] + bv;
                const float z0 = __uint_as_float(zz.x << 16), z1 = __uint_as_float(zz.x & 0xffff0000u), z2 = __uint_as_float(zz.y << 16), z3 = __uint_as_float(zz.y & 0xffff0000u);
                u32x2 w; w.x = pk2(z0 * sigmoidf_(sg.x), z1 * sigmoidf_(sg.y)); w.y = pk2(z2 * sigmoidf_(sg.z), z3 * sigmoidf_(sg.w));
                *(GAS u32x2*)(MIX + (size_t)(r0 + t) * 1024 + 512 + n0) = w; } }
        LBAR();
    }
}

__device__ __forceinline__ void conv_phase(const Ctx& a, int l, int G, const int tid) {
    bf16* AU = (bf16*)(a.ws + WS_BIG);
    const float* cw = inp(a, I_CW) + (size_t)l * 3 * DFF; const float* cb = inp(a, I_CB) + (size_t)l * DFF;
    const int NIT = MTOK * (DFF / 8);
    for (int it = a.bid * 512 + tid; it < NIT; it += G * 512) {
        const int m = it / (DFF / 8), f0 = (it % (DFF / 8)) * 8;
        const int t = m < NPROMPT ? (m & 255) : ((m - NPROMPT) & 1023); const int Ls = m < NPROMPT ? 256 : 1024;
        bf16* pa = AU + (size_t)m * NGU + (f0 >> 7) * 256 + (f0 & 127);
        const v4u ac = *(const v4u*)pa, uu = *(const v4u*)(pa + 128);
        v4u ap = {0u, 0u, 0u, 0u}, an = {0u, 0u, 0u, 0u};
        if (t > 0) ap = *(const v4u*)(pa - NGU);
        if (t < Ls - 1) an = *(const v4u*)(pa + NGU);
        const unsigned acw[4] = {ac.x, ac.y, ac.z, ac.w}, apw[4] = {ap.x, ap.y, ap.z, ap.w}, anw[4] = {an.x, an.y, an.z, an.w}, uw[4] = {uu.x, uu.y, uu.z, uu.w};
        float w0[8], w1[8], w2[8], bb[8];
        *(f32x4*)&w0[0] = *(const f32x4*)(cw + f0); *(f32x4*)&w0[4] = *(const f32x4*)(cw + f0 + 4);
        *(f32x4*)&w1[0] = *(const f32x4*)(cw + DFF + f0); *(f32x4*)&w1[4] = *(const f32x4*)(cw + DFF + f0 + 4);
        *(f32x4*)&w2[0] = *(const f32x4*)(cw + 2 * DFF + f0); *(f32x4*)&w2[4] = *(const f32x4*)(cw + 2 * DFF + f0 + 4);
        *(f32x4*)&bb[0] = *(const f32x4*)(cb + f0); *(f32x4*)&bb[4] = *(const f32x4*)(cb + f0 + 4);
        unsigned ow[4];
#pragma unroll
        for (int e = 0; e < 4; ++e) {
            const float c0 = w0[2 * e] * __uint_as_float(apw[e] << 16) + w1[2 * e] * __uint_as_float(acw[e] << 16) + w2[2 * e] * __uint_as_float(anw[e] << 16) + bb[2 * e];
            const float c1 = w0[2 * e + 1] * __uint_as_float(apw[e] & 0xffff0000u) + w1[2 * e + 1] * __uint_as_float(acw[e] & 0xffff0000u) + w2[2 * e + 1] * __uint_as_float(anw[e] & 0xffff0000u) + bb[2 * e + 1];
            ow[e] = pk2(c0 * sigmoidf_(c0) * __uint_as_float(uw[e] << 16), c1 * sigmoidf_(c1) * __uint_as_float(uw[e] & 0xffff0000u));
        }
        v4u o; o.x = ow[0]; o.y = ow[1]; o.z = ow[2]; o.w = ow[3];
        *(v4u*)(pa + 128) = o;
    }
}

constexpr int N_PHASES = 17;
#ifndef MK_SPLIT
#define MK_SPLIT 0
#endif

__global__ void __launch_bounds__(NWAVES * 64, 2) hyb_fwd(Args args) {
    extern __shared__ __attribute__((aligned(16))) unsigned char lds[];
    const int tid0 = threadIdx.x; const int G0 = gridDim.x;
    LAS unsigned char* ldsl = (LAS unsigned char*)lds;
    volatile LAS unsigned* MISC = (volatile LAS unsigned*)(ldsl + MISC_OFF);
    for (int u = tid0; u < (LDS_BYTES - LDSCTL_OFF) / 4; u += NWAVES * 64) ((LAS unsigned*)(ldsl + LDSCTL_OFF))[u] = 0u;
    __syncthreads();
    LAS unsigned long long* ptab = (LAS unsigned long long*)(ldsl + MISC_OFF + 256);
    if (tid0 < 36) ptab[tid0] = (unsigned long long)args.in[tid0];
    __syncthreads();
    gu32* ctl = (gu32*)(args.ws + WS_CTL);
    XcdBarrier bar; bar.bar = (unsigned*)(ctl + CW_BAR); bar.x = 0; bar.st = nullptr;
    if (!MK_SPLIT) bar = xcd_barrier_post((unsigned*)(ctl + CW_BAR), MISC + 8);
    const int lo = args.ph_lo, hi = args.ph_hi;
    const int wave_s = __builtin_amdgcn_readfirstlane(tid0 >> 6);
    for (int it = lo; it < hi; ++it) {
        const int ph = (PROBE_REP < 0 || it <= PROBE_REP) ? it : (it <= PROBE_REP + PROBE_NREP ? PROBE_REP : it - PROBE_NREP);
        const int rep = (PROBE_REP >= 0 && it > PROBE_REP && it <= PROBE_REP + PROBE_NREP) ? it - PROBE_REP : 0;
        unsigned ones = ~0u; asm volatile("" : "+s"(ones));
        int tid = wave_s * 64 + (int)__builtin_amdgcn_mbcnt_hi(ones, __builtin_amdgcn_mbcnt_lo(ones, 0u)); asm volatile("" : "+v"(tid));
        Ctx a; a.ws = args.ws; a.out = args.out; a.tbl = ptab; a.bid = blockIdx.x; asm volatile("" : "+s"(a.ws)); asm volatile("" : "+s"(a.out)); asm volatile("" : "+s"(a.bid));
        int G = G0; asm volatile("" : "+s"(G));
        const float* modb = (const float*)(a.ws + WS_MOD);
        if (ph == 0) { if (ENB(0)) p0_prologue(a, lds, G, rep, MISC, tid); }
        else {
            const int l = (ph - 1) / 8, q = (ph - 1) % 8;
            switch (q) {
            case 0: if (ENB(1)) norm_phase(a, l, 0, G, tid); break;
            case 1: if (ENB(2)) { gates_phase(a, l, G, tid);
                pg8::Gemm g{(const pg8::bf16_t*)(a.ws + WS_H), (const pg8::bf16_t*)(a.ws + WS_WIN) + (size_t)l * 2048 * 1024, MTOK, 2048, 1024, 1024, 0};
                pg8::StaticOrder S; S.init(MTOK, 2048, G, a.bid);
                EpiG1 E{l, a.ws, a.out, inp(a, I_QG) + l * 64, inp(a, I_KG) + l * 64};
                pg8::gemm_phase<EpiG1, pg8::StaticOrder, true, true>(tid, ldsl, g, S, E); } break;
            case 2: if (ENB(3)) mix_phase(a, l, rep, lds, MISC, tid); break;
            case 3: if (ENB(4)) fg_phase(a, l, G, ldsl, tid); break;
            case 4: if (ENB(6)) { pg8::Gemm g{(const pg8::bf16_t*)(a.ws + WS_MIX), (const pg8::bf16_t*)(a.ws + WS_WOUT) + (size_t)l * 1024 * 1024, MTOK, 1024, 1024, 1024, 0};
                pg8::StaticOrder S; S.init(MTOK, 1024, G, a.bid);
                EpiResid E{l == 0 ? inp(a, I_XP) : a.out + OUT_Y, l == 0 ? inp(a, I_XS) : a.out + OUT_Y + (size_t)NPROMPT * DM, a.out + OUT_Y, (rep && l == 1) ? (const float*)(a.ws + 131072) : modb + (size_t)l * 9 * 6144 + 2 * 1024};
                pg8::gemm_phase<EpiResid, pg8::StaticOrder, true, true>(tid, ldsl, g, S, E); } break;
            case 5: if (ENB(7)) norm_phase(a, l, 1, G, tid); break;
            case 6: if (ENB(8)) { pg8::Gemm g{(const pg8::bf16_t*)(a.ws + WS_H), (const pg8::bf16_t*)(a.ws + WS_WGU) + (size_t)l * NGU * 1024, MTOK, NGU, 1024, 1024, 0};
                StripOrder S{G, a.bid};
                EpiG3 E{(bf16*)(a.ws + WS_BIG), inp(a, I_CW) + (size_t)l * 3 * DFF, inp(a, I_CB) + (size_t)l * DFF, (LAS float*)(ldsl + XR_OFF)};
                pg8::gemm_phase<EpiG3, StripOrder, true, true>(tid, ldsl, g, S, E); } break;
            case 7: if (ENB(10)) { pg8::Gemm g{(const pg8::bf16_t*)(a.ws + WS_BIG), (const pg8::bf16_t*)(a.ws + WS_WDN) + (size_t)l * 1024 * DFF, MTOK, 1024, DFF, DFF, 0};
                pg8::StaticOrder S; S.init(MTOK, 1024, G, a.bid);
                EpiResid E{a.out + OUT_Y, a.out + OUT_Y + (size_t)NPROMPT * DM, a.out + OUT_Y, rep ? (const float*)(a.ws + 131072) : modb + (size_t)l * 9 * 6144 + 5 * 1024};
                pg8::gemm_phase<EpiResid, pg8::StaticOrder, true, true>(tid, ldsl, g, S, E); } break;
            }
        }
        if (it + 1 < hi) xcd_barrier(bar);
        if (PROBE_XBAR && it + 1 < hi) { for (int xb = 0; xb < PROBE_XBAR; ++xb) xcd_barrier(bar); }
    }
}

extern "C" void kernel_launch(void* const* d_in, const int* in_sizes, int n_in, void* d_out, int out_size, void* d_ws, size_t ws_size, hipStream_t stream) {
    static int grid = 0;
    if (grid == 0) {
        if (n_in != 36 || ws_size < WS_END) { fprintf(stderr, "kernel_launch: unexpected inputs (n_in %d, ws %zu)\n", n_in, ws_size); grid = -1; return; }
        int dev = 0, cus = 0, per_cu = 0;
        if (hipGetDevice(&dev) != hipSuccess || hipDeviceGetAttribute(&cus, hipDeviceAttributeMultiprocessorCount, dev) != hipSuccess) { grid = -1; return; }
        if (hipFuncSetAttribute((const void*)hyb_fwd, hipFuncAttributeMaxDynamicSharedMemorySize, LDS_BYTES) != hipSuccess) { fprintf(stderr, "kernel_launch: hipFuncSetAttribute failed\n"); grid = -1; return; }
        if (hipOccupancyMaxActiveBlocksPerMultiprocessor(&per_cu, (const void*)hyb_fwd, NWAVES * 64, LDS_BYTES) != hipSuccess || per_cu < 1) { fprintf(stderr, "kernel_launch: occupancy query says %d\n", per_cu); }
        (void)hipGetLastError();
        grid = cus;
    }
    if (grid < 0) return;
    (void)hipMemsetAsync((char*)d_ws + WS_CTL, 0, CTL_ZERO_BYTES, stream);
    Args a{};
    for (int i = 0; i < 36; ++i) a.in[i] = (const float*)d_in[i];
    a.out = (float*)d_out; a.ws = (unsigned char*)d_ws;
#if MK_SPLIT
    for (int ph = 0; ph < N_PHASES; ++ph) { a.ph_lo = ph; a.ph_hi = ph + 1; hipLaunchKernelGGL(hyb_fwd, dim3(grid), dim3(NWAVES * 64), LDS_BYTES, stream, a); }
#else
    a.ph_lo = 0; a.ph_hi = N_PHASES + (PROBE_REP >= 0 ? PROBE_NREP : 0);
    hipLaunchKernelGGL(hyb_fwd, dim3(grid), dim3(NWAVES * 64), LDS_BYTES, stream, a);
#endif
}
```
